# Optimizing an MI355X kernel written in HIP

```python
import math
import jax
import jax.numpy as jnp
from jax import lax
import numpy as np

D_MODEL = 2048
BATCH = 4
SEQ = 4096
DEPTH = 4

GRID_W = 64
HEAD_DIM = 128
MIX_WIDTH = D_MODEL
EPS = 1e-6
A_WIDTH = MIX_WIDTH // 2
A_GROUPS = 8
A_GROUP_DIM = A_WIDTH // A_GROUPS
CHUNK = 128
B_WIDTH = MIX_WIDTH - A_WIDTH
HYENA_ORDER = 2
HYENA_EMB = 33
HYENA_BANDS = (HYENA_EMB - 1) // 2
HYENA_FFN = 64
HYENA_TARGET = 1e-2
HYENA_FAST = 0.3
HYENA_SLOW = 1.5
AB_IN = 2 * A_WIDTH + (HYENA_ORDER + 1) * B_WIDTH
C_WIDTH = MIX_WIDTH // 2
C_HEADS = C_WIDTH // HEAD_DIM
NA_KH = 8
NA_KW = 16
D_WIDTH = MIX_WIDTH - C_WIDTH
D_HEADS = 8
D_HALF = D_WIDTH // (2 * D_HEADS)
Q_BLOCK = 128
ROPE_THETA = 10000.0
CD_IN = 3 * C_WIDTH + 3 * D_WIDTH
D_FF = 256 * ((8 * D_MODEL // 3 + 255) // 256)
N_EVEN = (DEPTH + 1) // 2
N_ODD = DEPTH // 2

kernel_name = 'hybrid_gmlp_hyena_natten_diffattn_encoder'


def rms_norm(x, g):
    xf = x.astype(jnp.float32)
    y = xf * lax.rsqrt(jnp.mean(xf * xf, axis=-1, keepdims=True) + EPS)
    return (y * g.astype(jnp.float32)).astype(x.dtype)


def dwconv3(h, w, b):
    hp = jnp.pad(h, ((0, 0), (1, 1), (0, 0)))
    return hp[:, :-2] * w[0] + hp[:, 1:-1] * w[1] + hp[:, 2:] * w[2] + b


def rotary(x):
    L, dh = x.shape[1], x.shape[-1]
    half = dh // 2
    inv = 1.0 / (ROPE_THETA ** (jnp.arange(half, dtype=jnp.float32) * 2.0 / dh))
    ang = jnp.arange(L, dtype=jnp.float32)[:, None] * inv[None, :]
    cos = jnp.cos(ang)[None, :, None, None, :]
    sin = jnp.sin(ang)[None, :, None, None, :]
    xf = x.astype(jnp.float32)
    x1, x2 = xf[..., :half], xf[..., half:]
    return jnp.concatenate([x1 * cos - x2 * sin, x1 * sin + x2 * cos], axis=-1).astype(x.dtype)


def chunked_spatial_gating(p, v_gain, w_s, b_s):
    Bn, L, _ = p.shape
    u, v = jnp.split(jax.nn.gelu(p, approximate=False), 2, axis=-1)
    v = rms_norm(v, v_gain).reshape(Bn, L // CHUNK, CHUNK, A_GROUPS, A_GROUP_DIM)
    s = jnp.einsum('gpq,bcqgd->bcpgd', w_s, v) + b_s.T[None, None, :, :, None]
    return u * s.reshape(Bn, L, A_WIDTH)


def hyena_filter_spectrum(L, w1, b1, w2, b2, w3, freq):
    f32 = jnp.float32
    t = jnp.linspace(0.0, 1.0, L, dtype=f32)[:, None]
    w = 2.0 * math.pi * jnp.arange(L, dtype=f32)[:, None] / L
    bands = jnp.linspace(1e-4, HYENA_BANDS - 1, HYENA_BANDS, dtype=f32)[None, :]
    z = jnp.concatenate([t, jnp.cos(w * bands), -jnp.sin(w * bands)], axis=-1)
    fr = freq.astype(f32)
    h = jnp.sin(fr[0] * (z @ w1.astype(f32) + b1.astype(f32)))
    h = jnp.sin(fr[1] * (h @ w2.astype(f32) + b2.astype(f32)))
    h = (h @ w3.astype(f32)).reshape(L, HYENA_ORDER, 2, B_WIDTH)
    max_decay = math.log(HYENA_TARGET) / HYENA_FAST
    min_decay = math.log(HYENA_TARGET) / HYENA_SLOW
    deltas = jnp.abs(jnp.linspace(min_decay, max_decay, B_WIDTH, dtype=f32))
    h = h * jnp.exp(-t[:, :, None, None] * deltas)
    k = jnp.concatenate([h[:, :, 0], jnp.zeros((1, HYENA_ORDER, B_WIDTH), f32), h[:0:-1, :, 1]], axis=0)
    k = k / jnp.sum(jnp.abs(k), axis=0, keepdims=True)
    return jnp.fft.rfft(k, axis=0)


def long_conv(u, kf, skip):
    L = u.shape[1]
    uf32 = u.astype(jnp.float32)
    uf = jnp.fft.rfft(uf32, n=2 * L, axis=1)
    y = jnp.fft.irfft(uf * kf[None], n=2 * L, axis=1)[:, :L]
    return (y + uf32 * skip.astype(jnp.float32)).astype(u.dtype)


def hyena_mixer(p, conv_w, conv_b, kf, skip):
    p = dwconv3(p, conv_w, conv_b)
    v, x1, x2 = jnp.split(p, 3, axis=-1)
    z = x1 * long_conv(v, kf[:, 0], skip[0])
    return x2 * long_conv(z, kf[:, 1], skip[1])


def neighborhood_attention(q, k, v, rpb):
    Bn, L, H, dh = q.shape
    rows = L // GRID_W
    kh = min(NA_KH, rows)
    kw = NA_KW
    col = jnp.arange(GRID_W)
    col_start = jnp.clip(col - kw // 2, 0, GRID_W - kw)
    key_col = col_start[:, None] + jnp.arange(kw)[None, :]
    rel_col = key_col - col[:, None] + (NA_KW - 1)
    scale = dh ** -0.5

    def one_row(r):
        row_start = jnp.clip(r - kh // 2, 0, rows - kh)
        key_row = row_start + jnp.arange(kh)
        idx = (key_row[None, :, None] * GRID_W + key_col[:, None, :]).reshape(GRID_W, kh * kw)
        rel_row = key_row - r + (NA_KH - 1)
        bias = rpb[:, rel_row[None, :, None], rel_col[:, None, :]].reshape(H, GRID_W, kh * kw)
        qr = lax.dynamic_slice_in_dim(q, r * GRID_W, GRID_W, axis=1)
        kr = jnp.take(k, idx, axis=1)
        vr = jnp.take(v, idx, axis=1)
        s = jnp.einsum('bqhd,bqkhd->bhqk', qr, kr, preferred_element_type=jnp.float32) * scale
        pr = jax.nn.softmax(s + bias.astype(jnp.float32), axis=-1).astype(v.dtype)
        return jnp.einsum('bhqk,bqkhd->bqhd', pr, vr)

    out = lax.map(one_row, jnp.arange(rows))
    return out.transpose(1, 0, 2, 3, 4).reshape(Bn, L, H, dh)


def diff_attention(q, k, v, lam_params, subln, lam_init):
    Bn, L, H, _, dh = q.shape
    lp = lam_params.astype(jnp.float32)
    lam = jnp.exp(jnp.sum(lp[0] * lp[1])) - jnp.exp(jnp.sum(lp[2] * lp[3])) + lam_init
    scale = dh ** -0.5
    nblk = L // Q_BLOCK
    qb = q.reshape(Bn, nblk, Q_BLOCK, H, 2, dh).transpose(1, 0, 2, 3, 4, 5)

    def one_block(qblk):
        s = jnp.einsum('bqhmd,bkhmd->bhmqk', qblk, k, preferred_element_type=jnp.float32) * scale
        pr = jax.nn.softmax(s, axis=-1)
        a = pr[:, :, 0] - lam * pr[:, :, 1]
        return jnp.einsum('bhqk,bkhd->bqhd', a.astype(v.dtype), v)

    o = lax.map(one_block, qb)
    o = o.transpose(1, 0, 2, 3, 4).reshape(Bn, L, H, 2 * dh)
    return rms_norm(o, subln) * (1.0 - lam_init)


def conv_glu_ffn(h, w_up, conv_w, conv_b, w_down):
    a = dwconv3(h @ w_up, conv_w, conv_b)
    g, val = jnp.split(a, 2, axis=-1)
    return (jax.nn.silu(g) * val) @ w_down


def setup_inputs(seed: int = 0) -> dict:
    key = jax.random.key(seed)
    ks = iter(jax.random.split(key, 32))

    def nrm(shape, scale):
        return jax.random.normal(next(ks), shape, jnp.float32) * scale

    def gain(shape):
        return 1.0 + nrm(shape, 0.02)

    F = D_FF
    return {
        'x': nrm((BATCH, SEQ, D_MODEL), 1.0),
        'norm_mix': gain((DEPTH, D_MODEL)),
        'norm_ffn': gain((DEPTH, D_MODEL)),
        'w_out': nrm((DEPTH, MIX_WIDTH, D_MODEL), MIX_WIDTH ** -0.5),
        'ffn_up': nrm((DEPTH, D_MODEL, 2 * F), D_MODEL ** -0.5),
        'ffn_conv_w': nrm((DEPTH, 3, 2 * F), 3 ** -0.5),
        'ffn_conv_b': nrm((DEPTH, 2 * F), 0.02),
        'ffn_down': nrm((DEPTH, F, D_MODEL), F ** -0.5),
        'final_norm': gain((D_MODEL,)),
        'ab_w_in': nrm((N_EVEN, D_MODEL, AB_IN), D_MODEL ** -0.5),
        'a_vnorm': gain((N_EVEN, A_WIDTH)),
        'a_ws': nrm((N_EVEN, A_GROUPS, CHUNK, CHUNK), CHUNK ** -0.5),
        'a_bs': 1.0 + nrm((N_EVEN, A_GROUPS, CHUNK), 0.02),
        'b_conv_w': nrm((N_EVEN, 3, 3 * B_WIDTH), 3 ** -0.5),
        'b_conv_b': nrm((N_EVEN, 3 * B_WIDTH), 0.02),
        'b_filt_w1': nrm((N_EVEN, HYENA_EMB, HYENA_FFN), HYENA_EMB ** -0.5),
        'b_filt_b1': nrm((N_EVEN, HYENA_FFN), 0.02),
        'b_filt_w2': nrm((N_EVEN, HYENA_FFN, HYENA_FFN), HYENA_FFN ** -0.5),
        'b_filt_b2': nrm((N_EVEN, HYENA_FFN), 0.02),
        'b_filt_w3': nrm((N_EVEN, HYENA_FFN, HYENA_ORDER * 2 * B_WIDTH), HYENA_FFN ** -0.5),
        'b_filt_freq': gain((N_EVEN, 2, HYENA_FFN)),
        'b_skip': nrm((N_EVEN, HYENA_ORDER, B_WIDTH), 0.1),
        'cd_w_in': nrm((N_ODD, D_MODEL, CD_IN), D_MODEL ** -0.5),
        'c_rpb': nrm((N_ODD, C_HEADS, 2 * NA_KH - 1, 2 * NA_KW - 1), 0.02),
        'd_lambda': nrm((N_ODD, 4, D_HALF), 0.1),
        'd_subln': gain((N_ODD, 2 * D_HALF)),
    }


def reference(x, norm_mix, norm_ffn, w_out, ffn_up, ffn_conv_w, ffn_conv_b, ffn_down, final_norm,
              ab_w_in, a_vnorm, a_ws, a_bs, b_conv_w, b_conv_b, b_filt_w1, b_filt_b1, b_filt_w2,
              b_filt_b2, b_filt_w3, b_filt_freq, b_skip, cd_w_in, c_rpb, d_lambda, d_subln):
    Bn, L, _ = x.shape
    for l in range(DEPTH):
        i = l // 2
        h = rms_norm(x, norm_mix[l])
        if l % 2 == 0:
            p = h @ ab_w_in[i]
            ya = chunked_spatial_gating(p[..., :2 * A_WIDTH], a_vnorm[i], a_ws[i], a_bs[i])
            kf = hyena_filter_spectrum(L, b_filt_w1[i], b_filt_b1[i], b_filt_w2[i], b_filt_b2[i],
                                       b_filt_w3[i], b_filt_freq[i])
            yb = hyena_mixer(p[..., 2 * A_WIDTH:], b_conv_w[i], b_conv_b[i], kf, b_skip[i])
            y = jnp.concatenate([ya, yb], axis=-1)
        else:
            p = h @ cd_w_in[i]
            qkv_c = p[..., :3 * C_WIDTH].reshape(Bn, L, 3, C_HEADS, HEAD_DIM)
            yc = neighborhood_attention(qkv_c[:, :, 0], qkv_c[:, :, 1], qkv_c[:, :, 2], c_rpb[i])
            pd = p[..., 3 * C_WIDTH:]
            qd = pd[..., :D_WIDTH].reshape(Bn, L, D_HEADS, 2, D_HALF)
            kd = pd[..., D_WIDTH:2 * D_WIDTH].reshape(Bn, L, D_HEADS, 2, D_HALF)
            vd = pd[..., 2 * D_WIDTH:].reshape(Bn, L, D_HEADS, 2 * D_HALF)
            lam_init = 0.8 - 0.6 * math.exp(-0.3 * l)
            yd = diff_attention(rotary(qd), rotary(kd), vd, d_lambda[i], d_subln[i], lam_init)
            y = jnp.concatenate([yc.reshape(Bn, L, C_WIDTH), yd.reshape(Bn, L, D_WIDTH)], axis=-1)
        x = x + y @ w_out[l]
        x = x + conv_glu_ffn(rms_norm(x, norm_ffn[l]), ffn_up[l], ffn_conv_w[l], ffn_conv_b[l], ffn_down[l])
    return rms_norm(x, final_norm)
```

```cpp
#include <hip/hip_runtime.h>
#include <hip/hip_cooperative_groups.h>
#include <cstdio>
#include <cstring>
namespace cg = cooperative_groups;
#ifndef MEGA
#define MEGA 1
#endif
__device__ __forceinline__ int opaque_tid() { int t = (int)threadIdx.x; asm volatile("" : "+v"(t)); return t; }
namespace pg8 {
#define PG8_LAS __attribute__((address_space(3)))
typedef unsigned short bf16_t;
typedef short bf16x8 __attribute__((ext_vector_type(8)));
typedef float f32x4 __attribute__((ext_vector_type(4)));
typedef unsigned u32x4 __attribute__((ext_vector_type(4)));
constexpr int BM = 256, BK = 64, HALF = 128, HTB = HALF * BK * 2  , STAGE_BYTES = 8 * HTB, NXCD = 8, WGM = 8;

__host__ __device__ __forceinline__ int lds_byte(int r, int c) { const int st = (r >> 4) * 2 + (c >> 5), rr = r & 15, cc = c & 31, ob = rr * 64 + cc * 2; return st * 1024 + (ob ^ (((ob >> 9) & 1) << 5)); }
__host__ __device__ __forceinline__ void stage_rc(int b, int& R, int& C) { const int st = b / 1024, sb = b % 1024, swz = sb ^ (((sb >> 9) & 1) << 5); R = (st >> 1) * 16 + swz / 64; C = (st & 1) * 32 + (swz % 64) / 2; }
__host__ __device__ __forceinline__ int perm32(int rho) { const int n = rho >> 4, i = rho & 15; return 8 * (i >> 2) + 4 * n + (i & 3); }

struct Unit { int pm, pn; };
struct Gemm { const bf16_t* A; const bf16_t* Bt; int M, N, K; };

struct StaticOrder {
    int nM, nN, nwg, G, c;
    __host__ __device__ void init(int M, int N, int G_, int c_) { nM = M / BM; nN = N / BM; nwg = nM * nN; G = G_; c = c_; }
    __host__ __device__ bool next(int i, Unit& u) const {
        const long L = (long)i * G + c; if (L >= nwg) return false;
        int wgid = (int)L; { const int q = nwg / NXCD, r = nwg % NXCD, xcd = wgid % NXCD, off = wgid / NXCD; wgid = (xcd < r ? xcd * (q + 1) : r * (q + 1) + (xcd - r) * q) + off; }
        const int nig = WGM * nN, gid = wgid / nig, fm = gid * WGM, gsz = (nM - fm) < WGM ? (nM - fm) : WGM;
        u.pm = fm + ((wgid % nig) % gsz); u.pn = (wgid % nig) / gsz; return true;
    }
    __device__ __forceinline__ void a_ready(const Unit&) const {}
    __device__ __forceinline__ void done(const Unit&) const {}
};
__device__ __forceinline__ unsigned cvt_pk_bf16(float lo, float hi) { unsigned r; asm volatile("v_cvt_pk_bf16_f32 %0, %1, %2" : "=v"(r) : "v"(lo), "v"(hi)); return r; }
typedef float f32x2 __attribute__((ext_vector_type(2)));
__device__ __forceinline__ f32x2 gelu_pk(f32x2 v) {
    const f32x2 av = __builtin_elementwise_abs(v), d = av * 0.2316418882f + 1.0f;
    f32x2 t; t.x = __builtin_amdgcn_rcpf(d.x); t.y = __builtin_amdgcn_rcpf(d.y);
    f32x2 q = t * 0.5307027145f + (-0.7265760135f); q = q * t + 0.7107068705f; q = q * t + (-0.142248368f); q = q * t + 0.127414796f; q = q * t;
    const f32x2 s = (v * v) * (-0.72134752044f);
    f32x2 e; e.x = __builtin_amdgcn_exp2f(s.x); e.y = __builtin_amdgcn_exp2f(s.y);
    const f32x2 m = v * (q * e), r = v - m;
    f32x2 o; o.x = v.x < 0.f ? m.x : r.x; o.y = v.y < 0.f ? m.y : r.y; return o;
}

template <class Epi, class Sched, bool STAMP = false>
__device__ __forceinline__ void gemm_phase(PG8_LAS unsigned char* lds, const Gemm g, const Sched& S, const Epi& E, unsigned long long* stamps) {
    const int tid = opaque_tid(), wid = __builtin_amdgcn_readfirstlane(tid >> 6), lane = tid & 63, wr = wid >> 2, wc = wid & 3, fr = lane & 15, fq = lane >> 4;
    const int K = g.K, nt = K / BK;
    int ts_lo = 0, ts_hi = 0, nts = 0; const unsigned long long rt_entry = STAMP ? (unsigned long long)wall_clock64() : 0ull;
#define PG8_STAMP() do { if (STAMP && wid == 0 && nts < 64) { const unsigned long long _c = (unsigned long long)clock64(); \
        ts_lo = (lane == nts) ? (int)(unsigned)_c : ts_lo; ts_hi = (lane == nts) ? (int)(unsigned)(_c >> 32) : ts_hi; ++nts; } } while (0)
    PG8_STAMP();
    unsigned voffA[2], voffB[2];
#pragma unroll
    for (int i = 0; i < 2; ++i) { int R, C; stage_rc(tid * 16 + i * 8192, R, C); const int Rb = Epi::PERM ? ((R & ~31) + perm32(R & 31)) : R;
        voffA[i] = (unsigned)(R * K + C) * 2u; voffB[i] = (unsigned)(Rb * K + C) * 2u; }
    const size_t kstep = (size_t)(BK * 2);
    const size_t hstep = (size_t)HALF * K * 2;
    const size_t tstep = 2 * hstep;
    const unsigned ldsw = (unsigned)wid * 1024u;
    const int aoff = lds_byte(wr * 64 + fr, fq * 8), boff = lds_byte(wc * 32 + fr, fq * 8);
#define PG8_SA(b, h) (((b) * 2 + (h)) * HTB)
#define PG8_SB(b, h) ((4 + (b) * 2 + (h)) * HTB)
#define PG8_STAGE(bufoff, gbase, voff) do { _Pragma("unroll") for (int _i = 0; _i < 2; ++_i) \
        __builtin_amdgcn_global_load_lds((const unsigned*)((const char*)(gbase) + (voff)[_i]), (PG8_LAS unsigned*)(lds + (bufoff) + ldsw + _i * 8192), 16, 0, 0); } while (0)
#define PG8_LDA(dst, b, h) do { _Pragma("unroll") for (int m = 0; m < 4; ++m) _Pragma("unroll") for (int k = 0; k < 2; ++k) dst[m][k] = *(const PG8_LAS bf16x8*)(lds + PG8_SA(b, h) + aoff + m * 2048 + k * 1024); } while (0)
#define PG8_LDB(dst, b, h) do { _Pragma("unroll") for (int n = 0; n < 2; ++n) _Pragma("unroll") for (int k = 0; k < 2; ++k) dst[n][k] = *(const PG8_LAS bf16x8*)(lds + PG8_SB(b, h) + boff + n * 2048 + k * 1024); } while (0)
#define PG8_MMA(ai, bj, At, Bt) do { __builtin_amdgcn_s_setprio(1); _Pragma("unroll") for (int m = 0; m < 4; ++m) _Pragma("unroll") for (int n = 0; n < 2; ++n) _Pragma("unroll") for (int k = 0; k < 2; ++k) \
        acc[ai][bj][m][n] = __builtin_amdgcn_mfma_f32_16x16x32_bf16(Bt[n][k], At[m][k], acc[ai][bj][m][n], 0, 0, 0); __builtin_amdgcn_s_setprio(0); } while (0)
#define PG8_WAIT_V(n) asm volatile("s_waitcnt vmcnt(" #n ")" ::: "memory")
#define PG8_WAIT_L(n) asm volatile("s_waitcnt lgkmcnt(" #n ")" ::: "memory")
#define PG8_BAR __builtin_amdgcn_s_barrier()
#define PG8_SCHED __builtin_amdgcn_sched_barrier(0)
    Unit cur, nxt; int ui = 0;
    if (!S.next(0, cur)) return;
    f32x4 acc[2][2][4][2];
#pragma unroll
    for (int a = 0; a < 2; ++a)
#pragma unroll
        for (int b = 0; b < 2; ++b)
#pragma unroll
            for (int m = 0; m < 4; ++m)
#pragma unroll
                for (int n = 0; n < 2; ++n) acc[a][b][m][n] = (f32x4){0.f, 0.f, 0.f, 0.f};
    bf16x8 At[4][2], B0[2][2], B1[2][2];
    const char* cA = (const char*)g.A + (size_t)cur.pm * tstep; const char* cB = (const char*)g.Bt + (size_t)cur.pn * tstep;
    S.a_ready(cur);
    PG8_STAGE(PG8_SB(0, 0), cB, voffB); PG8_STAGE(PG8_SA(0, 0), cA, voffA); PG8_STAGE(PG8_SB(0, 1), cB + hstep, voffB); PG8_STAGE(PG8_SA(0, 1), cA + hstep, voffA);
    if (wr == 1) PG8_BAR;
    PG8_WAIT_V(4); PG8_BAR;
    PG8_STAGE(PG8_SB(1, 0), cB + kstep, voffB); PG8_STAGE(PG8_SA(1, 0), cA + kstep, voffA); PG8_STAGE(PG8_SB(1, 1), cB + hstep + kstep, voffB);
    PG8_WAIT_V(6); PG8_BAR;
    PG8_STAMP();
    for (;;) {
        const bool has_next = S.next(ui + 1, nxt);
        const char* nA = has_next ? (const char*)g.A + (size_t)nxt.pm * tstep : cA; const char* nB = has_next ? (const char*)g.Bt + (size_t)nxt.pn * tstep : cB;
        for (int t = 0; t < nt; t += 2) {
            const bool last = (t == nt - 2);
            const char* a1 = cA + (size_t)(t + 1) * kstep;
            const char* a2 = last ? nA : cA + (size_t)(t + 2) * kstep; const char* b2 = last ? nB : cB + (size_t)(t + 2) * kstep;
            const char* a3 = a2 + kstep; const char* b3 = b2 + kstep;
            if (last && has_next) S.a_ready(nxt);
            PG8_LDB(B0, 0, 0); PG8_SCHED; PG8_LDA(At, 0, 0); PG8_STAGE(PG8_SA(1, 1), a1 + hstep, voffA);
            PG8_WAIT_L(8); PG8_BAR; PG8_WAIT_L(0); PG8_MMA(0, 0, At, B0); PG8_BAR; PG8_SCHED;
            PG8_LDB(B1, 0, 1); PG8_STAGE(PG8_SB(0, 0), b2, voffB);
            PG8_BAR; PG8_WAIT_L(0); PG8_MMA(0, 1, At, B1); PG8_BAR;
            PG8_LDA(At, 0, 1); PG8_STAGE(PG8_SA(0, 0), a2, voffA);
            PG8_BAR; PG8_WAIT_L(0); PG8_MMA(1, 0, At, B0); PG8_BAR; PG8_SCHED;
            PG8_STAGE(PG8_SB(0, 1), b2 + hstep, voffB);
            PG8_WAIT_V(6); PG8_BAR; PG8_MMA(1, 1, At, B1); PG8_BAR;
            PG8_LDB(B0, 1, 0); PG8_SCHED; PG8_LDA(At, 1, 0); PG8_STAGE(PG8_SA(0, 1), a2 + hstep, voffA);
            PG8_WAIT_L(8); PG8_BAR; PG8_WAIT_L(0); PG8_MMA(0, 0, At, B0); PG8_BAR; PG8_SCHED;
            PG8_LDB(B1, 1, 1); PG8_STAGE(PG8_SB(1, 0), b3, voffB);
            PG8_BAR; PG8_WAIT_L(0); PG8_MMA(0, 1, At, B1); PG8_BAR;
            PG8_LDA(At, 1, 1); PG8_STAGE(PG8_SA(1, 0), a3, voffA);
            PG8_BAR; PG8_WAIT_L(0); PG8_MMA(1, 0, At, B0); PG8_BAR; PG8_SCHED;
            PG8_STAGE(PG8_SB(1, 1), b3 + hstep, voffB);
            PG8_WAIT_V(6); PG8_BAR; PG8_MMA(1, 1, At, B1); PG8_BAR;
        }
        PG8_STAMP();
        if constexpr (!Epi::AFTER_DRAIN) { E(acc, cur, wr, wc, fr, fq); S.done(cur); }
        PG8_STAMP();
        if (!has_next) break;
#pragma unroll
        for (int a = 0; a < 2; ++a)
#pragma unroll
            for (int b = 0; b < 2; ++b)
#pragma unroll
                for (int m = 0; m < 4; ++m)
#pragma unroll
                    for (int n = 0; n < 2; ++n) acc[a][b][m][n] = (f32x4){0.f, 0.f, 0.f, 0.f};
        cur = nxt; cA = nA; cB = nB; ++ui;
    }
    PG8_WAIT_V(0);
    if (wr == 0) PG8_BAR;
    PG8_BAR;
    if constexpr (Epi::AFTER_DRAIN) { E.fused(acc, cur, wr, wc, fr, fq, lds, wid, lane); S.done(cur); }
    PG8_STAMP();
    if (STAMP && wid == 0) { stamps[lane] = lane < nts ? (((unsigned long long)(unsigned)ts_hi << 32) | (unsigned)ts_lo) : 0ull;
        if (lane == 62) stamps[62] = rt_entry; if (lane == 63) stamps[63] = (unsigned long long)wall_clock64(); }
#undef PG8_STAMP
#undef PG8_SA
#undef PG8_SB
#undef PG8_STAGE
#undef PG8_LDA
#undef PG8_LDB
#undef PG8_MMA
#undef PG8_WAIT_V
#undef PG8_WAIT_L
#undef PG8_BAR
#undef PG8_SCHED
}
}
using pg8::bf16x8; using pg8::f32x4; using pg8::u32x4; using pg8::f32x2; using pg8::cvt_pk_bf16; using pg8::gelu_pk;
typedef float f32x16 __attribute__((ext_vector_type(16)));
typedef unsigned u32x2 __attribute__((ext_vector_type(2)));
typedef unsigned short u16;
typedef unsigned char u8;

constexpr int T_ = 16384, D_ = 2048, L_ = 4096, F_ = 5632, F2_ = 11264;
constexpr int FS = 8208;
constexpr int LDS_BYTES = 131072;
constexpr int MAXSTEPS = 64;

enum { OP_PRE = 0, OP_HF2, OP_NORM, OP_GEMM_IN, OP_EVEN_A, OP_HC, OP_HB, OP_ODD_PREP, OP_ATTN, OP_GEMM_OUT, OP_GEMM_UP, OP_CG, OP_GEMM_DOWN };

struct Params {
    const float* in[26];
    float* x;
    u16* wt_in[4]; u16* wt_out[4]; u16* wt_up[4]; u16* wt_down[4];
    u16* h; u16* p; u16* y; u16* up; u16* gated;
    u16* pT; u16* yT; u16* vcT; u16* vdT;
    u16* filt; float* invn; float* h2tab;
    const float* cw_src[16]; u16* cw_dst[16];
    int cw_K[16]; int cw_N[16]; int cw_t0[18];
    int nsteps; int pad0;
    int ops[MAXSTEPS]; int lyr[MAXSTEPS]; int arg[MAXSTEPS];
};

union V8 { bf16x8 v; unsigned u[4]; uint4 q; };

__device__ __forceinline__ float bflo(unsigned w) { return __uint_as_float(w << 16); }
__device__ __forceinline__ float bfhi(unsigned w) { return __uint_as_float(w & 0xffff0000u); }
__device__ __forceinline__ float bf2f(u16 b) { return __uint_as_float(((unsigned)b) << 16); }
__device__ __forceinline__ u16 f2bf(float f) { unsigned u = __float_as_uint(f); u += 0x7FFFu + ((u >> 16) & 1u); return (u16)(u >> 16); }
__device__ __forceinline__ unsigned pk2(float a, float b) { return (unsigned)f2bf(a) | ((unsigned)f2bf(b) << 16); }
__device__ __forceinline__ float wave_sum(float v) {
#pragma unroll
    for (int o = 32; o >= 1; o >>= 1) v += __shfl_xor(v, o);
    return v;
}
#define MFMA16(a, b, c) __builtin_amdgcn_mfma_f32_16x16x32_bf16((a), (b), (c), 0, 0, 0)
#define MFMA32(a, b, c) __builtin_amdgcn_mfma_f32_32x32x16_bf16((a), (b), (c), 0, 0, 0)

struct EpiStoreBf16 {
    static constexpr bool PERM = true, AFTER_DRAIN = false;
    u16* O; int ldc; int gelu_cols;
    __device__ __forceinline__ void operator()(const f32x4 (&acc)[2][2][4][2], const pg8::Unit& u, int wr, int wc, int fr, int fq) const {
        const int row0 = u.pm * 256 + wr * 64 + fr, col0 = u.pn * 256 + wc * 32 + 8 * fq;
        const bool act = (u.pn * 256) < gelu_cols;
#pragma unroll
        for (int ai = 0; ai < 2; ++ai)
#pragma unroll
            for (int m = 0; m < 4; ++m) {
                u16* rowp = O + (size_t)(row0 + ai * 128 + m * 16) * ldc + col0;
#pragma unroll
                for (int bj = 0; bj < 2; ++bj) {
                    f32x4 v0 = acc[ai][bj][m][0], v1 = acc[ai][bj][m][1];
                    if (act) {
                        f32x2 a = gelu_pk((f32x2){v0[0], v0[1]}), b = gelu_pk((f32x2){v0[2], v0[3]}), c = gelu_pk((f32x2){v1[0], v1[1]}), d = gelu_pk((f32x2){v1[2], v1[3]});
                        v0 = (f32x4){a.x, a.y, b.x, b.y}; v1 = (f32x4){c.x, c.y, d.x, d.y};
                    }
                    u32x4 w; w.x = cvt_pk_bf16(v0[0], v0[1]); w.y = cvt_pk_bf16(v0[2], v0[3]); w.z = cvt_pk_bf16(v1[0], v1[1]); w.w = cvt_pk_bf16(v1[2], v1[3]);
                    *(u32x4*)(rowp + bj * 128) = w;
                }
            }
    }
};
struct EpiResid {
    static constexpr bool PERM = false, AFTER_DRAIN = false;
    const float* R; float* X;
    __device__ __forceinline__ void operator()(const f32x4 (&acc)[2][2][4][2], const pg8::Unit& u, int wr, int wc, int fr, int fq) const {
        const int row0 = u.pm * 256 + wr * 64 + fr, col0 = u.pn * 256 + wc * 32 + 4 * fq;
#pragma unroll
        for (int ai = 0; ai < 2; ++ai)
#pragma unroll
            for (int m = 0; m < 4; ++m) {
                const size_t off = (size_t)(row0 + ai * 128 + m * 16) * D_ + col0;
#pragma unroll
                for (int bj = 0; bj < 2; ++bj)
#pragma unroll
                    for (int n = 0; n < 2; ++n) {
                        const f32x4 r = *(const f32x4*)(R + off + bj * 128 + n * 16);
                        *(f32x4*)(X + off + bj * 128 + n * 16) = acc[ai][bj][m][n] + r;
                    }
            }
    }
};

__device__ __forceinline__ void convT_tile(const float* __restrict__ W, int K, int N, u16* __restrict__ Wt, int tile, u8* shm) {
    unsigned* tl = (unsigned*)shm;
    const int tid = opaque_tid(), wid = tid >> 6, lane = tid & 63;
    const int nN = N >> 8, kt = tile / nN, nt = tile - kt * nN, k0 = kt * 64, n0 = nt * 256;
    float v[8][4];
#pragma unroll
    for (int r = 0; r < 8; ++r)
#pragma unroll
        for (int e = 0; e < 4; ++e) v[r][e] = W[(size_t)(k0 + wid * 8 + r) * N + n0 + lane + 64 * e];
#pragma unroll
    for (int rp = 0; rp < 4; ++rp)
#pragma unroll
        for (int e = 0; e < 4; ++e) tl[(lane + 64 * e) * 33 + wid * 4 + rp] = cvt_pk_bf16(v[2 * rp][e], v[2 * rp + 1][e]);
    __syncthreads();
#pragma unroll
    for (int i = 0; i < 4; ++i) {
        const int id = i * 512 + tid, n = id >> 3, kc = id & 7;
        uint4 w; w.x = tl[n * 33 + kc * 4]; w.y = tl[n * 33 + kc * 4 + 1]; w.z = tl[n * 33 + kc * 4 + 2]; w.w = tl[n * 33 + kc * 4 + 3];
        *(uint4*)(Wt + (size_t)(n0 + n) * K + k0 + kc * 8) = w;
    }
    __syncthreads();
}

__device__ __forceinline__ void norm_phase(const float* x, const float* __restrict__ g, u16* h, float* outf) {
    const int wid = opaque_tid() >> 6, lane = opaque_tid() & 63;
    for (int row = blockIdx.x * 8 + wid; row < T_; row += gridDim.x * 8) {
        const float* xr = x + (size_t)row * D_;
        float4 v[8]; float ss = 0.f;
#pragma unroll
        for (int i = 0; i < 8; ++i) { v[i] = *(const float4*)(xr + i * 256 + lane * 4); ss += v[i].x * v[i].x + v[i].y * v[i].y + v[i].z * v[i].z + v[i].w * v[i].w; }
        ss = wave_sum(ss);
        const float rstd = rsqrtf(ss * (1.0f / D_) + 1e-6f);
#pragma unroll
        for (int i = 0; i < 8; ++i) {
            const float4 gg = *(const float4*)(g + i * 256 + lane * 4);
            const float a = v[i].x * rstd * gg.x, b = v[i].y * rstd * gg.y, c = v[i].z * rstd * gg.z, d = v[i].w * rstd * gg.w;
            if (outf) *(float4*)(outf + (size_t)row * D_ + i * 256 + lane * 4) = make_float4(a, b, c, d);
            else { u32x2 w; w.x = cvt_pk_bf16(a, b); w.y = cvt_pk_bf16(c, d); *(u32x2*)(h + (size_t)row * D_ + i * 256 + lane * 4) = w; }
        }
    }
}

__device__ __forceinline__ void hf1_phase(const Params& P) {
    const int wid = opaque_tid() >> 6, lane = opaque_tid() & 63;
    for (int idx = blockIdx.x * 8 + wid; idx < 2 * L_; idx += gridDim.x * 8) {
        const int i = idx >> 12, t = idx & 4095;
        const float* w1 = P.in[15] + i * 33 * 64; const float* b1 = P.in[16] + i * 64;
        const float* w2 = P.in[17] + i * 64 * 64; const float* b2 = P.in[18] + i * 64;
        const float* fr = P.in[20] + i * 128;
        const float tn = (float)t / 4095.0f;
        const float w = (6.283185307179586f * (float)t) / 4096.0f;
        float acc = b1[lane] + tn * w1[lane];
        for (int k = 0; k < 16; ++k) {
            const float band = 1e-4f + (float)k * ((15.0f - 1e-4f) / 15.0f);
            const float a = w * band;
            acc += cosf(a) * w1[(1 + k) * 64 + lane] - sinf(a) * w1[(17 + k) * 64 + lane];
        }
        const float h1 = sinf(fr[lane] * acc);
        float acc2 = b2[lane];
#pragma unroll 8
        for (int k = 0; k < 64; ++k) acc2 += __shfl(h1, k) * w2[k * 64 + lane];
        P.h2tab[(size_t)idx * 64 + lane] = sinf(fr[64 + lane] * acc2);
    }
}

__device__ __forceinline__ void hf2_item(const Params& P, int id, u8* shm) {
    float* w3s = (float*)shm;
    float* red = w3s + 1024;
    const int tid = opaque_tid(), wid = tid >> 6, lane = tid & 63;
    const int cb = id & 127, o = (id >> 7) & 1, i = id >> 8;
    const float* w3 = P.in[19] + (size_t)i * 64 * 4096;
    __syncthreads();
#pragma unroll
    for (int j = 0; j < 2; ++j) { const int e = j * 512 + tid, k = e >> 4, col = e & 15; w3s[e] = w3[(size_t)k * 4096 + o * 2048 + (col >> 3) * 1024 + cb * 8 + (col & 7)]; }
    __syncthreads();
    float asum[8];
#pragma unroll
    for (int e = 0; e < 8; ++e) asum[e] = 0.f;
    u16* fb = P.filt + ((size_t)(i * 2 + o) * 1024 + cb * 8) * FS;
#pragma unroll 1
    for (int it = 0; it < 8; ++it) {
        asm volatile("" ::: "memory");
        const int t = it * 512 + tid;
        const float4* hp = (const float4*)(P.h2tab + ((size_t)i * 4096 + t) * 64);
        float acc[16];
#pragma unroll
        for (int c = 0; c < 16; ++c) acc[c] = 0.f;
#pragma unroll 1
        for (int k4 = 0; k4 < 16; ++k4) {
            const float4 hv = hp[k4];
#pragma unroll
            for (int kk = 0; kk < 4; ++kk) {
                const float hk = kk == 0 ? hv.x : kk == 1 ? hv.y : kk == 2 ? hv.z : hv.w;
                const float4* wr = (const float4*)(w3s + (k4 * 4 + kk) * 16);
                const float4 wa = wr[0], wb = wr[1], wc = wr[2], wd = wr[3];
                acc[0] += hk * wa.x; acc[1] += hk * wa.y; acc[2] += hk * wa.z; acc[3] += hk * wa.w;
                acc[4] += hk * wb.x; acc[5] += hk * wb.y; acc[6] += hk * wb.z; acc[7] += hk * wb.w;
                acc[8] += hk * wc.x; acc[9] += hk * wc.y; acc[10] += hk * wc.z; acc[11] += hk * wc.w;
                acc[12] += hk * wd.x; acc[13] += hk * wd.y; acc[14] += hk * wd.z; acc[15] += hk * wd.w;
            }
        }
        const float tn = (float)t / 4095.0f;
#pragma unroll
        for (int e = 0; e < 8; ++e) {
            const float delta = 3.0701134573253945f + (15.350567286626973f - 3.0701134573253945f) * ((float)(cb * 8 + e) / 1023.0f);
            const float dec = expf(-tn * delta);
            const float f = acc[e] * dec, bk = acc[8 + e] * dec;
            fb[(size_t)e * FS + 4096 - t] = f2bf(f);
            if (t >= 1) fb[(size_t)e * FS + 4096 + t] = f2bf(bk);
            asum[e] += fabsf(f) + (t >= 1 ? fabsf(bk) : 0.f);
        }
    }
    if (tid < 8 * 17) { const int e = tid / 17, j = tid % 17; fb[(size_t)e * FS + (j == 0 ? 0 : 8191 + j)] = 0; }
#pragma unroll
    for (int e = 0; e < 8; ++e) { const float s = wave_sum(asum[e]); if (lane == 0) red[wid * 8 + e] = s; }
    __syncthreads();
    if (tid < 8) { float s = 0.f; for (int w = 0; w < 8; ++w) s += red[w * 8 + tid]; P.invn[(i * 2 + o) * 1024 + cb * 8 + tid] = 1.0f / s; }
}

__device__ __forceinline__ void tr_tile(const u16* __restrict__ src, int src_ld, int col0, int nct, u16* __restrict__ dst, size_t ch_stride, size_t b_stride,
                                        const float* cw, const float* cb, int cw_ld, int tile, u8* shm) {
    unsigned* tl = (unsigned*)shm;
    const u16* tl16 = (const u16*)shm;
    const int tid = opaque_tid();
    const int ct = tile % nct, bs = tile / nct, st = bs & 63, b = bs >> 6, s0 = st * 64, c0 = ct * 64;
    {
        const int row = tid >> 3, chunk = tid & 7;
        const uint4 w = *(const uint4*)(src + (size_t)(b * L_ + s0 + row) * src_ld + col0 + c0 + chunk * 8);
        unsigned* d = tl + (row + 1) * 33 + chunk * 4; d[0] = w.x; d[1] = w.y; d[2] = w.z; d[3] = w.w;
        if (tid < 16) {
            const int hr = tid >> 3, s = hr ? s0 + 64 : s0 - 1;
            uint4 hw = make_uint4(0, 0, 0, 0);
            if (s >= 0 && s < L_) hw = *(const uint4*)(src + (size_t)(b * L_ + s) * src_ld + col0 + c0 + chunk * 8);
            unsigned* hd = tl + (hr ? 65 : 0) * 33 + chunk * 4; hd[0] = hw.x; hd[1] = hw.y; hd[2] = hw.z; hd[3] = hw.w;
        }
    }
    __syncthreads();
    {
        const int ch = tid >> 3, sc = tid & 7;
        float o[8];
        if (cw) {
            const float w0 = cw[c0 + ch], w1 = cw[cw_ld + c0 + ch], w2 = cw[2 * cw_ld + c0 + ch], bb = cb[c0 + ch];
            float r[10];
#pragma unroll
            for (int j = 0; j < 10; ++j) r[j] = bf2f(tl16[(sc * 8 + j) * 66 + ch]);
#pragma unroll
            for (int j = 0; j < 8; ++j) o[j] = w0 * r[j] + w1 * r[j + 1] + w2 * r[j + 2] + bb;
        } else {
#pragma unroll
            for (int j = 0; j < 8; ++j) o[j] = bf2f(tl16[(sc * 8 + j + 1) * 66 + ch]);
        }
        uint4 w; w.x = cvt_pk_bf16(o[0], o[1]); w.y = cvt_pk_bf16(o[2], o[3]); w.z = cvt_pk_bf16(o[4], o[5]); w.w = cvt_pk_bf16(o[6], o[7]);
        *(uint4*)(dst + (size_t)(c0 + ch) * ch_stride + (size_t)b * b_stride + s0 + sc * 8) = w;
    }
    __syncthreads();
}

__device__ __forceinline__ void trback_tile(const u16* __restrict__ yT, u16* __restrict__ y, int tile, u8* shm) {
    unsigned* tl = (unsigned*)shm;
    const u16* tl16 = (const u16*)shm;
    const int tid = opaque_tid();
    const int ct = tile & 15, bs = tile >> 4, st = bs & 63, b = bs >> 6, t0 = st * 64, c0 = ct * 64;
    {
        const int c = tid >> 3, chunk = tid & 7;
        const uint4 w = *(const uint4*)(yT + ((size_t)(c0 + c) * 4 + b) * L_ + t0 + chunk * 8);
        unsigned* d = tl + c * 33 + chunk * 4; d[0] = w.x; d[1] = w.y; d[2] = w.z; d[3] = w.w;
    }
    __syncthreads();
    {
        const int t = tid >> 3, cc = tid & 7;
        unsigned short e[8];
#pragma unroll
        for (int j = 0; j < 8; ++j) e[j] = tl16[(cc * 8 + j) * 66 + t];
        uint4 w; w.x = e[0] | ((unsigned)e[1] << 16); w.y = e[2] | ((unsigned)e[3] << 16); w.z = e[4] | ((unsigned)e[5] << 16); w.w = e[6] | ((unsigned)e[7] << 16);
        *(uint4*)(y + (size_t)(b * L_ + t0 + t) * D_ + 1024 + c0 + cc * 8) = w;
    }
    __syncthreads();
}

__device__ __forceinline__ void hconv_item(const Params& P, int i, int c, u8* shm) {
    u16* F0 = (u16*)shm; u16* F1 = F0 + FS; u16* U = F1 + FS; u16* Z = U + 4 * L_;
    const int tid = opaque_tid(), wid = tid >> 6, lane = tid & 63, n = lane & 15, quad = lane >> 4;
    __syncthreads();
    {
        const uint4* s0 = (const uint4*)(P.filt + ((size_t)(i * 2 + 0) * 1024 + c) * FS);
        const uint4* s1 = (const uint4*)(P.filt + ((size_t)(i * 2 + 1) * 1024 + c) * FS);
        for (int j = tid; j < FS / 8; j += 512) { ((uint4*)F0)[j] = s0[j]; ((uint4*)F1)[j] = s1[j]; }
        const uint4* su = (const uint4*)(P.pT + (size_t)c * 4 * L_);
#pragma unroll
        for (int j = 0; j < 4; ++j) ((uint4*)U)[j * 512 + tid] = su[j * 512 + tid];
    }
    __syncthreads();
    const float skip0 = P.in[21][(i * 2 + 0) * 1024 + c], skip1 = P.in[21][(i * 2 + 1) * 1024 + c];
    const float in0 = P.invn[(i * 2 + 0) * 1024 + c], in1 = P.invn[(i * 2 + 1) * 1024 + c];
    const int sh = (n & 1) * 16;
#pragma unroll 1
    for (int o = 0; o < 2; ++o) {
        const u16* Fo = o ? F1 : F0; const u16* Uo = o ? Z : U;
        f32x4 acc[4][2];
#pragma unroll
        for (int mt = 0; mt < 4; ++mt) { acc[mt][0] = (f32x4){0.f, 0.f, 0.f, 0.f}; acc[mt][1] = (f32x4){0.f, 0.f, 0.f, 0.f}; }
#pragma unroll 1
        for (int m = -63; m <= 63; ++m) {
            const int nt0 = 2 * wid, nt1 = 2 * wid + 1;
            const bool v0 = (4 * nt0 - m <= 63) && (4 * nt0 + 3 - m >= 0);
            const bool v1 = (4 * nt1 - m <= 63) && (4 * nt1 + 3 - m >= 0);
            if (!v0 && !v1) continue;
#pragma unroll
            for (int ks = 0; ks < 2; ++ks) {
                V8 bv[2];
#pragma unroll
                for (int nt = 0; nt < 2; ++nt) {
                    const int ii = 4 * (2 * wid + nt) + (n >> 2), b = n & 3, j = ii - m;
                    const bool ok = (unsigned)j < 64u;
                    bv[nt].q = *(const uint4*)(Uo + b * L_ + (ok ? j : 0) * 64 + 32 * ks + 8 * quad);
                    if (!ok) bv[nt].q = make_uint4(0, 0, 0, 0);
                }
#pragma unroll
                for (int mt = 0; mt < 4; ++mt) {
                    const int x0 = 4096 - 64 * m - (16 * mt + n) + 32 * ks + 8 * quad;
                    const unsigned* fp = (const unsigned*)(Fo + (x0 & ~1));
                    const unsigned d0 = fp[0], d1 = fp[1], d2 = fp[2], d3 = fp[3], d4 = fp[4];
                    V8 av;
                    av.u[0] = __builtin_amdgcn_alignbit(d1, d0, sh); av.u[1] = __builtin_amdgcn_alignbit(d2, d1, sh);
                    av.u[2] = __builtin_amdgcn_alignbit(d3, d2, sh); av.u[3] = __builtin_amdgcn_alignbit(d4, d3, sh);
                    if (v0) acc[mt][0] = MFMA16(av.v, bv[0].v, acc[mt][0]);
                    if (v1) acc[mt][1] = MFMA16(av.v, bv[1].v, acc[mt][1]);
                }
            }
        }
        const float sk = o ? skip1 : skip0, inn = o ? in1 : in0;
        const u16* gsrc = P.pT + ((size_t)((o ? 2048 : 1024) + c) * 4) * L_;
#pragma unroll
        for (int nt = 0; nt < 2; ++nt) {
            const int ii = 4 * (2 * wid + nt) + (n >> 2), b = n & 3;
#pragma unroll
            for (int mt = 0; mt < 4; ++mt) {
                const int t0 = 64 * ii + 16 * mt + 4 * quad;
                const u32x2 uu = *(const u32x2*)(Uo + b * L_ + t0);
                const u32x2 gg = *(const u32x2*)(gsrc + (size_t)b * L_ + t0);
                const float r0 = bflo(gg.x) * (acc[mt][nt][0] * inn + sk * bflo(uu.x));
                const float r1 = bfhi(gg.x) * (acc[mt][nt][1] * inn + sk * bfhi(uu.x));
                const float r2 = bflo(gg.y) * (acc[mt][nt][2] * inn + sk * bflo(uu.y));
                const float r3 = bfhi(gg.y) * (acc[mt][nt][3] * inn + sk * bfhi(uu.y));
                u32x2 w; w.x = cvt_pk_bf16(r0, r1); w.y = cvt_pk_bf16(r2, r3);
                if (o == 0) *(u32x2*)(Z + b * L_ + t0) = w;
                else *(u32x2*)(P.yT + ((size_t)c * 4 + b) * L_ + t0) = w;
            }
        }
        __syncthreads();
    }
}

__device__ __forceinline__ void gmlp_item(const Params& P, int i, int item, u8* shm) {
    float* rs = (float*)shm; u16* Ws = (u16*)(shm + 512); u16* Vt = Ws + 128 * 136;
    const int tid = opaque_tid(), wid = tid >> 6, lane = tid & 63, n = lane & 15, quad = lane >> 4;
    const int bc = item >> 1, gh = item & 1, tok0 = bc * 128;
    const u16* p = P.p;
    __syncthreads();
    {
        const int q = tid >> 2, part = tid & 3; float ss = 0.f;
        const uint4* vp = (const uint4*)(p + (size_t)(tok0 + q) * 5120 + 1024 + part * 256);
#pragma unroll 4
        for (int j = 0; j < 32; ++j) { const uint4 w = vp[j];
            ss += bflo(w.x) * bflo(w.x) + bfhi(w.x) * bfhi(w.x) + bflo(w.y) * bflo(w.y) + bfhi(w.y) * bfhi(w.y) + bflo(w.z) * bflo(w.z) + bfhi(w.z) * bfhi(w.z) + bflo(w.w) * bflo(w.w) + bfhi(w.w) * bfhi(w.w); }
        ss += __shfl_xor(ss, 1); ss += __shfl_xor(ss, 2);
        if (part == 0) rs[q] = rsqrtf(ss * (1.0f / 1024.0f) + 1e-6f);
    }
    __syncthreads();
    const float* gain = P.in[10] + i * 1024;
    for (int gi = 0; gi < 4; ++gi) {
        const int g = gh * 4 + gi;
        const float* ws = P.in[11] + ((size_t)(i * 8 + g)) * 16384;
#pragma unroll
        for (int j = 0; j < 8; ++j) { const int e4 = (j * 512 + tid) * 4; const float4 w = *(const float4*)(ws + e4); const int pp = e4 >> 7, qq = e4 & 127;
            u32x2 o; o.x = cvt_pk_bf16(w.x, w.y); o.y = cvt_pk_bf16(w.z, w.w); *(u32x2*)(Ws + pp * 136 + qq) = o; }
#pragma unroll
        for (int j = 0; j < 4; ++j) { const int id = j * 512 + tid, qq = id >> 4, dc = id & 15;
            const uint4 w = *(const uint4*)(p + (size_t)(tok0 + qq) * 5120 + 1024 + g * 128 + dc * 8);
            const float r = rs[qq]; const float* gp = gain + g * 128 + dc * 8;
            Vt[(dc * 8 + 0) * 136 + qq] = f2bf(bflo(w.x) * r * gp[0]); Vt[(dc * 8 + 1) * 136 + qq] = f2bf(bfhi(w.x) * r * gp[1]);
            Vt[(dc * 8 + 2) * 136 + qq] = f2bf(bflo(w.y) * r * gp[2]); Vt[(dc * 8 + 3) * 136 + qq] = f2bf(bfhi(w.y) * r * gp[3]);
            Vt[(dc * 8 + 4) * 136 + qq] = f2bf(bflo(w.z) * r * gp[4]); Vt[(dc * 8 + 5) * 136 + qq] = f2bf(bfhi(w.z) * r * gp[5]);
            Vt[(dc * 8 + 6) * 136 + qq] = f2bf(bflo(w.w) * r * gp[6]); Vt[(dc * 8 + 7) * 136 + qq] = f2bf(bfhi(w.w) * r * gp[7]); }
        __syncthreads();
        f32x4 acc[8];
#pragma unroll
        for (int dt = 0; dt < 8; ++dt) acc[dt] = (f32x4){0.f, 0.f, 0.f, 0.f};
#pragma unroll
        for (int ks = 0; ks < 4; ++ks) {
            const bf16x8 bfr = *(const bf16x8*)(Ws + (16 * wid + n) * 136 + 32 * ks + 8 * quad);
#pragma unroll
            for (int dt = 0; dt < 8; ++dt) { const bf16x8 afr = *(const bf16x8*)(Vt + (16 * dt + n) * 136 + 32 * ks + 8 * quad); acc[dt] = MFMA16(afr, bfr, acc[dt]); }
        }
        const int pp = 16 * wid + n;
        const float bsv = P.in[12][(i * 8 + g) * 128 + pp];
#pragma unroll
        for (int dt = 0; dt < 8; ++dt) {
            const int d = g * 128 + 16 * dt + 4 * quad;
            const u32x2 uu = *(const u32x2*)(p + (size_t)(tok0 + pp) * 5120 + d);
            u32x2 w; w.x = cvt_pk_bf16(bflo(uu.x) * (acc[dt][0] + bsv), bfhi(uu.x) * (acc[dt][1] + bsv)); w.y = cvt_pk_bf16(bflo(uu.y) * (acc[dt][2] + bsv), bfhi(uu.y) * (acc[dt][3] + bsv));
            *(u32x2*)(P.y + (size_t)(tok0 + pp) * D_ + d) = w;
        }
        __syncthreads();
    }
}

__device__ __forceinline__ void rotary_phase(const Params& P) {
    const int nth = gridDim.x * 512;
    for (int idx = blockIdx.x * 512 + opaque_tid(); idx < T_ * 4; idx += nth) {
        const int tok = idx >> 2, dq = idx & 3, pos = tok & 4095;
        float cs[8], sn[8];
#pragma unroll
        for (int e = 0; e < 8; ++e) { const float inv = exp2f(-(float)(dq * 8 + e) * 0.41524101186092029f); const float ang = (float)pos * inv; cs[e] = cosf(ang); sn[e] = sinf(ang); }
        u16* base = P.p + (size_t)tok * 6144 + 3072;
#pragma unroll 2
        for (int grp = 0; grp < 32; ++grp) {
            u16* gp = base + (grp >> 4) * 1024 + (grp & 15) * 64 + dq * 8;
            const float sc = (grp < 16) ? 0.125f * 1.4426950408889634f : 1.0f;
            const uint4 a = *(const uint4*)gp, b = *(const uint4*)(gp + 32);
            const unsigned aw[4] = {a.x, a.y, a.z, a.w}, bw[4] = {b.x, b.y, b.z, b.w};
            unsigned oa[4], ob[4];
#pragma unroll
            for (int j = 0; j < 4; ++j) {
                const float x1l = bflo(aw[j]), x1h = bfhi(aw[j]), x2l = bflo(bw[j]), x2h = bfhi(bw[j]);
                oa[j] = cvt_pk_bf16((x1l * cs[2 * j] - x2l * sn[2 * j]) * sc, (x1h * cs[2 * j + 1] - x2h * sn[2 * j + 1]) * sc);
                ob[j] = cvt_pk_bf16((x1l * sn[2 * j] + x2l * cs[2 * j]) * sc, (x1h * sn[2 * j + 1] + x2h * cs[2 * j + 1]) * sc);
            }
            *(uint4*)gp = make_uint4(oa[0], oa[1], oa[2], oa[3]); *(uint4*)(gp + 32) = make_uint4(ob[0], ob[1], ob[2], ob[3]);
        }
    }
}

__device__ __forceinline__ void nattn_witem(const Params& P, int io, int id) {
    const int lane = opaque_tid() & 63, n = lane & 15, quad = lane >> 4;
    const int qb = id & 3, h = (id >> 2) & 7, r = (id >> 5) & 63, b = id >> 11;
    const int rs = min(max(r - 4, 0), 56);
    const int cw = qb == 0 ? 0 : qb == 1 ? 8 : qb == 2 ? 24 : 32;
    const int c = 16 * qb + n, cs = min(max(c - 8, 0), 48);
    const u16* pb = P.p + (size_t)b * L_ * 6144;
    bf16x8 qf[4];
#pragma unroll
    for (int ks = 0; ks < 4; ++ks) qf[ks] = *(const bf16x8*)(pb + (size_t)(r * 64 + c) * 6144 + h * 128 + 32 * ks + 8 * quad);
    f32x4 S[16];
#pragma unroll
    for (int kt = 0; kt < 16; ++kt) {
        const int kr = kt >> 1, ct = kt & 1;
        const u16* kp = pb + (size_t)((rs + kr) * 64 + cw + 16 * ct + n) * 6144 + 1024 + h * 128 + 8 * quad;
        f32x4 acc = (f32x4){0.f, 0.f, 0.f, 0.f};
#pragma unroll
        for (int ks = 0; ks < 4; ++ks) { const bf16x8 kf = *(const bf16x8*)(kp + 32 * ks); acc = MFMA16(kf, qf[ks], acc); }
        S[kt] = acc;
    }
    const float* rp = P.in[23] + (size_t)(io * 8 + h) * 15 * 31;
    float mx = -1e30f;
#pragma unroll
    for (int kt = 0; kt < 16; ++kt) {
        const int kr = kt >> 1, ct = kt & 1, relr = rs + kr - r + 7;
#pragma unroll
        for (int j = 0; j < 4; ++j) {
            const int kc = cw + 16 * ct + 4 * quad + j; const bool valid = (kc >= cs) && (kc < cs + 16);
            const int relc = min(max(kc - c + 15, 0), 30);
            const float v = valid ? S[kt][j] * 0.08838834764831845f + rp[relr * 31 + relc] : -1e30f;
            S[kt][j] = v; mx = fmaxf(mx, v);
        }
    }
    mx = fmaxf(mx, __shfl_xor(mx, 16)); mx = fmaxf(mx, __shfl_xor(mx, 32));
    float sum = 0.f;
#pragma unroll
    for (int kt = 0; kt < 16; ++kt)
#pragma unroll
        for (int j = 0; j < 4; ++j) { const float v = S[kt][j]; const float e = (v > -1e29f) ? __expf(v - mx) : 0.f; S[kt][j] = e; sum += e; }
    sum += __shfl_xor(sum, 16); sum += __shfl_xor(sum, 32);
    f32x4 O[8];
#pragma unroll
    for (int dt = 0; dt < 8; ++dt) O[dt] = (f32x4){0.f, 0.f, 0.f, 0.f};
    const u16* vb = P.vcT + ((size_t)(b * 8 + h) * 128) * L_;
#pragma unroll
    for (int kr = 0; kr < 8; ++kr) {
        V8 pf; pf.u[0] = cvt_pk_bf16(S[2 * kr][0], S[2 * kr][1]); pf.u[1] = cvt_pk_bf16(S[2 * kr][2], S[2 * kr][3]);
        pf.u[2] = cvt_pk_bf16(S[2 * kr + 1][0], S[2 * kr + 1][1]); pf.u[3] = cvt_pk_bf16(S[2 * kr + 1][2], S[2 * kr + 1][3]);
        const int tok0 = (rs + kr) * 64 + cw + 4 * quad;
#pragma unroll
        for (int dt = 0; dt < 8; ++dt) {
            const u16* vp = vb + (size_t)(16 * dt + n) * L_ + tok0;
            const u32x2 lo = *(const u32x2*)vp, hi = *(const u32x2*)(vp + 16);
            V8 av; av.u[0] = lo.x; av.u[1] = lo.y; av.u[2] = hi.x; av.u[3] = hi.y;
            O[dt] = MFMA16(av.v, pf.v, O[dt]);
        }
    }
    const float inv = 1.0f / sum;
    u16* yp = P.y + (size_t)(b * L_ + r * 64 + c) * D_ + h * 128 + 4 * quad;
#pragma unroll
    for (int dt = 0; dt < 8; ++dt) { u32x2 w; w.x = cvt_pk_bf16(O[dt][0] * inv, O[dt][1] * inv); w.y = cvt_pk_bf16(O[dt][2] * inv, O[dt][3] * inv); *(u32x2*)(yp + 16 * dt) = w; }
}

__device__ __forceinline__ void dattn_item(const Params& P, int io, float lam_init, int item, u8* shm) {
    const int tid = opaque_tid(), wid = tid >> 6, lane = tid & 63, l31 = lane & 31, kh = lane >> 5, mw = wid >> 2, qw = wid & 3;
    const int qb = item & 31, h = (item >> 5) & 7, b = item >> 8;
    const float* lp = P.in[24] + io * 256;
    const float sa = wave_sum(lp[lane] * lp[64 + lane]), sc = wave_sum(lp[128 + lane] * lp[192 + lane]);
    const float lam = expf(sa) - expf(sc) + lam_init;
    const int tq = qb * 128 + 32 * qw + l31;
    const u16* pb = P.p + (size_t)b * L_ * 6144;
    const u16* qrow = pb + (size_t)tq * 6144 + 3072 + h * 128 + mw * 64;
    bf16x8 qf[4];
#pragma unroll
    for (int ks = 0; ks < 4; ++ks) qf[ks] = *(const bf16x8*)(qrow + 16 * ks + 8 * kh);
    f32x16 O[4];
#pragma unroll
    for (int dt = 0; dt < 4; ++dt)
#pragma unroll
        for (int r = 0; r < 16; ++r) O[dt][r] = 0.f;
    float mrun = -1e30f, lrun = 0.f;
    u16* Ks = (u16*)shm; u16* Vs = Ks + 2 * 64 * 72;
    const u16* vb = P.vdT + ((size_t)(b * 8 + h) * 128) * L_;
#pragma unroll 1
    for (int kt = 0; kt < 64; ++kt) {
        __syncthreads();
#pragma unroll
        for (int j = 0; j < 2; ++j) { const int row = tid >> 3, ch = tid & 7;
            const uint4 w = *(const uint4*)(pb + (size_t)(kt * 64 + row) * 6144 + 4096 + h * 128 + j * 64 + ch * 8);
            *(uint4*)(Ks + (j * 64 + row) * 72 + ch * 8) = w; }
#pragma unroll
        for (int j = 0; j < 2; ++j) { const int id = j * 512 + tid, d = id >> 3, ch = id & 7;
            const uint4 w = *(const uint4*)(vb + (size_t)d * L_ + kt * 64 + ch * 8);
            *(uint4*)(Vs + d * 72 + ch * 8) = w; }
        __syncthreads();
        f32x16 s0, s1;
#pragma unroll
        for (int r = 0; r < 16; ++r) { s0[r] = 0.f; s1[r] = 0.f; }
#pragma unroll
        for (int ks = 0; ks < 4; ++ks) {
            const bf16x8 a0 = *(const bf16x8*)(Ks + (mw * 64 + l31) * 72 + 16 * ks + 8 * kh);
            const bf16x8 a1 = *(const bf16x8*)(Ks + (mw * 64 + 32 + l31) * 72 + 16 * ks + 8 * kh);
            s0 = MFMA32(a0, qf[ks], s0); s1 = MFMA32(a1, qf[ks], s1);
        }
        float mx = s0[0];
#pragma unroll
        for (int r = 0; r < 16; ++r) { mx = fmaxf(mx, s0[r]); mx = fmaxf(mx, s1[r]); }
        mx = fmaxf(mx, __shfl_xor(mx, 32));
        const float mnew = fmaxf(mrun, mx), alpha = exp2f(mrun - mnew);
        float ps = 0.f;
#pragma unroll
        for (int r = 0; r < 16; ++r) { s0[r] = exp2f(s0[r] - mnew); s1[r] = exp2f(s1[r] - mnew); ps += s0[r] + s1[r]; }
        ps += __shfl_xor(ps, 32);
        lrun = lrun * alpha + ps; mrun = mnew;
#pragma unroll
        for (int dt = 0; dt < 4; ++dt)
#pragma unroll
            for (int r = 0; r < 16; ++r) O[dt][r] *= alpha;
        V8 pf[2][2];
#pragma unroll
        for (int ip = 0; ip < 2; ++ip)
#pragma unroll
            for (int j = 0; j < 4; ++j) { pf[0][ip].u[j] = cvt_pk_bf16(s0[8 * ip + 2 * j], s0[8 * ip + 2 * j + 1]); pf[1][ip].u[j] = cvt_pk_bf16(s1[8 * ip + 2 * j], s1[8 * ip + 2 * j + 1]); }
#pragma unroll
        for (int tt = 0; tt < 2; ++tt)
#pragma unroll
            for (int ip = 0; ip < 2; ++ip) {
                const int keybase = 32 * tt + 16 * ip + 4 * kh;
#pragma unroll
                for (int dt = 0; dt < 4; ++dt) {
                    const u16* vp = Vs + (32 * dt + l31) * 72 + keybase;
                    const u32x2 lo = *(const u32x2*)vp, hi = *(const u32x2*)(vp + 8);
                    V8 av; av.u[0] = lo.x; av.u[1] = lo.y; av.u[2] = hi.x; av.u[3] = hi.y;
                    O[dt] = MFMA32(av.v, pf[tt][ip].v, O[dt]);
                }
            }
    }
    __syncthreads();
    float* comb = (float*)shm;
    const float inv = 1.0f / lrun;
    if (mw == 1) {
#pragma unroll
        for (int dt = 0; dt < 4; ++dt)
#pragma unroll
            for (int i4 = 0; i4 < 4; ++i4) {
                const int d = 32 * dt + 8 * i4 + 4 * kh;
                *(float4*)(comb + (32 * qw + l31) * 132 + d) = make_float4(O[dt][4 * i4] * inv, O[dt][4 * i4 + 1] * inv, O[dt][4 * i4 + 2] * inv, O[dt][4 * i4 + 3] * inv);
            }
    }
    __syncthreads();
    if (mw == 0) {
        float ss = 0.f;
#pragma unroll
        for (int dt = 0; dt < 4; ++dt)
#pragma unroll
            for (int i4 = 0; i4 < 4; ++i4) {
                const int d = 32 * dt + 8 * i4 + 4 * kh;
                const float4 o1 = *(const float4*)(comb + (32 * qw + l31) * 132 + d);
                const float a0 = O[dt][4 * i4] * inv - lam * o1.x, a1 = O[dt][4 * i4 + 1] * inv - lam * o1.y, a2 = O[dt][4 * i4 + 2] * inv - lam * o1.z, a3 = O[dt][4 * i4 + 3] * inv - lam * o1.w;
                O[dt][4 * i4] = a0; O[dt][4 * i4 + 1] = a1; O[dt][4 * i4 + 2] = a2; O[dt][4 * i4 + 3] = a3;
                ss += a0 * a0 + a1 * a1 + a2 * a2 + a3 * a3;
            }
        ss += __shfl_xor(ss, 32);
        const float rstd = rsqrtf(ss * (1.0f / 128.0f) + 1e-6f) * (1.0f - lam_init);
        const float* sg = P.in[25] + io * 128;
        u16* yp = P.y + (size_t)(b * L_ + tq) * D_ + 1024 + h * 128;
#pragma unroll
        for (int dt = 0; dt < 4; ++dt)
#pragma unroll
            for (int i4 = 0; i4 < 4; ++i4) {
                const int d = 32 * dt + 8 * i4 + 4 * kh;
                const float4 g4 = *(const float4*)(sg + d);
                u32x2 w; w.x = cvt_pk_bf16(O[dt][4 * i4] * rstd * g4.x, O[dt][4 * i4 + 1] * rstd * g4.y); w.y = cvt_pk_bf16(O[dt][4 * i4 + 2] * rstd * g4.z, O[dt][4 * i4 + 3] * rstd * g4.w);
                *(u32x2*)(yp + d) = w;
            }
    }
}

__device__ __forceinline__ void cg_phase(const Params& P, int l) {
    const float* cw = P.in[5] + (size_t)l * 3 * F2_; const float* cb = P.in[6] + (size_t)l * F2_;
    const int nth = gridDim.x * 512;
    for (int idx = blockIdx.x * 512 + opaque_tid(); idx < 1024 * 704; idx += nth) {
        const int chunk = idx % 704, tb = idx / 704, f0 = chunk * 8, t0 = tb * 16, s0 = t0 & 4095;
        float wg[3][8], wv[3][8], bg[8], bv[8];
#pragma unroll
        for (int k = 0; k < 3; ++k)
#pragma unroll
            for (int e4 = 0; e4 < 2; ++e4) {
                const float4 a = *(const float4*)(cw + k * F2_ + f0 + e4 * 4), b = *(const float4*)(cw + k * F2_ + F_ + f0 + e4 * 4);
                wg[k][e4 * 4] = a.x; wg[k][e4 * 4 + 1] = a.y; wg[k][e4 * 4 + 2] = a.z; wg[k][e4 * 4 + 3] = a.w;
                wv[k][e4 * 4] = b.x; wv[k][e4 * 4 + 1] = b.y; wv[k][e4 * 4 + 2] = b.z; wv[k][e4 * 4 + 3] = b.w;
            }
#pragma unroll
        for (int e4 = 0; e4 < 2; ++e4) {
            const float4 a = *(const float4*)(cb + f0 + e4 * 4), b = *(const float4*)(cb + F_ + f0 + e4 * 4);
            bg[e4 * 4] = a.x; bg[e4 * 4 + 1] = a.y; bg[e4 * 4 + 2] = a.z; bg[e4 * 4 + 3] = a.w;
            bv[e4 * 4] = b.x; bv[e4 * 4 + 1] = b.y; bv[e4 * 4 + 2] = b.z; bv[e4 * 4 + 3] = b.w;
        }
        const u16* ub = P.up + (size_t)t0 * F2_ + f0;
        const uint4 zero = make_uint4(0, 0, 0, 0);
        uint4 pg = zero, pv = zero;
        if (s0 > 0) { pg = *(const uint4*)(ub - F2_); pv = *(const uint4*)(ub - F2_ + F_); }
        uint4 cg_ = *(const uint4*)ub, cv = *(const uint4*)(ub + F_);
#pragma unroll 1
        for (int r = 0; r < 16; ++r) {
            uint4 ng = zero, nv = zero;
            if (s0 + r + 1 < L_) { ng = *(const uint4*)(ub + (size_t)(r + 1) * F2_); nv = *(const uint4*)(ub + (size_t)(r + 1) * F2_ + F_); }
            const unsigned a0[4] = {pg.x, pg.y, pg.z, pg.w}, a1[4] = {cg_.x, cg_.y, cg_.z, cg_.w}, a2[4] = {ng.x, ng.y, ng.z, ng.w};
            const unsigned c0[4] = {pv.x, pv.y, pv.z, pv.w}, c1[4] = {cv.x, cv.y, cv.z, cv.w}, c2[4] = {nv.x, nv.y, nv.z, nv.w};
            unsigned ow[4];
#pragma unroll
            for (int j = 0; j < 4; ++j) {
                const float gl = wg[0][2 * j] * bflo(a0[j]) + wg[1][2 * j] * bflo(a1[j]) + wg[2][2 * j] * bflo(a2[j]) + bg[2 * j];
                const float gh = wg[0][2 * j + 1] * bfhi(a0[j]) + wg[1][2 * j + 1] * bfhi(a1[j]) + wg[2][2 * j + 1] * bfhi(a2[j]) + bg[2 * j + 1];
                const float vl = wv[0][2 * j] * bflo(c0[j]) + wv[1][2 * j] * bflo(c1[j]) + wv[2][2 * j] * bflo(c2[j]) + bv[2 * j];
                const float vh = wv[0][2 * j + 1] * bfhi(c0[j]) + wv[1][2 * j + 1] * bfhi(c1[j]) + wv[2][2 * j + 1] * bfhi(c2[j]) + bv[2 * j + 1];
                const float ol = gl / (1.0f + __expf(-gl)) * vl, oh = gh / (1.0f + __expf(-gh)) * vh;
                ow[j] = cvt_pk_bf16(ol, oh);
            }
            *(uint4*)(P.gated + (size_t)(t0 + r) * F_ + f0) = make_uint4(ow[0], ow[1], ow[2], ow[3]);
            pg = cg_; pv = cv; cg_ = ng; cv = nv;
        }
    }
}

__device__ __forceinline__ void run_step(const Params& P, int step, u8* shm) {
#ifdef ONLY_OP
    const int op = ONLY_OP, l = P.lyr[step], i = l >> 1;
#else
    const int op = P.ops[step], l = P.lyr[step], i = l >> 1;
#endif
    PG8_LAS u8* lds = (PG8_LAS u8*)shm;
    switch (op) {
    case OP_PRE: {
        const int total = P.cw_t0[16];
        for (int tile = blockIdx.x; tile < total; tile += gridDim.x) {
            int mi = 0;
#pragma unroll 1
            for (int k = 1; k < 16; ++k) if (tile >= P.cw_t0[k]) mi = k;
            convT_tile(P.cw_src[mi], P.cw_K[mi], P.cw_N[mi], P.cw_dst[mi], tile - P.cw_t0[mi], shm);
        }
        hf1_phase(P);
        norm_phase(P.in[0], P.in[1], P.h, nullptr);
    } break;
    case OP_HF2: {
        for (int id = blockIdx.x; id < 512; id += gridDim.x) hf2_item(P, id, shm);
    } break;
    case OP_NORM: {
        const int which = P.arg[step];
        if (which == 0) norm_phase(P.x, P.in[1] + l * D_, P.h, nullptr);
        else if (which == 1) norm_phase(P.x, P.in[2] + l * D_, P.h, nullptr);
        else norm_phase(P.x, P.in[8], nullptr, P.x);
    } break;
    case OP_GEMM_IN: {
        const int N = (l & 1) ? 6144 : 5120;
        pg8::Gemm g{P.h, P.wt_in[l], T_, N, D_};
        pg8::StaticOrder S; S.init(T_, N, gridDim.x, blockIdx.x);
        EpiStoreBf16 E{P.p, N, (l & 1) ? 0 : 2048};
        pg8::gemm_phase<EpiStoreBf16, pg8::StaticOrder, false>(lds, g, S, E, nullptr);
    } break;
    case OP_GEMM_UP: {
        pg8::Gemm g{P.h, P.wt_up[l], T_, F2_, D_};
        pg8::StaticOrder S; S.init(T_, F2_, gridDim.x, blockIdx.x);
        EpiStoreBf16 E{P.up, F2_, 0};
        pg8::gemm_phase<EpiStoreBf16, pg8::StaticOrder, false>(lds, g, S, E, nullptr);
    } break;
    case OP_GEMM_OUT: {
        pg8::Gemm g{P.y, P.wt_out[l], T_, D_, D_};
        pg8::StaticOrder S; S.init(T_, D_, gridDim.x, blockIdx.x);
        EpiResid E{l == 0 ? P.in[0] : P.x, P.x};
        pg8::gemm_phase<EpiResid, pg8::StaticOrder, false>(lds, g, S, E, nullptr);
    } break;
    case OP_GEMM_DOWN: {
        pg8::Gemm g{P.gated, P.wt_down[l], T_, D_, F_};
        pg8::StaticOrder S; S.init(T_, D_, gridDim.x, blockIdx.x);
        EpiResid E{P.x, P.x};
        pg8::gemm_phase<EpiResid, pg8::StaticOrder, false>(lds, g, S, E, nullptr);
    } break;
    case OP_EVEN_A: {
        for (int it = blockIdx.x; it < 256; it += gridDim.x) gmlp_item(P, i, it, shm);
        for (int tile = blockIdx.x; tile < 48 * 256; tile += gridDim.x)
            tr_tile(P.p, 5120, 2048, 48, P.pT, (size_t)4 * L_, (size_t)L_, P.in[13] + (size_t)i * 3 * 3072, P.in[14] + (size_t)i * 3072, 3072, tile, shm);
    } break;
    case OP_HC: {
        for (int c = blockIdx.x; c < 1024; c += gridDim.x) hconv_item(P, i, c, shm);
    } break;
    case OP_HB: {
        for (int tile = blockIdx.x; tile < 4096; tile += gridDim.x) trback_tile(P.yT, P.y, tile, shm);
    } break;
    case OP_ODD_PREP: {
        rotary_phase(P);
        for (int tile = blockIdx.x; tile < 16 * 256; tile += gridDim.x)
            tr_tile(P.p, 6144, 2048, 16, P.vcT, (size_t)L_, (size_t)1024 * L_, nullptr, nullptr, 0, tile, shm);
        for (int tile = blockIdx.x; tile < 16 * 256; tile += gridDim.x)
            tr_tile(P.p, 6144, 5120, 16, P.vdT, (size_t)L_, (size_t)1024 * L_, nullptr, nullptr, 0, tile, shm);
    } break;
    case OP_ATTN: {
        const float lam_init = 0.8f - 0.6f * expf(-0.3f * (float)l);
        for (int it = blockIdx.x; it < 1024; it += gridDim.x) dattn_item(P, i, lam_init, it, shm);
        const int wid = opaque_tid() >> 6;
        for (int id = blockIdx.x * 8 + wid; id < 8192; id += gridDim.x * 8) nattn_witem(P, i, id);
    } break;
    case OP_CG: cg_phase(P, l); break;

    }
}

#if MEGA
__global__ __launch_bounds__(512, 2) void k_mega(Params P) {
    extern __shared__ __attribute__((aligned(16))) u8 shm[];
    cg::grid_group grid = cg::this_grid();
    for (int s = 0; s < P.nsteps; ++s) {
        run_step(P, s, shm);
        if (s + 1 < P.nsteps) grid.sync();
    }
}
#else
__global__ __launch_bounds__(512, 2) void k_step(Params P, int step) {
    extern __shared__ __attribute__((aligned(16))) u8 shm[];
    run_step(P, step, shm);
}
#endif

extern "C" void kernel_launch(void* const* d_in, const int* in_sizes, int n_in, void* d_out, int out_size, void* d_ws, size_t ws_size, hipStream_t stream) {
    Params P; std::memset((void*)&P, 0, sizeof(P));
    for (int k = 0; k < 26; ++k) P.in[k] = (const float*)d_in[k];
    P.x = (float*)d_out;
    char* ws = (char*)d_ws; size_t off = 0;
    auto take = [&](size_t bytes) { char* r = ws + off; off += (bytes + 255) & ~(size_t)255; return r; };
    int nm = 0, t0 = 0;
    auto addw = [&](const float* src, int K, int N, u16* dst) { P.cw_src[nm] = src; P.cw_dst[nm] = dst; P.cw_K[nm] = K; P.cw_N[nm] = N; P.cw_t0[nm] = t0; t0 += (K / 64) * (N / 256); ++nm; };
    for (int l = 0; l < 4; ++l) {
        const int N = (l & 1) ? 6144 : 5120, i = l >> 1;
        P.wt_in[l] = (u16*)take((size_t)N * D_ * 2);
        P.wt_out[l] = (u16*)take((size_t)D_ * D_ * 2);
        P.wt_up[l] = (u16*)take((size_t)F2_ * D_ * 2);
        P.wt_down[l] = (u16*)take((size_t)D_ * F_ * 2);
        addw(((l & 1) ? P.in[22] : P.in[9]) + (size_t)i * D_ * N, D_, N, P.wt_in[l]);
        addw(P.in[3] + (size_t)l * D_ * D_, D_, D_, P.wt_out[l]);
        addw(P.in[4] + (size_t)l * D_ * F2_, D_, F2_, P.wt_up[l]);
        addw(P.in[7] + (size_t)l * F_ * D_, F_, D_, P.wt_down[l]);
    }
    P.cw_t0[16] = t0; P.cw_t0[17] = 0;
    P.h = (u16*)take((size_t)T_ * D_ * 2);
    P.y = (u16*)take((size_t)T_ * D_ * 2);
    char* r1 = take((size_t)T_ * F2_ * 2);
    P.up = (u16*)r1; P.p = (u16*)r1;
    P.pT = (u16*)(r1 + (size_t)T_ * 6144 * 2); P.yT = (u16*)(r1 + (size_t)T_ * 6144 * 2 + (size_t)3072 * T_ * 2);
    P.vcT = (u16*)(r1 + (size_t)T_ * 6144 * 2); P.vdT = (u16*)(r1 + (size_t)T_ * 6144 * 2 + (size_t)1024 * T_ * 2);
    P.gated = (u16*)take((size_t)T_ * F_ * 2);
    P.filt = (u16*)take((size_t)4096 * FS * 2);
    P.invn = (float*)take(4096 * 4);
    P.h2tab = (float*)take((size_t)2 * L_ * 64 * 4);
    if (off > ws_size) { fprintf(stderr, "workspace too small: need %zu have %zu\n", off, ws_size); }
    int ns = 0;
    auto add = [&](int op, int l, int a) { P.ops[ns] = op; P.lyr[ns] = l; P.arg[ns] = a; ++ns; };
    add(OP_PRE, 0, 0); add(OP_HF2, 0, 0);
    for (int l = 0; l < 4; ++l) {
        add(OP_GEMM_IN, l, 0);
        if ((l & 1) == 0) { add(OP_EVEN_A, l, 0); add(OP_HC, l, 0); add(OP_HB, l, 0); }
        else { add(OP_ODD_PREP, l, 0); add(OP_ATTN, l, 0); }
        add(OP_GEMM_OUT, l, 0); add(OP_NORM, l, 1); add(OP_GEMM_UP, l, 0); add(OP_CG, l, 0); add(OP_GEMM_DOWN, l, 0);
        if (l < 3) add(OP_NORM, l + 1, 0); else add(OP_NORM, l, 2);
    }
    P.nsteps = ns;
#if MEGA
    static int grid_blocks = 0;
    if (!grid_blocks) {
        (void)hipFuncSetAttribute((const void*)k_mega, hipFuncAttributeMaxDynamicSharedMemorySize, LDS_BYTES);
        int dev = 0, cus = 0, per_cu = 0;
        (void)hipGetDevice(&dev);
        (void)hipDeviceGetAttribute(&cus, hipDeviceAttributeMultiprocessorCount, dev);
        (void)hipOccupancyMaxActiveBlocksPerMultiprocessor(&per_cu, k_mega, 512, LDS_BYTES);
        if (per_cu < 1) per_cu = 1;
        grid_blocks = cus * 1;
    }
    void* args[] = {&P};
    hipError_t e = hipLaunchCooperativeKernel((void*)k_mega, dim3(grid_blocks), dim3(512), args, LDS_BYTES, stream);
    if (e != hipSuccess) fprintf(stderr, "cooperative launch failed: %s (grid %d)\n", hipGetErrorString(e), grid_blocks);
#else
    static int inited = 0;
    if (!inited) { (void)hipFuncSetAttribute((const void*)k_step, hipFuncAttributeMaxDynamicSharedMemorySize, LDS_BYTES); inited = 1; }
    for (int s = 0; s < ns; ++s) k_step<<<256, 512, LDS_BYTES, stream>>>(P, s);
#endif
}
```

```cpp
#include <hip/hip_runtime.h>
#include <hip/hip_cooperative_groups.h>
#include <cstdio>
#include <cstring>
namespace cg = cooperative_groups;
#ifndef MEGA
#define MEGA 1
#endif
__device__ __forceinline__ int opaque_tid() { int t = (int)threadIdx.x; asm volatile("" : "+v"(t)); return t; }
namespace pg8 {
#define PG8_LAS __attribute__((address_space(3)))
typedef unsigned short bf16_t;
typedef short bf16x8 __attribute__((ext_vector_type(8)));
typedef float f32x4 __attribute__((ext_vector_type(4)));
typedef unsigned u32x4 __attribute__((ext_vector_type(4)));
constexpr int BM = 256, BK = 64, HALF = 128, HTB = HALF * BK * 2  , STAGE_BYTES = 8 * HTB, NXCD = 8, WGM = 8;

__host__ __device__ __forceinline__ int lds_byte(int r, int c) { const int st = (r >> 4) * 2 + (c >> 5), rr = r & 15, cc = c & 31, ob = rr * 64 + cc * 2; return st * 1024 + (ob ^ (((ob >> 9) & 1) << 5)); }
__host__ __device__ __forceinline__ void stage_rc(int b, int& R, int& C) { const int st = b / 1024, sb = b % 1024, swz = sb ^ (((sb >> 9) & 1) << 5); R = (st >> 1) * 16 + swz / 64; C = (st & 1) * 32 + (swz % 64) / 2; }
__host__ __device__ __forceinline__ int perm32(int rho) { const int n = rho >> 4, i = rho & 15; return 8 * (i >> 2) + 4 * n + (i & 3); }

struct Unit { int pm, pn; };
struct Gemm { const bf16_t* A; const bf16_t* Bt; int M, N, K; };

struct StaticOrder {
    int nM, nN, nwg, G, c;
    __host__ __device__ void init(int M, int N, int G_, int c_) { nM = M / BM; nN = N / BM; nwg = nM * nN; G = G_; c = c_; }
    __host__ __device__ bool next(int i, Unit& u) const {
        const long L = (long)i * G + c; if (L >= nwg) return false;
        int wgid = (int)L; { const int q = nwg / NXCD, r = nwg % NXCD, xcd = wgid % NXCD, off = wgid / NXCD; wgid = (xcd < r ? xcd * (q + 1) : r * (q + 1) + (xcd - r) * q) + off; }
        const int nig = WGM * nN, gid = wgid / nig, fm = gid * WGM, gsz = (nM - fm) < WGM ? (nM - fm) : WGM;
        u.pm = fm + ((wgid % nig) % gsz); u.pn = (wgid % nig) / gsz; return true;
    }
    __device__ __forceinline__ void a_ready(const Unit&) const {}
    __device__ __forceinline__ void done(const Unit&) const {}
};
typedef __bf16 bf16x2_cv __attribute__((ext_vector_type(2)));
typedef float f32x2_cv __attribute__((ext_vector_type(2)));
__device__ __forceinline__ unsigned cvt_pk_bf16(float lo, float hi) { f32x2_cv f = {lo, hi}; bf16x2_cv b = __builtin_convertvector(f, bf16x2_cv); return __builtin_bit_cast(unsigned, b); }
typedef float f32x2 __attribute__((ext_vector_type(2)));
__device__ __forceinline__ f32x2 gelu_pk(f32x2 v) {
    const f32x2 av = __builtin_elementwise_abs(v), d = av * 0.2316418882f + 1.0f;
    f32x2 t; t.x = __builtin_amdgcn_rcpf(d.x); t.y = __builtin_amdgcn_rcpf(d.y);
    f32x2 q = t * 0.5307027145f + (-0.7265760135f); q = q * t + 0.7107068705f; q = q * t + (-0.142248368f); q = q * t + 0.127414796f; q = q * t;
    const f32x2 s = (v * v) * (-0.72134752044f);
    f32x2 e; e.x = __builtin_amdgcn_exp2f(s.x); e.y = __builtin_amdgcn_exp2f(s.y);
    const f32x2 m = v * (q * e), r = v - m;
    f32x2 o; o.x = v.x < 0.f ? m.x : r.x; o.y = v.y < 0.f ? m.y : r.y; return o;
}

template <class Epi, class Sched, bool STAMP = false>
__device__ __forceinline__ void gemm_phase(PG8_LAS unsigned char* lds, const Gemm g, const Sched& S, const Epi& E, unsigned long long* stamps) {
    const int tid = opaque_tid(), wid = __builtin_amdgcn_readfirstlane(tid >> 6), lane = tid & 63, wr = wid >> 2, wc = wid & 3, fr = lane & 15, fq = lane >> 4;
    const int K = g.K, nt = K / BK;
    int ts_lo = 0, ts_hi = 0, nts = 0; const unsigned long long rt_entry = STAMP ? (unsigned long long)wall_clock64() : 0ull;
#define PG8_STAMP() do { if (STAMP && wid == 0 && nts < 64) { const unsigned long long _c = (unsigned long long)clock64(); \
        ts_lo = (lane == nts) ? (int)(unsigned)_c : ts_lo; ts_hi = (lane == nts) ? (int)(unsigned)(_c >> 32) : ts_hi; ++nts; } } while (0)
    PG8_STAMP();
    unsigned voffA[2], voffB[2];
#pragma unroll
    for (int i = 0; i < 2; ++i) { int R, C; stage_rc(tid * 16 + i * 8192, R, C); const int Rb = Epi::PERM ? ((R & ~31) + perm32(R & 31)) : R;
        voffA[i] = (unsigned)(R * K + C) * 2u; voffB[i] = (unsigned)(Rb * K + C) * 2u; }
    const size_t kstep = (size_t)(BK * 2);
    const size_t hstep = (size_t)HALF * K * 2;
    const size_t tstep = 2 * hstep;
    const unsigned ldsw = (unsigned)wid * 1024u;
    const int aoff = lds_byte(wr * 64 + fr, fq * 8), boff = lds_byte(wc * 32 + fr, fq * 8);
#define PG8_SA(b, h) (((b) * 2 + (h)) * HTB)
#define PG8_SB(b, h) ((4 + (b) * 2 + (h)) * HTB)
#define PG8_STAGE(bufoff, gbase, voff) do { _Pragma("unroll") for (int _i = 0; _i < 2; ++_i) \
        __builtin_amdgcn_global_load_lds((const unsigned*)((const char*)(gbase) + (voff)[_i]), (PG8_LAS unsigned*)(lds + (bufoff) + ldsw + _i * 8192), 16, 0, 0); } while (0)
#define PG8_LDA(dst, b, h) do { _Pragma("unroll") for (int m = 0; m < 4; ++m) _Pragma("unroll") for (int k = 0; k < 2; ++k) dst[m][k] = *(const PG8_LAS bf16x8*)(lds + PG8_SA(b, h) + aoff + m * 2048 + k * 1024); } while (0)
#define PG8_LDB(dst, b, h) do { _Pragma("unroll") for (int n = 0; n < 2; ++n) _Pragma("unroll") for (int k = 0; k < 2; ++k) dst[n][k] = *(const PG8_LAS bf16x8*)(lds + PG8_SB(b, h) + boff + n * 2048 + k * 1024); } while (0)
#define PG8_MMA(ai, bj, At, Bt) do { __builtin_amdgcn_s_setprio(1); _Pragma("unroll") for (int m = 0; m < 4; ++m) _Pragma("unroll") for (int n = 0; n < 2; ++n) _Pragma("unroll") for (int k = 0; k < 2; ++k) \
        acc[ai][bj][m][n] = __builtin_amdgcn_mfma_f32_16x16x32_bf16(Bt[n][k], At[m][k], acc[ai][bj][m][n], 0, 0, 0); __builtin_amdgcn_s_setprio(0); } while (0)
#define PG8_WAIT_V(n) asm volatile("s_waitcnt vmcnt(" #n ")" ::: "memory")
#define PG8_WAIT_L(n) asm volatile("s_waitcnt lgkmcnt(" #n ")" ::: "memory")
#define PG8_BAR __builtin_amdgcn_s_barrier()
#define PG8_SCHED __builtin_amdgcn_sched_barrier(0)
    Unit cur, nxt; int ui = 0;
    if (!S.next(0, cur)) return;
    f32x4 acc[2][2][4][2];
#pragma unroll
    for (int a = 0; a < 2; ++a)
#pragma unroll
        for (int b = 0; b < 2; ++b)
#pragma unroll
            for (int m = 0; m < 4; ++m)
#pragma unroll
                for (int n = 0; n < 2; ++n) acc[a][b][m][n] = (f32x4){0.f, 0.f, 0.f, 0.f};
    bf16x8 At[4][2], B0[2][2], B1[2][2];
    const char* cA = (const char*)g.A + (size_t)cur.pm * tstep; const char* cB = (const char*)g.Bt + (size_t)cur.pn * tstep;
    S.a_ready(cur);
    PG8_STAGE(PG8_SB(0, 0), cB, voffB); PG8_STAGE(PG8_SA(0, 0), cA, voffA); PG8_STAGE(PG8_SB(0, 1), cB + hstep, voffB); PG8_STAGE(PG8_SA(0, 1), cA + hstep, voffA);
    if (wr == 1) PG8_BAR;
    PG8_WAIT_V(4); PG8_BAR;
    PG8_STAGE(PG8_SB(1, 0), cB + kstep, voffB); PG8_STAGE(PG8_SA(1, 0), cA + kstep, voffA); PG8_STAGE(PG8_SB(1, 1), cB + hstep + kstep, voffB);
    PG8_WAIT_V(6); PG8_BAR;
    PG8_STAMP();
    for (;;) {
        const bool has_next = S.next(ui + 1, nxt);
        const char* nA = has_next ? (const char*)g.A + (size_t)nxt.pm * tstep : cA; const char* nB = has_next ? (const char*)g.Bt + (size_t)nxt.pn * tstep : cB;
        for (int t = 0; t < nt; t += 2) {
            const bool last = (t == nt - 2);
            const char* a1 = cA + (size_t)(t + 1) * kstep;
            const char* a2 = last ? nA : cA + (size_t)(t + 2) * kstep; const char* b2 = last ? nB : cB + (size_t)(t + 2) * kstep;
            const char* a3 = a2 + kstep; const char* b3 = b2 + kstep;
            if (last && has_next) S.a_ready(nxt);
            PG8_LDB(B0, 0, 0); PG8_SCHED; PG8_LDA(At, 0, 0); PG8_STAGE(PG8_SA(1, 1), a1 + hstep, voffA);
            PG8_WAIT_L(8); PG8_BAR; PG8_WAIT_L(0); PG8_MMA(0, 0, At, B0); PG8_BAR; PG8_SCHED;
            PG8_LDB(B1, 0, 1); PG8_STAGE(PG8_SB(0, 0), b2, voffB);
            PG8_BAR; PG8_WAIT_L(0); PG8_MMA(0, 1, At, B1); PG8_BAR;
            PG8_LDA(At, 0, 1); PG8_STAGE(PG8_SA(0, 0), a2, voffA);
            PG8_BAR; PG8_WAIT_L(0); PG8_MMA(1, 0, At, B0); PG8_BAR; PG8_SCHED;
            PG8_STAGE(PG8_SB(0, 1), b2 + hstep, voffB);
            PG8_WAIT_V(6); PG8_BAR; PG8_MMA(1, 1, At, B1); PG8_BAR;
            PG8_LDB(B0, 1, 0); PG8_SCHED; PG8_LDA(At, 1, 0); PG8_STAGE(PG8_SA(0, 1), a2 + hstep, voffA);
            PG8_WAIT_L(8); PG8_BAR; PG8_WAIT_L(0); PG8_MMA(0, 0, At, B0); PG8_BAR; PG8_SCHED;
            PG8_LDB(B1, 1, 1); PG8_STAGE(PG8_SB(1, 0), b3, voffB);
            PG8_BAR; PG8_WAIT_L(0); PG8_MMA(0, 1, At, B1); PG8_BAR;
            PG8_LDA(At, 1, 1); PG8_STAGE(PG8_SA(1, 0), a3, voffA);
            PG8_BAR; PG8_WAIT_L(0); PG8_MMA(1, 0, At, B0); PG8_BAR; PG8_SCHED;
            PG8_STAGE(PG8_SB(1, 1), b3 + hstep, voffB);
            PG8_WAIT_V(6); PG8_BAR; PG8_MMA(1, 1, At, B1); PG8_BAR;
        }
        PG8_STAMP();
        if constexpr (!Epi::AFTER_DRAIN) { E(acc, cur, wr, wc, fr, fq); S.done(cur); }
        PG8_STAMP();
        if (!has_next) break;
#pragma unroll
        for (int a = 0; a < 2; ++a)
#pragma unroll
            for (int b = 0; b < 2; ++b)
#pragma unroll
                for (int m = 0; m < 4; ++m)
#pragma unroll
                    for (int n = 0; n < 2; ++n) acc[a][b][m][n] = (f32x4){0.f, 0.f, 0.f, 0.f};
        cur = nxt; cA = nA; cB = nB; ++ui;
    }
    PG8_WAIT_V(0);
    if (wr == 0) PG8_BAR;
    PG8_BAR;
    if constexpr (Epi::AFTER_DRAIN) { E.fused(acc, cur, wr, wc, fr, fq, lds, wid, lane); S.done(cur); }
    PG8_STAMP();
    if (STAMP && wid == 0) { stamps[lane] = lane < nts ? (((unsigned long long)(unsigned)ts_hi << 32) | (unsigned)ts_lo) : 0ull;
        if (lane == 62) stamps[62] = rt_entry; if (lane == 63) stamps[63] = (unsigned long long)wall_clock64(); }
#undef PG8_STAMP
#undef PG8_SA
#undef PG8_SB
#undef PG8_STAGE
#undef PG8_LDA
#undef PG8_LDB
#undef PG8_MMA
#undef PG8_WAIT_V
#undef PG8_WAIT_L
#undef PG8_BAR
#undef PG8_SCHED
}
}
#define XB_TMO      128
#define XB_XCNT(j)  (256  + 64 * (j))
#define XB_XSUB(j)  (1280 + 64 * (j))
#define XB_XGEN(j)  (2304 + 64 * (j))
#define XB_TOP      3328
#define XB_TOPGEN   3392
#define XCD_BAR_WORDS 3456
#define XB_SPIN_CAP (1u << 18)
#define LAS __attribute__((address_space(3)))

__device__ __forceinline__ unsigned xb_ld(unsigned* p)              { return __hip_atomic_load(p, __ATOMIC_RELAXED, __HIP_MEMORY_SCOPE_AGENT); }
__device__ __forceinline__ unsigned xb_add(unsigned* p, unsigned v) { return __hip_atomic_fetch_add(p, v, __ATOMIC_RELAXED, __HIP_MEMORY_SCOPE_AGENT); }
__device__ __forceinline__ unsigned xb_xcc_id() { return (unsigned)__builtin_amdgcn_s_getreg((3 << 11) | 20) & 0xFu; }
#define XB_SPIN(cond, bar) do { unsigned _sp = 0; while (cond) { __builtin_amdgcn_s_sleep(1); \
    if ((++_sp & 255u) == 0u) { if (xb_ld(&(bar)[XB_TMO])) break; if (_sp > XB_SPIN_CAP) { atomicAdd(&(bar)[XB_TMO], 1u); break; } } } } while (0)

struct XcdBarrier {
    unsigned* bar; unsigned x;
    volatile LAS unsigned* st;
};

__device__ __forceinline__ XcdBarrier xcd_barrier_post(unsigned* bar, volatile LAS unsigned* st) {
    XcdBarrier b; b.bar = bar; b.x = xb_xcc_id(); b.st = st;
    if (threadIdx.x == 0) (void)xb_add(&bar[XB_XCNT(b.x)], 1u);
    return b;
}
__device__ __forceinline__ void xcd_barrier_complete(unsigned* bar, unsigned x, unsigned& nloc, unsigned& nx) {
    const unsigned G = gridDim.x * gridDim.y * gridDim.z;
    unsigned sum, cnt, mine, sp = 0u;
    for (;;) {
        sum = 0u; cnt = 0u; mine = 0u;
#pragma unroll
        for (unsigned j = 0; j < 16; ++j) { const unsigned c = xb_ld(&bar[XB_XCNT(j)]); sum += c; cnt += (c > 0u) ? 1u : 0u; mine = (j == x) ? c : mine; }
        if (sum == G) break;
        __builtin_amdgcn_s_sleep(1);
        if ((++sp & 255u) == 0u) { if (xb_ld(&bar[XB_TMO])) break; if (sp > XB_SPIN_CAP) { atomicAdd(&bar[XB_TMO], 1u); break; } }
    }
    nloc = mine > 0u ? mine : 1u; nx = cnt > 0u ? cnt : 1u;
}

__device__ __forceinline__ void xcd_barrier(const XcdBarrier& b) {
    asm volatile("s_waitcnt vmcnt(0)" ::: "memory");
    __syncthreads();
    if (threadIdx.x == 0) {
        unsigned* bar = b.bar;
        __builtin_amdgcn_s_waitcnt(0);
        unsigned nloc = b.st[0], nx = b.st[1];
        if (nloc == 0u) { xcd_barrier_complete(bar, b.x, nloc, nx); b.st[0] = nloc; b.st[1] = nx; }
        const unsigned old = xb_add(&bar[XB_XSUB(b.x)], 1u);
        const unsigned gen = old / nloc;
        if (old + 1u == (gen + 1u) * nloc) {
            __builtin_amdgcn_fence(__ATOMIC_RELEASE, "agent");
            asm volatile("s_waitcnt vmcnt(0)" ::: "memory");
            const unsigned og = xb_add(&bar[XB_TOP], 1u);
            const unsigned tg = og / nx;
            if (og + 1u == (tg + 1u) * nx) xb_add(&bar[XB_TOPGEN], 1u);
            else XB_SPIN(xb_ld(&bar[XB_TOPGEN]) == tg, bar);
            __builtin_amdgcn_fence(__ATOMIC_ACQUIRE, "agent");
            xb_add(&bar[XB_XGEN(b.x)], 1u);
            asm volatile("s_waitcnt vmcnt(0)" ::: "memory");
        } else {
            XB_SPIN(xb_ld(&bar[XB_XGEN(b.x)]) == gen, bar);
            __builtin_amdgcn_fence(__ATOMIC_ACQUIRE, "agent");
            asm volatile("s_waitcnt vmcnt(0)" ::: "memory");
        }
    }
    __syncthreads();
}

using pg8::bf16x8; using pg8::f32x4; using pg8::u32x4; using pg8::f32x2; using pg8::cvt_pk_bf16; using pg8::gelu_pk;
typedef float f32x16 __attribute__((ext_vector_type(16)));
typedef unsigned u32x2 __attribute__((ext_vector_type(2)));
typedef unsigned short u16;
typedef unsigned char u8;

constexpr int T_ = 16384, D_ = 2048, L_ = 4096, F_ = 5632, F2_ = 11264;
constexpr int FS = 8208;
constexpr int LDS_BYTES = 131072 + 1024 + 16 + 8192;
constexpr int MAXSTEPS = 64;

enum { OP_PRE = 0, OP_HF2, OP_NORM, OP_GEMM_IN, OP_EVEN_A, OP_HC, OP_HB, OP_ODD_PREP, OP_ATTN, OP_GEMM_OUT, OP_GEMM_UP, OP_CG, OP_GEMM_DOWN };

struct Params {
    const float* in[26];
    float* x;
    u16* wt_in[4]; u16* wt_out[4]; u16* wt_up[4]; u16* wt_down[4];
    u16* h; u16* p; u16* y; u16* up; u16* gated;
    u16* pT; u16* yT; u16* vcT; u16* vdT;
    u16* filt; float* invn; float* h2tab;
    const float* cw_src[16]; u16* cw_dst[16]; const float* cw_g[16]; float* ssp; unsigned* bar;
    int cw_K[16]; int cw_N[16]; int cw_t0[18]; int cw_perm[16]; u16* edge; float* cgtab;
    int nsteps; int pad0;
    int ops[MAXSTEPS]; int lyr[MAXSTEPS]; int arg[MAXSTEPS]; int rep[MAXSTEPS];
};

union V8 { bf16x8 v; unsigned u[4]; uint4 q; };

__device__ __forceinline__ float bflo(unsigned w) { return __uint_as_float(w << 16); }
__device__ __forceinline__ float bfhi(unsigned w) { return __uint_as_float(w & 0xffff0000u); }
__device__ __forceinline__ float bf2f(u16 b) { return __uint_as_float(((unsigned)b) << 16); }
__device__ __forceinline__ u16 f2bf(float f) { unsigned u = __float_as_uint(f); u += 0x7FFFu + ((u >> 16) & 1u); return (u16)(u >> 16); }
__device__ __forceinline__ unsigned pk2(float a, float b) { return (unsigned)f2bf(a) | ((unsigned)f2bf(b) << 16); }
__device__ __forceinline__ float sx(float v, int o) {
    const int l = opaque_tid() & 63;
    return __builtin_bit_cast(float, __builtin_amdgcn_ds_bpermute((l ^ o) << 2, __builtin_bit_cast(int, v)));
}
__device__ __forceinline__ float wave_sum(float v) {
#pragma unroll
    for (int o = 32; o >= 1; o >>= 1) v += sx(v, o);
    return v;
}
#define MFMA16(a, b, c) __builtin_amdgcn_mfma_f32_16x16x32_bf16((a), (b), (c), 0, 0, 0)
#define MFMA32(a, b, c) __builtin_amdgcn_mfma_f32_32x32x16_bf16((a), (b), (c), 0, 0, 0)

struct EpiStoreBf16 {
    static constexpr bool PERM = true, AFTER_DRAIN = false;
    u16* O; int ldc; int gelu_cols; const float* SSP; const PG8_LAS float* rt; int pm0;
    __device__ __forceinline__ void operator()(const f32x4 (&acc)[2][2][4][2], const pg8::Unit& u, int wr, int wc, int fr, int fq) const {
        const int row0 = u.pm * 256 + wr * 64 + fr, col0 = u.pn * 256 + wc * 32 + 8 * fq;
        const bool act = (u.pn * 256) < gelu_cols;
#pragma unroll
        for (int ai = 0; ai < 2; ++ai)
#pragma unroll
            for (int m = 0; m < 4; ++m) {
                float rstd;
                if (u.pm == pm0) rstd = rt[wr * 64 + ai * 128 + m * 16 + fr];
                else {
                    const float4* sp = (const float4*)(SSP + (size_t)(row0 + ai * 128 + m * 16) * 32 + fq * 8);
                    const float4 sa = sp[0], sb = sp[1];
                    float ssum = (sa.x + sa.y) + (sa.z + sa.w) + (sb.x + sb.y) + (sb.z + sb.w);
                    ssum += sx(ssum, 16); ssum += sx(ssum, 32);
                    rstd = rsqrtf(ssum * (1.0f / D_) + 1e-6f);
                }
                u16* rowp = O + (size_t)(row0 + ai * 128 + m * 16) * ldc + col0;
#pragma unroll
                for (int bj = 0; bj < 2; ++bj) {
                    f32x4 v0 = acc[ai][bj][m][0] * rstd, v1 = acc[ai][bj][m][1] * rstd;
                    if (act) {
                        f32x2 a = gelu_pk((f32x2){v0[0], v0[1]}), b = gelu_pk((f32x2){v0[2], v0[3]}), c = gelu_pk((f32x2){v1[0], v1[1]}), d = gelu_pk((f32x2){v1[2], v1[3]});
                        v0 = (f32x4){a.x, a.y, b.x, b.y}; v1 = (f32x4){c.x, c.y, d.x, d.y};
                    }
                    u32x4 w; w.x = cvt_pk_bf16(v0[0], v0[1]); w.y = cvt_pk_bf16(v0[2], v0[3]); w.z = cvt_pk_bf16(v1[0], v1[1]); w.w = cvt_pk_bf16(v1[2], v1[3]);
                    *(u32x4*)(rowp + bj * 128) = w;
                }
            }
    }
};
struct EpiResid {
    static constexpr bool PERM = false, AFTER_DRAIN = false;
    const float* R; float* X; u16* XB; float* SSP;
    __device__ __forceinline__ void operator()(const f32x4 (&acc)[2][2][4][2], const pg8::Unit& u, int wr, int wc, int fr, int fq) const {
        const int row0 = u.pm * 256 + wr * 64 + fr, col0 = u.pn * 256 + wc * 32 + 4 * fq;
#pragma unroll
        for (int ai = 0; ai < 2; ++ai)
#pragma unroll
            for (int m = 0; m < 4; ++m) {
                const size_t off = (size_t)(row0 + ai * 128 + m * 16) * D_ + col0;
                float ss = 0.f;
#pragma unroll
                for (int bj = 0; bj < 2; ++bj)
#pragma unroll
                    for (int n = 0; n < 2; ++n) {
                        const f32x4 r = *(const f32x4*)(R + off + bj * 128 + n * 16);
                        const f32x4 v = acc[ai][bj][m][n] + r;
                        *(f32x4*)(X + off + bj * 128 + n * 16) = v;
                        if (XB) { ss += v[0] * v[0] + v[1] * v[1] + v[2] * v[2] + v[3] * v[3];
                            u32x2 w; w.x = cvt_pk_bf16(v[0], v[1]); w.y = cvt_pk_bf16(v[2], v[3]); *(u32x2*)(XB + off + bj * 128 + n * 16) = w; }
                    }
                if (XB) { ss += sx(ss, 16); ss += sx(ss, 32);
                    if (fq == 0) SSP[(size_t)(row0 + ai * 128 + m * 16) * 32 + u.pn * 4 + wc] = ss; }
            }
    }
};

__device__ __forceinline__ float dpp_ror1(float x) { return __builtin_bit_cast(float, __builtin_amdgcn_update_dpp(0, __builtin_bit_cast(int, x), 0x121, 0xf, 0xf, false)); }
__device__ __forceinline__ float dpp_ror15(float x) { return __builtin_bit_cast(float, __builtin_amdgcn_update_dpp(0, __builtin_bit_cast(int, x), 0x12F, 0xf, 0xf, false)); }
constexpr int LDS_RT = 131072, LDS_XST = 132096, LDS_CGT = 132112;
struct EpiGate {
    static constexpr bool PERM = true, AFTER_DRAIN = false;
    u16* G; u16* EDGE; const PG8_LAS float* rt; const PG8_LAS float* cgt;
    __device__ __forceinline__ void operator()(const f32x4 (&acc)[2][2][4][2], const pg8::Unit& u, int wr, int wc, int fr_in, int fq_in) const {
        const int lane_ = opaque_tid() & 63; const int fr = lane_ & 15, fq = lane_ >> 4;
        (void)fr_in; (void)fq_in;
        const PG8_LAS float* tb = cgt + ((u.pn >> 2) & 1) * 1024;
        const int cb = wc * 32 + 8 * fq;
        const int rowblk0 = u.pm * 256 + wr * 64;
#pragma unroll
        for (int n = 0; n < 2; ++n) {
            const int fcol = u.pn * 128 + cb + 4 * n;
#pragma unroll
            for (int ai = 0; ai < 2; ++ai) {
                float rs[4];
#pragma unroll
                for (int m = 0; m < 4; ++m) rs[m] = rt[wr * 64 + ai * 128 + m * 16 + fr];
                f32x4 o[4], eg[2], ev[2];
#pragma unroll
                for (int j = 0; j < 4; ++j) {
                    float W[4][2];
#pragma unroll
                    for (int k = 0; k < 4; ++k) { W[k][0] = tb[k * 256 + cb + 4 * n + j]; W[k][1] = tb[k * 256 + 128 + cb + 4 * n + j]; }
                    float g[4], v[4], gr[4], gl[4], vr[4], vl[4];
#pragma unroll
                    for (int m = 0; m < 4; ++m) { g[m] = acc[ai][0][m][n][j] * rs[m]; v[m] = acc[ai][1][m][n][j] * rs[m];
                        gr[m] = dpp_ror1(g[m]); gl[m] = dpp_ror15(g[m]); vr[m] = dpp_ror1(v[m]); vl[m] = dpp_ror15(v[m]); }
#pragma unroll
                    for (int m = 0; m < 4; ++m) {
                        const float gp = (fr == 0) ? (m > 0 ? gr[m > 0 ? m - 1 : 0] : 0.f) : gr[m];
                        const float gn = (fr == 15) ? (m < 3 ? gl[m < 3 ? m + 1 : 3] : 0.f) : gl[m];
                        const float vp = (fr == 0) ? (m > 0 ? vr[m > 0 ? m - 1 : 0] : 0.f) : vr[m];
                        const float vn = (fr == 15) ? (m < 3 ? vl[m < 3 ? m + 1 : 3] : 0.f) : vl[m];
                        const float cgv = W[0][0] * gp + W[1][0] * g[m] + W[2][0] * gn + W[3][0];
                        const float cvv = W[0][1] * vp + W[1][1] * v[m] + W[2][1] * vn + W[3][1];
                        o[m][j] = cgv * __builtin_amdgcn_rcpf(1.0f + __expf(-cgv)) * cvv;
                    }
                    eg[0][j] = g[0]; eg[1][j] = g[3]; ev[0][j] = v[0]; ev[1][j] = v[3];
                }
#pragma unroll
                for (int m = 0; m < 4; ++m) {
                    const bool skip = (m == 0 && fr == 0) || (m == 3 && fr == 15);
                    if (!skip) { u32x2 w; w.x = cvt_pk_bf16(o[m][0], o[m][1]); w.y = cvt_pk_bf16(o[m][2], o[m][3]);
                        *(u32x2*)(G + (size_t)(rowblk0 + ai * 128 + m * 16 + fr) * F_ + fcol) = w; }
                }
                const int blk = (rowblk0 + ai * 128) >> 6;
                if (fr < 2) { u16* ep = EDGE + (size_t)(blk * 4 + fr) * F2_ + fcol;
                    u32x2 w; w.x = cvt_pk_bf16(eg[0][0], eg[0][1]); w.y = cvt_pk_bf16(eg[0][2], eg[0][3]); *(u32x2*)ep = w;
                    u32x2 x; x.x = cvt_pk_bf16(ev[0][0], ev[0][1]); x.y = cvt_pk_bf16(ev[0][2], ev[0][3]); *(u32x2*)(ep + F_) = x; }
                if (fr >= 14) { u16* ep = EDGE + (size_t)(blk * 4 + fr - 12) * F2_ + fcol;
                    u32x2 w; w.x = cvt_pk_bf16(eg[1][0], eg[1][1]); w.y = cvt_pk_bf16(eg[1][2], eg[1][3]); *(u32x2*)ep = w;
                    u32x2 x; x.x = cvt_pk_bf16(ev[1][0], ev[1][1]); x.y = cvt_pk_bf16(ev[1][2], ev[1][3]); *(u32x2*)(ep + F_) = x; }
            }
        }
    }
};
struct CgOrder : pg8::StaticOrder {
    const float* tab; PG8_LAS u8* ldsb;
    __device__ __forceinline__ void a_ready(const pg8::Unit& u) const {
        const int t = opaque_tid(), wid = __builtin_amdgcn_readfirstlane(t >> 6), lane = t & 63;
        if (wid < 4) {
            const float* src = tab + (size_t)u.pn * 1024 + wid * 256 + lane * 4;
            __builtin_amdgcn_global_load_lds((const unsigned*)src, (PG8_LAS unsigned*)(ldsb + LDS_CGT + ((u.pn >> 2) & 1) * 4096 + wid * 1024), 16, 0, 0);
        }
    }
    __device__ __forceinline__ void done(const pg8::Unit&) const {}
};

__device__ __forceinline__ void convT_tile(const float* __restrict__ W, int K, int N, u16* __restrict__ Wt, const float* __restrict__ gk, int permF, int tile, u8* shm) {
    unsigned* tl = (unsigned*)shm;
    const int tid = opaque_tid(), wid = tid >> 6, lane = tid & 63;
    const int nN = N >> 8, kt = tile / nN, nt = tile - kt * nN, k0 = kt * 64, n0 = nt * 256;
    float v[8][4];
#pragma unroll
    for (int r = 0; r < 8; ++r)
#pragma unroll
        for (int e = 0; e < 4; ++e) v[r][e] = W[(size_t)(k0 + wid * 8 + r) * N + (permF ? ((e >> 1) * F_ + 128 * nt + lane + 64 * (e & 1)) : (n0 + lane + 64 * e))];
    if (gk) {
#pragma unroll
        for (int r = 0; r < 8; ++r) { const float g = gk[k0 + wid * 8 + r];
#pragma unroll
            for (int e = 0; e < 4; ++e) v[r][e] *= g; }
    }
#pragma unroll
    for (int rp = 0; rp < 4; ++rp)
#pragma unroll
        for (int e = 0; e < 4; ++e) tl[(lane + 64 * e) * 33 + wid * 4 + rp] = cvt_pk_bf16(v[2 * rp][e], v[2 * rp + 1][e]);
    __syncthreads();
#pragma unroll
    for (int i = 0; i < 4; ++i) {
        const int id = i * 512 + tid, n = id >> 3, kc = id & 7;
        uint4 w; w.x = tl[n * 33 + kc * 4]; w.y = tl[n * 33 + kc * 4 + 1]; w.z = tl[n * 33 + kc * 4 + 2]; w.w = tl[n * 33 + kc * 4 + 3];
        *(uint4*)(Wt + (size_t)(n0 + n) * K + k0 + kc * 8) = w;
    }
    __syncthreads();
}

__device__ __forceinline__ void norm_phase(const float* x, const float* __restrict__ g, u16* h, float* outf) {
    const int wid = opaque_tid() >> 6, lane = opaque_tid() & 63;
    for (int row = blockIdx.x * 8 + wid; row < T_; row += gridDim.x * 8) {
        const float* xr = x + (size_t)row * D_;
        float4 v[8]; float ss = 0.f;
#pragma unroll
        for (int i = 0; i < 8; ++i) { v[i] = *(const float4*)(xr + i * 256 + lane * 4); ss += v[i].x * v[i].x + v[i].y * v[i].y + v[i].z * v[i].z + v[i].w * v[i].w; }
        ss = wave_sum(ss);
        const float rstd = rsqrtf(ss * (1.0f / D_) + 1e-6f);
#pragma unroll
        for (int i = 0; i < 8; ++i) {
            const float4 gg = *(const float4*)(g + i * 256 + lane * 4);
            const float a = v[i].x * rstd * gg.x, b = v[i].y * rstd * gg.y, c = v[i].z * rstd * gg.z, d = v[i].w * rstd * gg.w;
            if (outf) *(float4*)(outf + (size_t)row * D_ + i * 256 + lane * 4) = make_float4(a, b, c, d);
            else { u32x2 w; w.x = cvt_pk_bf16(a, b); w.y = cvt_pk_bf16(c, d); *(u32x2*)(h + (size_t)row * D_ + i * 256 + lane * 4) = w; }
        }
    }
}

__device__ __forceinline__ void xprep_phase(const float* x, u16* xb, float* ssp) {
    const int wid = opaque_tid() >> 6, lane = opaque_tid() & 63;
    for (int row = blockIdx.x * 8 + wid; row < T_; row += gridDim.x * 8) {
        const float* xr = x + (size_t)row * D_;
        float ss = 0.f;
#pragma unroll
        for (int i = 0; i < 8; ++i) { const float4 v = *(const float4*)(xr + i * 256 + lane * 4); ss += v.x * v.x + v.y * v.y + v.z * v.z + v.w * v.w;
            u32x2 w; w.x = cvt_pk_bf16(v.x, v.y); w.y = cvt_pk_bf16(v.z, v.w); *(u32x2*)(xb + (size_t)row * D_ + i * 256 + lane * 4) = w; }
        ss = wave_sum(ss);
        if (lane < 32) ssp[(size_t)row * 32 + lane] = lane == 0 ? ss : 0.f;
    }
}

__device__ __forceinline__ void hf1_phase(const Params& P) {
    const int wid = opaque_tid() >> 6, lane = opaque_tid() & 63;
    for (int idx = blockIdx.x * 8 + wid; idx < 2 * L_; idx += gridDim.x * 8) {
        const int i = idx >> 12, t = idx & 4095;
        const float* w1 = P.in[15] + i * 33 * 64; const float* b1 = P.in[16] + i * 64;
        const float* w2 = P.in[17] + i * 64 * 64; const float* b2 = P.in[18] + i * 64;
        const float* fr = P.in[20] + i * 128;
        const float tn = (float)t / 4095.0f;
        const float w = (6.283185307179586f * (float)t) / 4096.0f;
        float acc = b1[lane] + tn * w1[lane];
        {
            const float band = 1e-4f + (float)(lane & 15) * ((15.0f - 1e-4f) / 15.0f);
            const float a = w * band;
            const float zv = ((lane & 16) == 0) ? cosf(a) : -sinf(a);
#pragma unroll 8
            for (int k = 0; k < 32; ++k) acc += __shfl(zv, k) * w1[(1 + k) * 64 + lane];
        }
        const float h1 = sinf(fr[lane] * acc);
        float acc2 = b2[lane];
#pragma unroll 8
        for (int k = 0; k < 64; ++k) acc2 += __shfl(h1, k) * w2[k * 64 + lane];
        ((u16*)P.h2tab)[(size_t)idx * 64 + lane] = f2bf(sinf(fr[64 + lane] * acc2));
    }
}

__device__ __forceinline__ void hf2_item(const Params& P, int id, u8* shm) {
    u16* w3s = (u16*)shm;
    float* red = (float*)(shm + 4096);
    const int tid = opaque_tid(), wid = tid >> 6, lane = tid & 63, n = lane & 15, quad = lane >> 4;
    const int cb = id & 127, o = (id >> 7) & 1, i = id >> 8;
    const float* w3 = P.in[19] + (size_t)i * 64 * 4096;
    __syncthreads();
#pragma unroll
    for (int j = 0; j < 2; ++j) { const int e = j * 512 + tid, k = e >> 4, col = e & 15; w3s[col * 72 + k] = f2bf(w3[(size_t)k * 4096 + o * 2048 + (col >> 3) * 1024 + cb * 8 + (col & 7)]); }
    __syncthreads();
    const bf16x8 b0 = *(const bf16x8*)(w3s + n * 72 + 8 * quad), b1 = *(const bf16x8*)(w3s + n * 72 + 32 + 8 * quad);
    const int dir = n >> 3, e8 = n & 7, ch = cb * 8 + e8;
    const float delta = 3.0701134573253945f + (15.350567286626973f - 3.0701134573253945f) * ((float)ch / 1023.0f);
    u16* fb = P.filt + ((size_t)(i * 2 + o) * 1024 + ch) * FS;
    const u16* hb = (const u16*)P.h2tab + (size_t)i * 4096 * 64;
    float asum = 0.f;
#pragma unroll 2
    for (int tile = wid; tile < 256; tile += 8) {
        const u16* hp = hb + (size_t)(tile * 16 + n) * 64 + 8 * quad;
        const bf16x8 a0 = *(const bf16x8*)hp, a1 = *(const bf16x8*)(hp + 32);
        f32x4 acc = (f32x4){0.f, 0.f, 0.f, 0.f};
        acc = MFMA16(a0, b0, acc); acc = MFMA16(a1, b1, acc);
        const int t0 = tile * 16 + 4 * quad;
        float v[4];
#pragma unroll
        for (int j = 0; j < 4; ++j) { const float tn = (float)(t0 + j) / 4095.0f; v[j] = acc[j] * expf(-tn * delta); }
        if (dir == 0) {
#pragma unroll
            for (int j = 0; j < 4; ++j) { fb[4096 - (t0 + j)] = f2bf(v[j]); asum += fabsf(v[j]); }
        } else {
            u32x2 w; w.x = cvt_pk_bf16(v[0], v[1]); w.y = cvt_pk_bf16(v[2], v[3]);
            if (t0 == 0) { fb[4097] = f2bf(v[1]); fb[4098] = f2bf(v[2]); fb[4099] = f2bf(v[3]); asum += fabsf(v[1]) + fabsf(v[2]) + fabsf(v[3]); }
            else { *(u32x2*)(fb + 4096 + t0) = w; asum += (fabsf(v[0]) + fabsf(v[1])) + (fabsf(v[2]) + fabsf(v[3])); }
        }
    }
    if (tid < 8 * 17) { const int e = tid / 17, j = tid % 17; (P.filt + ((size_t)(i * 2 + o) * 1024 + cb * 8 + e) * FS)[j == 0 ? 0 : 8191 + j] = 0; }
    asum += sx(asum, 16); asum += sx(asum, 32); asum += sx(asum, 8);
    if (lane < 8) red[wid * 8 + lane] = asum;
    __syncthreads();
    if (tid < 8) { float s = 0.f; for (int w = 0; w < 8; ++w) s += red[w * 8 + tid]; P.invn[(i * 2 + o) * 1024 + cb * 8 + tid] = 1.0f / s; }
}

template <int NT>
__device__ __forceinline__ void tr_tile(const u16* __restrict__ src, int src_ld, int col0, int nct, u16* __restrict__ dst, size_t ch_stride, size_t b_stride,
                                        const float* cw, const float* cb, int cw_ld, int tile0, int tstride, int ntot, u8* shm, bool perm = false) {
    const int tid = opaque_tid();
    const int row = tid >> 3, chunk = tid & 7;
    u32x4 w[NT], hw[NT];
#pragma unroll
    for (int k = 0; k < NT; ++k) {
        const int tile = tile0 + k * tstride;
        w[k] = (u32x4){0u, 0u, 0u, 0u}; hw[k] = (u32x4){0u, 0u, 0u, 0u};
        if (tile < ntot) {
            const int ct = tile % nct, bs = tile / nct, st = bs & 63, b = bs >> 6, s0 = st * 64, c0 = ct * 64;
            w[k] = *(const u32x4*)(src + (size_t)(b * L_ + s0 + row) * src_ld + col0 + c0 + chunk * 8);
            if (tid < 16) { const int hr = tid >> 3, s = hr ? s0 + 64 : s0 - 1;
                if (s >= 0 && s < L_) hw[k] = *(const u32x4*)(src + (size_t)(b * L_ + s) * src_ld + col0 + c0 + chunk * 8); }
        }
    }
#pragma unroll
    for (int k = 0; k < NT; ++k) {
        unsigned* tl = (unsigned*)shm + k * (66 * 33 + 2);
        unsigned* d = tl + (row + 1) * 33 + chunk * 4; d[0] = w[k].x; d[1] = w[k].y; d[2] = w[k].z; d[3] = w[k].w;
        if (tid < 16) { const int hr = tid >> 3; unsigned* hd = tl + (hr ? 65 : 0) * 33 + chunk * 4; hd[0] = hw[k].x; hd[1] = hw[k].y; hd[2] = hw[k].z; hd[3] = hw[k].w; }
    }
    __syncthreads();
#pragma unroll
    for (int k = 0; k < NT; ++k) {
        const int tile = tile0 + k * tstride;
        if (tile < ntot) {
            const u16* tl16 = (const u16*)((unsigned*)shm + k * (66 * 33 + 2));
            const int ct = tile % nct, bs = tile / nct, st = bs & 63, b = bs >> 6, s0 = st * 64, c0 = ct * 64;
            const int ch = tid >> 3, sc = tid & 7;
            float o[8];
            if (cw) {
                const float w0 = cw[c0 + ch], w1 = cw[cw_ld + c0 + ch], w2 = cw[2 * cw_ld + c0 + ch], bb = cb[c0 + ch];
                float r[10];
#pragma unroll
                for (int j = 0; j < 10; ++j) r[j] = bf2f(tl16[(sc * 8 + j) * 66 + ch]);
#pragma unroll
                for (int j = 0; j < 8; ++j) o[j] = w0 * r[j] + w1 * r[j + 1] + w2 * r[j + 2] + bb;
            } else {
#pragma unroll
                for (int j = 0; j < 8; ++j) o[j] = bf2f(tl16[(sc * 8 + j + 1) * 66 + ch]);
            }
            uint4 wv; wv.x = cvt_pk_bf16(o[0], o[1]); wv.y = cvt_pk_bf16(o[2], o[3]); wv.z = cvt_pk_bf16(o[4], o[5]); wv.w = cvt_pk_bf16(o[6], o[7]);
            u16* dp = dst + (size_t)(c0 + ch) * ch_stride + (size_t)b * b_stride + s0;
            if (!perm) *(uint4*)(dp + sc * 8) = wv;
            else { u32x2 lo; lo.x = wv.x; lo.y = wv.y; u32x2 hi; hi.x = wv.z; hi.y = wv.w;
                *(u32x2*)(dp + 16 * (sc >> 1) + 4 * (sc & 1)) = lo; *(u32x2*)(dp + 16 * (sc >> 1) + 8 + 4 * (sc & 1)) = hi; }
        }
    }
    __syncthreads();
}

template <int NT>
__device__ __forceinline__ void trback_tile(const u16* __restrict__ yT, u16* __restrict__ y, int tile0, int tstride, int ntot, u8* shm) {
    const int tid = opaque_tid();
    u32x4 w[NT];
#pragma unroll
    for (int k = 0; k < NT; ++k) {
        const int tile = tile0 + k * tstride;
        w[k] = (u32x4){0u, 0u, 0u, 0u};
        if (tile < ntot) { const int ct = tile & 15, bs = tile >> 4, st = bs & 63, b = bs >> 6, t0 = st * 64, c0 = ct * 64; const int c = tid >> 3, chunk = tid & 7;
            w[k] = *(const u32x4*)(yT + ((size_t)(c0 + c) * 4 + b) * L_ + t0 + chunk * 8); }
    }
#pragma unroll
    for (int k = 0; k < NT; ++k) { const int c = tid >> 3, chunk = tid & 7; unsigned* d = (unsigned*)shm + k * (64 * 33 + 2) + c * 33 + chunk * 4; d[0] = w[k].x; d[1] = w[k].y; d[2] = w[k].z; d[3] = w[k].w; }
    __syncthreads();
#pragma unroll
    for (int k = 0; k < NT; ++k) {
        const int tile = tile0 + k * tstride;
        if (tile < ntot) {
            const u16* tl16 = (const u16*)((unsigned*)shm + k * (64 * 33 + 2));
            const int ct = tile & 15, bs = tile >> 4, st = bs & 63, b = bs >> 6, t0 = st * 64, c0 = ct * 64;
            const int t = tid >> 3, cc = tid & 7;
            unsigned short e[8];
#pragma unroll
            for (int j = 0; j < 8; ++j) e[j] = tl16[(cc * 8 + j) * 66 + t];
            uint4 wv; wv.x = e[0] | ((unsigned)e[1] << 16); wv.y = e[2] | ((unsigned)e[3] << 16); wv.z = e[4] | ((unsigned)e[5] << 16); wv.w = e[6] | ((unsigned)e[7] << 16);
            *(uint4*)(y + (size_t)(b * L_ + t0 + t) * D_ + 1024 + c0 + cc * 8) = wv;
        }
    }
    __syncthreads();
}

constexpr int HU_B = 5792, HU_J = 72, HU_P = 7;
__device__ __forceinline__ void hc_loadF(V8& f, const u16* Fo  , int j) {
    const unsigned* fp = (const unsigned*)(Fo - 16 * j);
    f.u[0] = fp[0]; f.u[1] = fp[1]; f.u[2] = fp[2]; f.u[3] = fp[3];
}
__device__ __forceinline__ void hc_loadB(V8 (&bv)[2][2], const u16* Uo, int m, int wid, int n, int quad) {
#pragma unroll
    for (int nt = 0; nt < 2; ++nt) {
        const int ii = 4 * (2 * wid + nt) + (n >> 2), b = n & 3, j = ii - m;
        const u16* up = Uo + b * HU_B + (j + HU_P) * HU_J + 8 * quad;
#pragma unroll
        for (int ks = 0; ks < 2; ++ks) bv[ks][nt].q = *(const uint4*)(up + 32 * ks);
    }
}
template <int PAR>
__device__ __forceinline__ void hc_step(V8 (&F)[16], f32x4 (&acc)[4][2], const V8 (&bc)[2][2], V8 (&bn)[2][2], const u16* Fo, const u16* Uo, int m, int wid, int n, int quad, int sh) {
    V8 nf[4];
#pragma unroll
    for (int e = 0; e < 4; ++e) hc_loadF(nf[e], Fo, 4 * (m + 1) + e);
    hc_loadB(bn, Uo, m + 1, wid, n, quad);
#pragma unroll
    for (int ks = 0; ks < 2; ++ks)
#pragma unroll
        for (int mt = 0; mt < 4; ++mt) {
            const int slot = (PAR * 4 + mt - 2 * ks) & 15;
            acc[mt][0] = MFMA16(F[slot].v, bc[ks][0].v, acc[mt][0]);
            acc[mt][1] = MFMA16(F[slot].v, bc[ks][1].v, acc[mt][1]);
        }
#pragma unroll
    for (int e = 0; e < 4; ++e) F[(PAR * 4 + 4 + e) & 15] = nf[e];
}

__device__ __forceinline__ void hconv_item(const Params& P, int i, int c, u8* shm) {
    u16* FA = (u16*)shm + 64; u16* FB = FA + FS; u16* U = FB + FS; u16* Z = U + 4 * HU_B;
    const int tid = opaque_tid(), wid = tid >> 6, lane = tid & 63, n = lane & 15, quad = lane >> 4;
    __syncthreads();
    {
        const uint4* su = (const uint4*)(P.pT + (size_t)c * 4 * L_);
#pragma unroll
        for (int j = 0; j < 4; ++j) { const int cidx = j * 512 + tid, bb = cidx >> 9, tt = (cidx & 511) * 8; *(uint4*)(U + bb * HU_B + ((tt >> 6) + HU_P) * HU_J + (tt & 63)) = su[cidx]; }
    }
    __syncthreads();
    const float skip0 = P.in[21][(i * 2 + 0) * 1024 + c], skip1 = P.in[21][(i * 2 + 1) * 1024 + c];
    const float in0 = P.invn[(i * 2 + 0) * 1024 + c], in1 = P.invn[(i * 2 + 1) * 1024 + c];
    const int sh = (n & 1) * 16;
#pragma unroll 1
    for (int o = 0; o < 2; ++o) {
        {
            const uint4* sf = (const uint4*)(P.filt + ((size_t)(i * 2 + o) * 1024 + c) * FS);
            for (int j = tid; j < FS / 8; j += 512) ((uint4*)FA)[j] = sf[j];
            __syncthreads();
            const unsigned* fa = (const unsigned*)FA; unsigned* fb = (unsigned*)FB;
            for (int k = tid; k < FS / 2; k += 512) fb[k] = __builtin_amdgcn_alignbit(fa[k + 1], fa[k], 16);
            __syncthreads();
        }
        const u16* Fo = ((n & 1) ? FB : FA) + ((4096 - n + 8 * quad) & ~1); const u16* Uo = o ? Z : U;
        f32x4 acc[4][2];
#pragma unroll
        for (int mt = 0; mt < 4; ++mt) { acc[mt][0] = (f32x4){0.f, 0.f, 0.f, 0.f}; acc[mt][1] = (f32x4){0.f, 0.f, 0.f, 0.f}; }
        V8 F[16];
#pragma unroll
        for (int e = 0; e < 16; ++e) F[e].q = make_uint4(0, 0, 0, 0);
        const int mb = 8 * wid - 64;
        V8 ba[2][2], bb[2][2];
        const u16* gsrc = P.pT + ((size_t)((o ? 2048 : 1024) + c) * 4) * L_;
        u32x2 ggp[2][4];
#pragma unroll
        for (int nt = 0; nt < 2; ++nt) { const int ii = 4 * (2 * wid + nt) + (n >> 2), b = n & 3;
#pragma unroll
            for (int mt = 0; mt < 4; ++mt) ggp[nt][mt] = *(const u32x2*)(gsrc + (size_t)b * L_ + 64 * ii + 16 * mt + 4 * quad); }
#pragma unroll
        for (int e = 0; e < 4; ++e) hc_loadF(F[e], Fo, 4 * mb + e);
        hc_loadB(ba, Uo, mb, wid, n, quad);
#pragma unroll 1
        for (int kk = 0; kk < 18; ++kk) {
            const int m0 = mb + 4 * kk;
            hc_step<0>(F, acc, ba, bb, Fo, Uo, m0, wid, n, quad, sh);
            hc_step<1>(F, acc, bb, ba, Fo, Uo, m0 + 1, wid, n, quad, sh);
            hc_step<2>(F, acc, ba, bb, Fo, Uo, m0 + 2, wid, n, quad, sh);
            hc_step<3>(F, acc, bb, ba, Fo, Uo, m0 + 3, wid, n, quad, sh);
        }
        const float sk = o ? skip1 : skip0, inn = o ? in1 : in0;
#pragma unroll
        for (int nt = 0; nt < 2; ++nt) {
            const int ii = 4 * (2 * wid + nt) + (n >> 2), b = n & 3;
#pragma unroll
            for (int mt = 0; mt < 4; ++mt) {
                const int t0 = 64 * ii + 16 * mt + 4 * quad;
                const int uidx = b * HU_B + ((t0 >> 6) + HU_P) * HU_J + (t0 & 63);
                const u32x2 uu = *(const u32x2*)(Uo + uidx);
                const u32x2 gg = ggp[nt][mt];
                const float r0 = bflo(gg.x) * (acc[mt][nt][0] * inn + sk * bflo(uu.x));
                const float r1 = bfhi(gg.x) * (acc[mt][nt][1] * inn + sk * bfhi(uu.x));
                const float r2 = bflo(gg.y) * (acc[mt][nt][2] * inn + sk * bflo(uu.y));
                const float r3 = bfhi(gg.y) * (acc[mt][nt][3] * inn + sk * bfhi(uu.y));
                u32x2 w; w.x = cvt_pk_bf16(r0, r1); w.y = cvt_pk_bf16(r2, r3);
                if (o == 0) *(u32x2*)(Z + uidx) = w;
                else *(u32x2*)(P.yT + ((size_t)c * 4 + b) * L_ + t0) = w;
            }
        }
        __syncthreads();
    }
}

__device__ __forceinline__ void gmlp_item(const Params& P, int i, int item, u8* shm) {
    float* rs = (float*)shm; u16* Ws = (u16*)(shm + 512); u16* Vt = Ws + 128 * 136;
    const int tid = opaque_tid(), wid = tid >> 6, lane = tid & 63, n = lane & 15, quad = lane >> 4;
    const int bc = item >> 1, gh = item & 1, tok0 = bc * 128;
    const u16* p = P.p;
    __syncthreads();
    {
        const int q = tid >> 2, part = tid & 3; float ss = 0.f;
        const uint4* vp = (const uint4*)(p + (size_t)(tok0 + q) * 5120 + 1024 + part * 256);
#pragma unroll 16
        for (int j = 0; j < 32; ++j) { const uint4 w = vp[j];
            ss += bflo(w.x) * bflo(w.x) + bfhi(w.x) * bfhi(w.x) + bflo(w.y) * bflo(w.y) + bfhi(w.y) * bfhi(w.y) + bflo(w.z) * bflo(w.z) + bfhi(w.z) * bfhi(w.z) + bflo(w.w) * bflo(w.w) + bfhi(w.w) * bfhi(w.w); }
        ss += sx(ss, 1); ss += sx(ss, 2);
        if (part == 0) rs[q] = rsqrtf(ss * (1.0f / 1024.0f) + 1e-6f);
    }
    __syncthreads();
    const float* gain = P.in[10] + i * 1024;
    for (int gi = 0; gi < 4; ++gi) {
        const int g = gh * 4 + gi;
        const float* ws = P.in[11] + ((size_t)(i * 8 + g)) * 16384;
#pragma unroll
        for (int j = 0; j < 8; ++j) { const int e4 = (j * 512 + tid) * 4; const float4 w = *(const float4*)(ws + e4); const int pp = e4 >> 7, qq = e4 & 127;
            u32x2 o; o.x = cvt_pk_bf16(w.x, w.y); o.y = cvt_pk_bf16(w.z, w.w); *(u32x2*)(Ws + pp * 136 + qq) = o; }
#pragma unroll
        for (int j = 0; j < 4; ++j) { const int id = j * 512 + tid, qq = id >> 4, dc = id & 15;
            const uint4 w = *(const uint4*)(p + (size_t)(tok0 + qq) * 5120 + 1024 + g * 128 + dc * 8);
            const float r = rs[qq]; const float* gp = gain + g * 128 + dc * 8;
            Vt[(dc * 8 + 0) * 136 + qq] = f2bf(bflo(w.x) * r * gp[0]); Vt[(dc * 8 + 1) * 136 + qq] = f2bf(bfhi(w.x) * r * gp[1]);
            Vt[(dc * 8 + 2) * 136 + qq] = f2bf(bflo(w.y) * r * gp[2]); Vt[(dc * 8 + 3) * 136 + qq] = f2bf(bfhi(w.y) * r * gp[3]);
            Vt[(dc * 8 + 4) * 136 + qq] = f2bf(bflo(w.z) * r * gp[4]); Vt[(dc * 8 + 5) * 136 + qq] = f2bf(bfhi(w.z) * r * gp[5]);
            Vt[(dc * 8 + 6) * 136 + qq] = f2bf(bflo(w.w) * r * gp[6]); Vt[(dc * 8 + 7) * 136 + qq] = f2bf(bfhi(w.w) * r * gp[7]); }
        __syncthreads();
        f32x4 acc[8];
#pragma unroll
        for (int dt = 0; dt < 8; ++dt) acc[dt] = (f32x4){0.f, 0.f, 0.f, 0.f};
#pragma unroll
        for (int ks = 0; ks < 4; ++ks) {
            const bf16x8 bfr = *(const bf16x8*)(Ws + (16 * wid + n) * 136 + 32 * ks + 8 * quad);
#pragma unroll
            for (int dt = 0; dt < 8; ++dt) { const bf16x8 afr = *(const bf16x8*)(Vt + (16 * dt + n) * 136 + 32 * ks + 8 * quad); acc[dt] = MFMA16(afr, bfr, acc[dt]); }
        }
        const int pp = 16 * wid + n;
        const float bsv = P.in[12][(i * 8 + g) * 128 + pp];
#pragma unroll
        for (int dt = 0; dt < 8; ++dt) {
            const int d = g * 128 + 16 * dt + 4 * quad;
            const u32x2 uu = *(const u32x2*)(p + (size_t)(tok0 + pp) * 5120 + d);
            u32x2 w; w.x = cvt_pk_bf16(bflo(uu.x) * (acc[dt][0] + bsv), bfhi(uu.x) * (acc[dt][1] + bsv)); w.y = cvt_pk_bf16(bflo(uu.y) * (acc[dt][2] + bsv), bfhi(uu.y) * (acc[dt][3] + bsv));
            *(u32x2*)(P.y + (size_t)(tok0 + pp) * D_ + d) = w;
        }
        __syncthreads();
    }
}

__device__ __forceinline__ void rotary_phase(const Params& P) {
    const int nth = gridDim.x * 512;
    for (int idx2 = blockIdx.x * 512 + opaque_tid(); idx2 < T_ * 8; idx2 += nth) {
        const int idx = idx2 >> 1, ghalf = idx2 & 1;
        const int tok = idx >> 2, dq = idx & 3, pos = tok & 4095;
        float cs[8], sn[8];
#pragma unroll
        for (int e = 0; e < 8; ++e) { const float inv = exp2f(-(float)(dq * 8 + e) * 0.41524101186092029f); const float ang = (float)pos * inv; cs[e] = cosf(ang); sn[e] = sinf(ang); }
        u16* base = P.p + (size_t)tok * 6144 + 3072;
#pragma unroll 2
        for (int g16 = 0; g16 < 16; ++g16) {
            const int grp = ghalf * 16 + g16;
            u16* gp = base + (grp >> 4) * 1024 + (grp & 15) * 64 + dq * 8;
            const float sc = (grp < 16) ? 0.125f * 1.4426950408889634f : 1.0f;
            const uint4 a = *(const uint4*)gp, b = *(const uint4*)(gp + 32);
            const unsigned aw[4] = {a.x, a.y, a.z, a.w}, bw[4] = {b.x, b.y, b.z, b.w};
            unsigned oa[4], ob[4];
#pragma unroll
            for (int j = 0; j < 4; ++j) {
                const float x1l = bflo(aw[j]), x1h = bfhi(aw[j]), x2l = bflo(bw[j]), x2h = bfhi(bw[j]);
                oa[j] = cvt_pk_bf16((x1l * cs[2 * j] - x2l * sn[2 * j]) * sc, (x1h * cs[2 * j + 1] - x2h * sn[2 * j + 1]) * sc);
                ob[j] = cvt_pk_bf16((x1l * sn[2 * j] + x2l * cs[2 * j]) * sc, (x1h * sn[2 * j + 1] + x2h * cs[2 * j + 1]) * sc);
            }
            *(uint4*)gp = make_uint4(oa[0], oa[1], oa[2], oa[3]); *(uint4*)(gp + 32) = make_uint4(ob[0], ob[1], ob[2], ob[3]);
        }
    }
}

__device__ __forceinline__ void nattn_witem(const Params& P, int io, int id, const float* rpl  ) {
    const int lane = opaque_tid() & 63, n = lane & 15, quad = lane >> 4;
    const int qb = id & 3, h = (id >> 2) & 7, r = (id >> 5) & 63, b = id >> 11;
    const int rs = min(max(r - 4, 0), 56);
    const int cw = qb == 0 ? 0 : qb == 1 ? 8 : qb == 2 ? 24 : 32;
    const int c = 16 * qb + n, cs = min(max(c - 8, 0), 48);
    const u16* pb = P.p + (size_t)b * L_ * 6144;
    bf16x8 qf[4];
#pragma unroll
    for (int ks = 0; ks < 4; ++ks) qf[ks] = *(const bf16x8*)(pb + (size_t)(r * 64 + c) * 6144 + h * 128 + 32 * ks + 8 * quad);
    f32x4 S[16];
    const int krow = 8 * (n >> 2) + (n & 3);
#pragma unroll
    for (int half = 0; half < 2; ++half) {
        bf16x8 kf[8][4];
#pragma unroll
        for (int t8 = 0; t8 < 8; ++t8) {
            const int kt = half * 8 + t8, kr = kt >> 1, ct = kt & 1;
            const u16* kp = pb + (size_t)((rs + kr) * 64 + cw + krow + 4 * ct) * 6144 + 1024 + h * 128 + 8 * quad;
#pragma unroll
            for (int ks = 0; ks < 4; ++ks) kf[t8][ks] = *(const bf16x8*)(kp + 32 * ks);
        }
#pragma unroll
        for (int t8 = 0; t8 < 8; ++t8) {
            f32x4 acc = (f32x4){0.f, 0.f, 0.f, 0.f};
#pragma unroll
            for (int ks = 0; ks < 4; ++ks) acc = MFMA16(kf[t8][ks], qf[ks], acc);
            S[half * 8 + t8] = acc;
        }
    }
    const float* rp = rpl + h * 465;
    float mx = -1e30f;
#pragma unroll
    for (int kt = 0; kt < 16; ++kt) {
        const int kr = kt >> 1, ct = kt & 1, relr = rs + kr - r + 7;
#pragma unroll
        for (int j = 0; j < 4; ++j) {
            const int kc = cw + 8 * quad + 4 * ct + j; const bool valid = (kc >= cs) && (kc < cs + 16);
            const int relc = min(max(kc - c + 15, 0), 30);
            const float v = valid ? S[kt][j] * 0.08838834764831845f + rp[relr * 31 + relc] : -1e30f;
            S[kt][j] = v; mx = fmaxf(mx, v);
        }
    }
    mx = fmaxf(mx, sx(mx, 16)); mx = fmaxf(mx, sx(mx, 32));
    float sum = 0.f;
#pragma unroll
    for (int kt = 0; kt < 16; ++kt)
#pragma unroll
        for (int j = 0; j < 4; ++j) { const float v = S[kt][j]; const float e = (v > -1e29f) ? __expf(v - mx) : 0.f; S[kt][j] = e; sum += e; }
    sum += sx(sum, 16); sum += sx(sum, 32);
    f32x4 O[8];
#pragma unroll
    for (int dt = 0; dt < 8; ++dt) O[dt] = (f32x4){0.f, 0.f, 0.f, 0.f};
    const u16* vb = P.vcT + ((size_t)(b * 8 + h) * 128) * L_;
#pragma unroll
    for (int kq = 0; kq < 2; ++kq) {
        bf16x8 av[4][8];
#pragma unroll
        for (int k4 = 0; k4 < 4; ++k4) {
            const int tok0 = (rs + kq * 4 + k4) * 64 + cw + 8 * quad;
#pragma unroll
            for (int dt = 0; dt < 8; ++dt) av[k4][dt] = *(const bf16x8*)(vb + (size_t)(16 * dt + n) * L_ + tok0);
        }
#pragma unroll
        for (int k4 = 0; k4 < 4; ++k4) {
            const int kr = kq * 4 + k4;
            V8 pf; pf.u[0] = cvt_pk_bf16(S[2 * kr][0], S[2 * kr][1]); pf.u[1] = cvt_pk_bf16(S[2 * kr][2], S[2 * kr][3]);
            pf.u[2] = cvt_pk_bf16(S[2 * kr + 1][0], S[2 * kr + 1][1]); pf.u[3] = cvt_pk_bf16(S[2 * kr + 1][2], S[2 * kr + 1][3]);
#pragma unroll
            for (int dt = 0; dt < 8; ++dt) O[dt] = MFMA16(av[k4][dt], pf.v, O[dt]);
        }
    }
    const float inv = 1.0f / sum;
    u16* yp = P.y + (size_t)(b * L_ + r * 64 + c) * D_ + h * 128 + 4 * quad;
#pragma unroll
    for (int dt = 0; dt < 8; ++dt) { u32x2 w; w.x = cvt_pk_bf16(O[dt][0] * inv, O[dt][1] * inv); w.y = cvt_pk_bf16(O[dt][2] * inv, O[dt][3] * inv); *(u32x2*)(yp + 16 * dt) = w; }
}

constexpr int NA_ST = 18432;
template <int S_>
__device__ __forceinline__ void na_load_stage(u32x4 (&w)[4], const u16* pb, const u16* vb2, int rs, int h0, int tid) {
    constexpr int kr = S_ & 7;
    if (S_ < 8) {
#pragma unroll
        for (int j = 0; j < 4; ++j) { const int id = j * 512 + tid, tok = id >> 5, c16 = id & 31;
            w[j] = *(const u32x4*)(pb + (size_t)((rs + kr) * 64 + tok) * 6144 + 1024 + h0 * 128 + c16 * 8); }
    } else {
#pragma unroll
        for (int j = 0; j < 4; ++j) { const int id = j * 512 + tid, rowi = id >> 3, c = id & 7;
            w[j] = *(const u32x4*)(vb2 + (size_t)rowi * L_ + (rs + kr) * 64 + c * 8); }
    }
}
template <int S_>
__device__ __forceinline__ void na_write_stage(const u32x4 (&w)[4], u16* buf, int tid) {
    if (S_ < 8) {
#pragma unroll
        for (int j = 0; j < 4; ++j) { const int id = j * 512 + tid, tok = id >> 5, c16 = id & 31; *(u32x4*)(buf + ((c16 >> 4) * 64 + tok) * 136 + (c16 & 15) * 8) = w[j]; }
    } else {
#pragma unroll
        for (int j = 0; j < 4; ++j) { const int id = j * 512 + tid, rowi = id >> 3, c = id & 7; *(u32x4*)(buf + rowi * 72 + c * 8) = w[j]; }
    }
}
__device__ __forceinline__ void nattn_wgitem(const Params& P, int io, int bb, int r, int hp, const float* rpl, u8* shm) {
    const int tid = opaque_tid(), wid = tid >> 6, lane = tid & 63, n = lane & 15, quad = lane >> 4;
    const int hh = wid >> 2, qb = wid & 3, h0 = hp * 2, h = h0 + hh, b = bb;
    const int rs = min(max(r - 4, 0), 56);
    const int cw = qb == 0 ? 0 : qb == 1 ? 8 : qb == 2 ? 24 : 32;
    const int c = 16 * qb + n, cs = min(max(c - 8, 0), 48);
    const u16* pb = P.p + (size_t)b * L_ * 6144;
    const u16* vb2 = P.vcT + ((size_t)(b * 8 + h0) * 128) * L_;
    u16* SB = (u16*)(shm + 16384);
    bf16x8 qf[4];
#pragma unroll
    for (int ks = 0; ks < 4; ++ks) qf[ks] = *(const bf16x8*)(pb + (size_t)(r * 64 + c) * 6144 + h * 128 + 32 * ks + 8 * quad);
    const int krow = 8 * (n >> 2) + (n & 3);
    f32x4 S[16], O[8];
#pragma unroll
    for (int dt = 0; dt < 8; ++dt) O[dt] = (f32x4){0.f, 0.f, 0.f, 0.f};
    float inv = 0.f;
    u32x4 w0[4], w1[4], w2[4];
    __syncthreads();
    na_load_stage<0>(w0, pb, vb2, rs, h0, tid);
    na_load_stage<1>(w1, pb, vb2, rs, h0, tid);
    na_load_stage<2>(w2, pb, vb2, rs, h0, tid);
    na_write_stage<0>(w0, SB, tid);
    __syncthreads();
#define NA_STAGE(S_) do { \
        if ((S_) + 3 < 16) na_load_stage<((S_) + 3) & 15>(((S_) % 3) == 0 ? w0 : ((S_) % 3) == 1 ? w1 : w2, pb, vb2, rs, h0, tid); \
        const u16* buf = SB + ((S_) & 1) * NA_ST; \
        if ((S_) < 8) { \
            _Pragma("unroll") for (int ct = 0; ct < 2; ++ct) { \
                const u16* kp = buf + (hh * 64 + cw + krow + 4 * ct) * 136 + 8 * quad; \
                f32x4 acc = (f32x4){0.f, 0.f, 0.f, 0.f}; \
                _Pragma("unroll") for (int ks = 0; ks < 4; ++ks) { const bf16x8 kf = *(const bf16x8*)(kp + 32 * ks); acc = MFMA16(kf, qf[ks], acc); } \
                S[((S_) & 7) * 2 + ct] = acc; } \
        } else { \
            constexpr int kr = (S_) & 7; \
            V8 pf; pf.u[0] = cvt_pk_bf16(S[2 * kr][0], S[2 * kr][1]); pf.u[1] = cvt_pk_bf16(S[2 * kr][2], S[2 * kr][3]); \
            pf.u[2] = cvt_pk_bf16(S[2 * kr + 1][0], S[2 * kr + 1][1]); pf.u[3] = cvt_pk_bf16(S[2 * kr + 1][2], S[2 * kr + 1][3]); \
            _Pragma("unroll") for (int dt = 0; dt < 8; ++dt) { const bf16x8 av = *(const bf16x8*)(buf + (hh * 128 + 16 * dt + n) * 72 + cw + 8 * quad); O[dt] = MFMA16(av, pf.v, O[dt]); } \
        } \
        if ((S_) == 7) { \
            const float* rp = rpl + h * 465; \
            float mx = -1e30f; \
            _Pragma("unroll") for (int kt = 0; kt < 16; ++kt) { const int kr2 = kt >> 1, ct = kt & 1, relr = rs + kr2 - r + 7; \
                _Pragma("unroll") for (int j = 0; j < 4; ++j) { const int kc = cw + 8 * quad + 4 * ct + j; const bool valid = (kc >= cs) && (kc < cs + 16); \
                    const int relc = min(max(kc - c + 15, 0), 30); \
                    const float v = valid ? S[kt][j] * 0.08838834764831845f + rp[relr * 31 + relc] : -1e30f; S[kt][j] = v; mx = fmaxf(mx, v); } } \
            mx = fmaxf(mx, sx(mx, 16)); mx = fmaxf(mx, sx(mx, 32)); \
            float sum = 0.f; \
            _Pragma("unroll") for (int kt = 0; kt < 16; ++kt) _Pragma("unroll") for (int j = 0; j < 4; ++j) { const float v = S[kt][j]; const float e = (v > -1e29f) ? __expf(v - mx) : 0.f; S[kt][j] = e; sum += e; } \
            sum += sx(sum, 16); sum += sx(sum, 32); inv = 1.0f / sum; \
        } \
        if ((S_) + 1 < 16) na_write_stage<((S_) + 1) & 15>((((S_) + 1) % 3) == 0 ? w0 : (((S_) + 1) % 3) == 1 ? w1 : w2, SB + (((S_) + 1) & 1) * NA_ST, tid); \
        __syncthreads(); \
    } while (0)
    NA_STAGE(0); NA_STAGE(1); NA_STAGE(2); NA_STAGE(3); NA_STAGE(4); NA_STAGE(5); NA_STAGE(6); NA_STAGE(7);
    NA_STAGE(8); NA_STAGE(9); NA_STAGE(10); NA_STAGE(11); NA_STAGE(12); NA_STAGE(13); NA_STAGE(14); NA_STAGE(15);
#undef NA_STAGE
    u16* yp = P.y + (size_t)(b * L_ + r * 64 + c) * D_ + h * 128 + 4 * quad;
#pragma unroll
    for (int dt = 0; dt < 8; ++dt) { u32x2 wv; wv.x = cvt_pk_bf16(O[dt][0] * inv, O[dt][1] * inv); wv.y = cvt_pk_bf16(O[dt][2] * inv, O[dt][3] * inv); *(u32x2*)(yp + 16 * dt) = wv; }
}

constexpr int DA_BUFE = (128 + 128) * 72;
__device__ __forceinline__ void da_iter(const int kt, u32x4 (&wr)[4], u32x4 (&ld)[4], f32x16 (&O)[4], V8 (&pf)[2][2], float& mrun, float& lrun, const bf16x8 (&qf)[4],
                                        u16* SB, const u16* kg0, const u16* vg0, const int mw, const int l31, const int kh, const int lrow, const int lch) {
    constexpr int BUFE = DA_BUFE;
        const u16* Ks = SB + (kt & 1) * BUFE; const u16* Vs = Ks + 128 * 72;
        {
            const int kn = kt + 2 < 64 ? kt + 2 : 63, vn = kt + 1 < 64 ? kt + 1 : 63;
            const u16* kg = kg0 + (size_t)kn * 64 * 6144; const u16* vg = vg0 + vn * 64;
            ld[0] = *(const u32x4*)(kg); ld[1] = *(const u32x4*)(kg + 64); ld[2] = *(const u32x4*)(vg); ld[3] = *(const u32x4*)(vg + (size_t)64 * L_);
        }
        f32x16 s0, s1;
        const float nm = -mrun;
#pragma unroll
        for (int r = 0; r < 16; ++r) { s0[r] = nm; s1[r] = nm; }
        {
            bf16x8 a0[4], a1[4];
#pragma unroll
            for (int ks = 0; ks < 4; ++ks) { a0[ks] = *(const bf16x8*)(Ks + (mw * 64 + l31) * 72 + 16 * ks + 8 * kh); a1[ks] = *(const bf16x8*)(Ks + (mw * 64 + 32 + l31) * 72 + 16 * ks + 8 * kh); }
#pragma unroll
            for (int ks = 0; ks < 4; ++ks) { s0 = MFMA32(a0[ks], qf[ks], s0); s1 = MFMA32(a1[ks], qf[ks], s1); }
        }
        bf16x8 av[2][4];
#pragma unroll
        for (int dt = 0; dt < 4; ++dt) av[0][dt] = *(const bf16x8*)(Vs + (32 * dt + l31) * 72 + 8 * kh);
        float mx = fmaxf(s0[0], s1[0]);
#pragma unroll
        for (int r = 1; r < 16; ++r) mx = fmaxf(fmaxf(mx, s0[r]), s1[r]);
        mx = fmaxf(mx, sx(mx, 32));
        const bool resc = (kt == 0) || (__builtin_amdgcn_ballot_w64(mx > 8.0f) != 0ull);
        float alpha = 1.0f;
        if (resc) {
            const float delta = (kt == 0) ? mx : fmaxf(mx, 0.f);
            alpha = (kt == 0) ? 0.f : __builtin_amdgcn_exp2f(-delta);
#pragma unroll
            for (int r = 0; r < 16; ++r) { s0[r] -= delta; s1[r] -= delta; }
            lrun *= alpha; mrun += delta;
        }
        V8 pn[2][2];
        float ps = 0.f;
#pragma unroll
        for (int tt = 0; tt < 2; ++tt)
#pragma unroll
            for (int ip = 0; ip < 2; ++ip) {
                const int gq = tt * 2 + ip;
                if (gq < 3) {
#pragma unroll
                    for (int dt = 0; dt < 4; ++dt) av[(gq + 1) & 1][dt] = *(const bf16x8*)(Vs + (32 * dt + l31) * 72 + 16 * (gq + 1) + 8 * kh);
                }
#pragma unroll
                for (int dt = 0; dt < 4; ++dt) O[dt] = MFMA32(av[gq & 1][dt], pf[tt][ip].v, O[dt]);
#pragma unroll
                for (int j = 0; j < 4; ++j) {
                    float e0, e1;
                    if (tt == 0) { e0 = __builtin_amdgcn_exp2f(s0[8 * ip + 2 * j]); e1 = __builtin_amdgcn_exp2f(s0[8 * ip + 2 * j + 1]); }
                    else { e0 = __builtin_amdgcn_exp2f(s1[8 * ip + 2 * j]); e1 = __builtin_amdgcn_exp2f(s1[8 * ip + 2 * j + 1]); }
                    ps += e0 + e1;
                    pn[tt][ip].u[j] = cvt_pk_bf16(e0, e1);
                }
            }
        ps += sx(ps, 32);
        lrun += ps;
        if (resc) {
#pragma unroll
            for (int dt = 0; dt < 4; ++dt)
#pragma unroll
                for (int r = 0; r < 16; ++r) O[dt][r] *= alpha;
        }
#pragma unroll
        for (int a = 0; a < 2; ++a)
#pragma unroll
            for (int c = 0; c < 2; ++c) pf[a][c] = pn[a][c];
        {
            u16* nb = SB + ((kt + 1) & 1) * BUFE;
            *(u32x4*)(nb + lrow * 72 + lch * 8) = wr[0]; *(u32x4*)(nb + (64 + lrow) * 72 + lch * 8) = wr[1];
            *(u32x4*)(nb + (128 + lrow) * 72 + lch * 8) = wr[2]; *(u32x4*)(nb + (192 + lrow) * 72 + lch * 8) = wr[3];
        }
        __syncthreads();
}

__device__ __forceinline__ void da_iter_b(const int kt, u32x4 (&wr)[4], u32x4 (&ld)[4], f32x16 (&O)[4], V8 (&pf)[2][2], float& mrun, float& lrun, const bf16x8 (&qf)[4],
                                          u16* SB, const u16* kg0, const u16* vg0, const int mw, const int l31, const int kh, const int lrow, const int lch) {
    constexpr int BUFE = DA_BUFE;
    const u16* Ks = SB + (kt & 1) * BUFE; const u16* Vs = Ks + 128 * 72;
    {
        const int kn = kt + 2 < 64 ? kt + 2 : 63, vn = kt + 1 < 64 ? kt + 1 : 63;
        const u16* kg = kg0 + (size_t)kn * 64 * 6144; const u16* vg = vg0 + vn * 64;
        ld[0] = *(const u32x4*)(kg); ld[1] = *(const u32x4*)(kg + 64); ld[2] = *(const u32x4*)(vg); ld[3] = *(const u32x4*)(vg + (size_t)64 * L_);
    }
    {
        bf16x8 av[2][4];
#pragma unroll
        for (int dt = 0; dt < 4; ++dt) av[0][dt] = *(const bf16x8*)(Vs + (32 * dt + l31) * 72 + 8 * kh);
#pragma unroll
        for (int gq = 0; gq < 4; ++gq) {
            if (gq < 3) {
#pragma unroll
                for (int dt = 0; dt < 4; ++dt) av[(gq + 1) & 1][dt] = *(const bf16x8*)(Vs + (32 * dt + l31) * 72 + 16 * (gq + 1) + 8 * kh);
            }
#pragma unroll
            for (int dt = 0; dt < 4; ++dt) O[dt] = MFMA32(av[gq & 1][dt], pf[gq >> 1][gq & 1].v, O[dt]);
        }
    }
    f32x16 s0, s1;
    const float nm = -mrun;
#pragma unroll
    for (int r = 0; r < 16; ++r) { s0[r] = nm; s1[r] = nm; }
    {
        bf16x8 a0[4], a1[4];
#pragma unroll
        for (int ks = 0; ks < 4; ++ks) { a0[ks] = *(const bf16x8*)(Ks + (mw * 64 + l31) * 72 + 16 * ks + 8 * kh); a1[ks] = *(const bf16x8*)(Ks + (mw * 64 + 32 + l31) * 72 + 16 * ks + 8 * kh); }
#pragma unroll
        for (int ks = 0; ks < 4; ++ks) { s0 = MFMA32(a0[ks], qf[ks], s0); s1 = MFMA32(a1[ks], qf[ks], s1); }
    }
    float mx = fmaxf(s0[0], s1[0]);
#pragma unroll
    for (int r = 1; r < 16; ++r) mx = fmaxf(fmaxf(mx, s0[r]), s1[r]);
    mx = fmaxf(mx, sx(mx, 32));
    const bool resc = (kt == 0) || (__builtin_amdgcn_ballot_w64(mx > 8.0f) != 0ull);
    if (resc) {
        const float delta = (kt == 0) ? mx : fmaxf(mx, 0.f);
        const float alpha = (kt == 0) ? 0.f : __builtin_amdgcn_exp2f(-delta);
#pragma unroll
        for (int r = 0; r < 16; ++r) { s0[r] -= delta; s1[r] -= delta; }
        lrun *= alpha; mrun += delta;
#pragma unroll
        for (int dt = 0; dt < 4; ++dt)
#pragma unroll
            for (int r = 0; r < 16; ++r) O[dt][r] *= alpha;
    }
    float ps = 0.f;
#pragma unroll
    for (int ip = 0; ip < 2; ++ip)
#pragma unroll
        for (int j = 0; j < 4; ++j) {
            const float e0 = __builtin_amdgcn_exp2f(s0[8 * ip + 2 * j]), e1 = __builtin_amdgcn_exp2f(s0[8 * ip + 2 * j + 1]);
            const float f0 = __builtin_amdgcn_exp2f(s1[8 * ip + 2 * j]), f1 = __builtin_amdgcn_exp2f(s1[8 * ip + 2 * j + 1]);
            ps += (e0 + e1) + (f0 + f1);
            pf[0][ip].u[j] = cvt_pk_bf16(e0, e1); pf[1][ip].u[j] = cvt_pk_bf16(f0, f1);
        }
    ps += sx(ps, 32);
    lrun += ps;
    {
        u16* nb = SB + ((kt + 1) & 1) * BUFE;
        *(u32x4*)(nb + lrow * 72 + lch * 8) = wr[0]; *(u32x4*)(nb + (64 + lrow) * 72 + lch * 8) = wr[1];
        *(u32x4*)(nb + (128 + lrow) * 72 + lch * 8) = wr[2]; *(u32x4*)(nb + (192 + lrow) * 72 + lch * 8) = wr[3];
    }
    __syncthreads();
}

__device__ __forceinline__ void da_iter2(const int kt, f32x16 (&sc)[2], f32x16 (&sn)[2], u32x4 (&wr)[4], u32x4 (&ld)[4], f32x16 (&O)[4], V8 (&pf)[2][2], float& mrun, float& lrun,
                                         const bf16x8 (&qf)[4], u16* SB, const u16* kg0, const u16* vg0, const int mw, const int l31, const int kh, const int lrow, const int lch) {
    constexpr int BUFE = DA_BUFE;
    const u16* Ks = SB + (kt & 1) * BUFE; const u16* Vs = Ks + 128 * 72;
    {
        const int kn = kt + 3 < 64 ? kt + 3 : 63, vn = kt + 1 < 64 ? kt + 1 : 63;
        const u16* kg = kg0 + (size_t)kn * 64 * 6144; const u16* vg = vg0 + vn * 64;
        ld[0] = *(const u32x4*)(kg); ld[1] = *(const u32x4*)(kg + 64); ld[2] = *(const u32x4*)(vg); ld[3] = *(const u32x4*)(vg + (size_t)64 * L_);
    }
    {
        bf16x8 a0[4], a1[4];
#pragma unroll
        for (int ks = 0; ks < 4; ++ks) { a0[ks] = *(const bf16x8*)(Ks + (mw * 64 + l31) * 72 + 16 * ks + 8 * kh); a1[ks] = *(const bf16x8*)(Ks + (mw * 64 + 32 + l31) * 72 + 16 * ks + 8 * kh); }
        f32x16 z;
#pragma unroll
        for (int r = 0; r < 16; ++r) z[r] = 0.f;
        sn[0] = MFMA32(a0[0], qf[0], z); sn[1] = MFMA32(a1[0], qf[0], z);
#pragma unroll
        for (int ks = 1; ks < 4; ++ks) { sn[0] = MFMA32(a0[ks], qf[ks], sn[0]); sn[1] = MFMA32(a1[ks], qf[ks], sn[1]); }
    }
    float mx = fmaxf(sc[0][0], sc[1][0]);
#pragma unroll
    for (int r = 1; r < 16; ++r) mx = fmaxf(fmaxf(mx, sc[0][r]), sc[1][r]);
    mx = fmaxf(mx, sx(mx, 32));
    const bool resc = (kt == 0) || (__builtin_amdgcn_ballot_w64(mx - mrun > 8.0f) != 0ull);
    float alpha = 1.0f;
    if (resc) {
        const float mnew = (kt == 0) ? mx : fmaxf(mrun, mx);
        alpha = (kt == 0) ? 0.f : __builtin_amdgcn_exp2f(mrun - mnew);
        lrun *= alpha; mrun = mnew;
    }
    V8 pn[2][2];
    float ps = 0.f;
    bf16x8 av[2][4];
#pragma unroll
    for (int dt = 0; dt < 4; ++dt) av[0][dt] = *(const bf16x8*)(Vs + (32 * dt + l31) * 72 + 8 * kh);
#pragma unroll
    for (int tt = 0; tt < 2; ++tt)
#pragma unroll
        for (int ip = 0; ip < 2; ++ip) {
            const int gq = tt * 2 + ip;
            if (gq < 3) {
#pragma unroll
                for (int dt = 0; dt < 4; ++dt) av[(gq + 1) & 1][dt] = *(const bf16x8*)(Vs + (32 * dt + l31) * 72 + 16 * (gq + 1) + 8 * kh);
            }
#pragma unroll
            for (int dt = 0; dt < 4; ++dt) O[dt] = MFMA32(av[gq & 1][dt], pf[tt][ip].v, O[dt]);
#pragma unroll
            for (int j = 0; j < 4; ++j) {
                const float e0 = __builtin_amdgcn_exp2f(sc[tt][8 * ip + 2 * j] - mrun), e1 = __builtin_amdgcn_exp2f(sc[tt][8 * ip + 2 * j + 1] - mrun);
                ps += e0 + e1;
                pn[tt][ip].u[j] = cvt_pk_bf16(e0, e1);
            }
        }
    ps += sx(ps, 32);
    lrun += ps;
    if (resc) {
#pragma unroll
        for (int dt = 0; dt < 4; ++dt)
#pragma unroll
            for (int r = 0; r < 16; ++r) O[dt][r] *= alpha;
    }
#pragma unroll
    for (int a = 0; a < 2; ++a)
#pragma unroll
        for (int c = 0; c < 2; ++c) pf[a][c] = pn[a][c];
    {
        u16* nb = SB + ((kt + 1) & 1) * BUFE;
        *(u32x4*)(nb + lrow * 72 + lch * 8) = wr[0]; *(u32x4*)(nb + (64 + lrow) * 72 + lch * 8) = wr[1];
        *(u32x4*)(nb + (128 + lrow) * 72 + lch * 8) = wr[2]; *(u32x4*)(nb + (192 + lrow) * 72 + lch * 8) = wr[3];
    }
    __syncthreads();
}

__device__ __forceinline__ void dattn_item(const Params& P, int io, float lam_init, int item, u8* shm) {
    const int tid = opaque_tid(), wid = tid >> 6, lane = tid & 63, l31 = lane & 31, kh = lane >> 5, mw = wid >> 2, qw = wid & 3;
    const int qb = item & 31, h = (item >> 5) & 7, b = item >> 8;
    const float* lp = P.in[24] + io * 256;
    const float sa = wave_sum(lp[lane] * lp[64 + lane]), sc = wave_sum(lp[128 + lane] * lp[192 + lane]);
    const float lam = expf(sa) - expf(sc) + lam_init;
    const int tq = qb * 128 + 32 * qw + l31;
    const u16* pb = P.p + (size_t)b * L_ * 6144;
    const u16* qrow = pb + (size_t)tq * 6144 + 3072 + h * 128 + mw * 64;
    bf16x8 qf[4];
#pragma unroll
    for (int ks = 0; ks < 4; ++ks) qf[ks] = *(const bf16x8*)(qrow + 16 * ks + 8 * kh);
    f32x16 O[4];
#pragma unroll
    for (int dt = 0; dt < 4; ++dt)
#pragma unroll
        for (int r = 0; r < 16; ++r) O[dt][r] = 0.f;
    float mrun = 0.f, lrun = 0.f;
    constexpr int BUFE = (128 + 128) * 72;
    u16* SB = (u16*)shm;
    const u16* vb = P.vdT + ((size_t)(b * 8 + h) * 128) * L_;
    const int lrow = tid >> 3, lch = tid & 7;
    const u16* kg0 = pb + (size_t)lrow * 6144 + 4096 + h * 128 + lch * 8;
    const u16* vg0 = vb + (size_t)lrow * L_ + lch * 8;
    u32x4 wA[4], wB[4];
    f32x16 sA[2], sB[2];
    __syncthreads();
    {
        const u32x4 k0a = *(const u32x4*)(kg0), k0b = *(const u32x4*)(kg0 + 64);
        const u32x4 k1a = *(const u32x4*)(kg0 + (size_t)64 * 6144), k1b = *(const u32x4*)(kg0 + (size_t)64 * 6144 + 64);
        wA[0] = *(const u32x4*)(kg0 + (size_t)128 * 6144); wA[1] = *(const u32x4*)(kg0 + (size_t)128 * 6144 + 64); wA[2] = *(const u32x4*)(vg0); wA[3] = *(const u32x4*)(vg0 + (size_t)64 * L_);
        u16* B1 = SB + DA_BUFE;
        *(u32x4*)(B1 + lrow * 72 + lch * 8) = k0a; *(u32x4*)(B1 + (64 + lrow) * 72 + lch * 8) = k0b;
        *(u32x4*)(SB + lrow * 72 + lch * 8) = k1a; *(u32x4*)(SB + (64 + lrow) * 72 + lch * 8) = k1b;
        *(uint4*)(SB + (128 + lrow) * 72 + lch * 8) = make_uint4(0, 0, 0, 0); *(uint4*)(SB + (192 + lrow) * 72 + lch * 8) = make_uint4(0, 0, 0, 0);
    }
    __syncthreads();
    {
        const u16* Ks = SB + DA_BUFE;
        bf16x8 a0[4], a1[4];
#pragma unroll
        for (int ks = 0; ks < 4; ++ks) { a0[ks] = *(const bf16x8*)(Ks + (mw * 64 + l31) * 72 + 16 * ks + 8 * kh); a1[ks] = *(const bf16x8*)(Ks + (mw * 64 + 32 + l31) * 72 + 16 * ks + 8 * kh); }
#pragma unroll
        for (int r = 0; r < 16; ++r) { sA[0][r] = 0.f; sA[1][r] = 0.f; }
#pragma unroll
        for (int ks = 0; ks < 4; ++ks) { sA[0] = MFMA32(a0[ks], qf[ks], sA[0]); sA[1] = MFMA32(a1[ks], qf[ks], sA[1]); }
    }
    __syncthreads();
    V8 pf[2][2];
#pragma unroll
    for (int a = 0; a < 2; ++a)
#pragma unroll
        for (int c = 0; c < 2; ++c) pf[a][c].q = make_uint4(0, 0, 0, 0);
#pragma unroll 1
    for (int kt2 = 0; kt2 < 64; kt2 += 2) {
        da_iter2(kt2, sA, sB, wA, wB, O, pf, mrun, lrun, qf, SB, kg0, vg0, mw, l31, kh, lrow, lch);
        da_iter2(kt2 + 1, sB, sA, wB, wA, O, pf, mrun, lrun, qf, SB, kg0, vg0, mw, l31, kh, lrow, lch);
    }
    {
        const u16* Vs = SB + 128 * 72;
#pragma unroll
        for (int tt = 0; tt < 2; ++tt)
#pragma unroll
            for (int ip = 0; ip < 2; ++ip)
#pragma unroll
                for (int dt = 0; dt < 4; ++dt) {
                    const bf16x8 av = *(const bf16x8*)(Vs + (32 * dt + l31) * 72 + 32 * tt + 16 * ip + 8 * kh);
                    O[dt] = MFMA32(av, pf[tt][ip].v, O[dt]);
                }
    }
    __syncthreads();
    float* comb = (float*)shm;
    const float inv = 1.0f / lrun;
    if (mw == 1) {
#pragma unroll
        for (int dt = 0; dt < 4; ++dt)
#pragma unroll
            for (int i4 = 0; i4 < 4; ++i4) {
                const int d = 32 * dt + 8 * i4 + 4 * kh;
                *(float4*)(comb + (32 * qw + l31) * 132 + d) = make_float4(O[dt][4 * i4] * inv, O[dt][4 * i4 + 1] * inv, O[dt][4 * i4 + 2] * inv, O[dt][4 * i4 + 3] * inv);
            }
    }
    __syncthreads();
    if (mw == 0) {
        float ss = 0.f;
#pragma unroll
        for (int dt = 0; dt < 4; ++dt)
#pragma unroll
            for (int i4 = 0; i4 < 4; ++i4) {
                const int d = 32 * dt + 8 * i4 + 4 * kh;
                const float4 o1 = *(const float4*)(comb + (32 * qw + l31) * 132 + d);
                const float a0 = O[dt][4 * i4] * inv - lam * o1.x, a1 = O[dt][4 * i4 + 1] * inv - lam * o1.y, a2 = O[dt][4 * i4 + 2] * inv - lam * o1.z, a3 = O[dt][4 * i4 + 3] * inv - lam * o1.w;
                O[dt][4 * i4] = a0; O[dt][4 * i4 + 1] = a1; O[dt][4 * i4 + 2] = a2; O[dt][4 * i4 + 3] = a3;
                ss += a0 * a0 + a1 * a1 + a2 * a2 + a3 * a3;
            }
        ss += sx(ss, 32);
        const float rstd = rsqrtf(ss * (1.0f / 128.0f) + 1e-6f) * (1.0f - lam_init);
        const float* sg = P.in[25] + io * 128;
        u16* yp = P.y + (size_t)(b * L_ + tq) * D_ + 1024 + h * 128;
#pragma unroll
        for (int dt = 0; dt < 4; ++dt)
#pragma unroll
            for (int i4 = 0; i4 < 4; ++i4) {
                const int d = 32 * dt + 8 * i4 + 4 * kh;
                const float4 g4 = *(const float4*)(sg + d);
                u32x2 w; w.x = cvt_pk_bf16(O[dt][4 * i4] * rstd * g4.x, O[dt][4 * i4 + 1] * rstd * g4.y); w.y = cvt_pk_bf16(O[dt][4 * i4 + 2] * rstd * g4.z, O[dt][4 * i4 + 3] * rstd * g4.w);
                *(u32x2*)(yp + d) = w;
            }
    }
}

__device__ __forceinline__ void cgfix_phase(const Params& P, int l) {
    const float* cw = P.in[5] + (size_t)l * 3 * F2_; const float* cb = P.in[6] + (size_t)l * F2_;
    const int nth = gridDim.x * 512;
    for (int idx = blockIdx.x * 512 + opaque_tid(); idx < 257 * 2 * 704; idx += nth) {
        const int chunk = idx % 704, t = idx / 704, which = t & 1, k = t >> 1, f0 = chunk * 8;
        const int row = which ? 64 * k : 64 * k - 1;
        if (row < 0 || row >= T_) continue;
        const int s0 = row & 4095;
        const int rp = row - 1, rn = row + 1;
        const u16* ec = P.edge + (size_t)((row >> 6) * 4 + ((row & 63) < 2 ? (row & 63) : (row & 63) - 60)) * F2_ + f0;
        const uint4 zero = make_uint4(0, 0, 0, 0);
        uint4 pg = zero, pv = zero, ng = zero, nv = zero;
        if (s0 > 0) { const u16* ep = P.edge + (size_t)((rp >> 6) * 4 + ((rp & 63) < 2 ? (rp & 63) : (rp & 63) - 60)) * F2_ + f0; pg = *(const uint4*)ep; pv = *(const uint4*)(ep + F_); }
        if (s0 < 4095) { const u16* en = P.edge + (size_t)((rn >> 6) * 4 + ((rn & 63) < 2 ? (rn & 63) : (rn & 63) - 60)) * F2_ + f0; ng = *(const uint4*)en; nv = *(const uint4*)(en + F_); }
        const uint4 cg_ = *(const uint4*)ec, cv = *(const uint4*)(ec + F_);
        const unsigned a0[4] = {pg.x, pg.y, pg.z, pg.w}, a1[4] = {cg_.x, cg_.y, cg_.z, cg_.w}, a2[4] = {ng.x, ng.y, ng.z, ng.w};
        const unsigned c0[4] = {pv.x, pv.y, pv.z, pv.w}, c1[4] = {cv.x, cv.y, cv.z, cv.w}, c2[4] = {nv.x, nv.y, nv.z, nv.w};
        unsigned ow[4];
#pragma unroll
        for (int j = 0; j < 4; ++j) {
            const int fa = f0 + 2 * j, fb = fa + 1;
            const float gl = cw[fa] * bflo(a0[j]) + cw[F2_ + fa] * bflo(a1[j]) + cw[2 * F2_ + fa] * bflo(a2[j]) + cb[fa];
            const float gh = cw[fb] * bfhi(a0[j]) + cw[F2_ + fb] * bfhi(a1[j]) + cw[2 * F2_ + fb] * bfhi(a2[j]) + cb[fb];
            const float vl = cw[F_ + fa] * bflo(c0[j]) + cw[F2_ + F_ + fa] * bflo(c1[j]) + cw[2 * F2_ + F_ + fa] * bflo(c2[j]) + cb[F_ + fa];
            const float vh = cw[F_ + fb] * bfhi(c0[j]) + cw[F2_ + F_ + fb] * bfhi(c1[j]) + cw[2 * F2_ + F_ + fb] * bfhi(c2[j]) + cb[F_ + fb];
            ow[j] = cvt_pk_bf16(gl / (1.0f + __expf(-gl)) * vl, gh / (1.0f + __expf(-gh)) * vh);
        }
        *(uint4*)(P.gated + (size_t)row * F_ + f0) = make_uint4(ow[0], ow[1], ow[2], ow[3]);
    }
}
__device__ __forceinline__ void cgtab_phase(const Params& P) {
    const int nth = gridDim.x * 512;
    for (int idx = blockIdx.x * 512 + opaque_tid(); idx < 4 * 44 * 1024; idx += nth) {
        const int c = idx & 255, k = (idx >> 8) & 3, pn = (idx >> 10) % 44, l = idx / (44 * 1024);
        const int col = (c >> 7) * F_ + 128 * pn + (c & 127);
        P.cgtab[idx] = k < 3 ? P.in[5][((size_t)l * 3 + k) * F2_ + col] : P.in[6][(size_t)l * F2_ + col];
    }
}

__device__ __forceinline__ int rstd_table(const float* ssp, const pg8::StaticOrder& S, u8* shm) {
    PG8_LAS float* rt = (PG8_LAS float*)((PG8_LAS u8*)shm + 131072);
    pg8::Unit u0; if (!S.next(0, u0)) return -1;
    const int tid = opaque_tid();
    const float4* sp = (const float4*)(ssp + (size_t)(u0.pm * 256 + (tid >> 1)) * 32 + (tid & 1) * 16);
    const float4 a = sp[0], b = sp[1], c = sp[2], d = sp[3];
    float s = ((a.x + a.y) + (a.z + a.w)) + ((b.x + b.y) + (b.z + b.w)) + ((c.x + c.y) + (c.z + c.w)) + ((d.x + d.y) + (d.z + d.w));
    s += sx(s, 1);
    if ((tid & 1) == 0) rt[tid >> 1] = rsqrtf(s * (1.0f / D_) + 1e-6f);
    __syncthreads();
    return u0.pm;
}

template <int OP>
__device__ __forceinline__ void run_op(const Params& P, const int l, const int which, u8* shm) {
    constexpr int op = OP; const int i = l >> 1;
    PG8_LAS u8* lds = (PG8_LAS u8*)shm;
    switch (op) {
    case OP_PRE: {
        const int total = P.cw_t0[16];
        for (int tile = blockIdx.x; tile < total; tile += gridDim.x) {
            int mi = 0;
#pragma unroll 1
            for (int k = 1; k < 16; ++k) if (tile >= P.cw_t0[k]) mi = k;
            convT_tile(P.cw_src[mi], P.cw_K[mi], P.cw_N[mi], P.cw_dst[mi], P.cw_g[mi], P.cw_perm[mi], tile - P.cw_t0[mi], shm);
        }
        hf1_phase(P);
        cgtab_phase(P);
        xprep_phase(P.in[0], P.h, P.ssp);
    } break;
    case OP_HF2: {
        for (int id = blockIdx.x; id < 512; id += gridDim.x) hf2_item(P, id, shm);
    } break;
    case OP_NORM: {
        if (which == 0) norm_phase(P.x, P.in[1] + l * D_, P.h, nullptr);
        else if (which == 1) norm_phase(P.x, P.in[2] + l * D_, P.h, nullptr);
        else norm_phase(P.x, P.in[8], nullptr, P.x);
    } break;
    case OP_GEMM_IN: {
        const int N = (l & 1) ? 6144 : 5120;
        pg8::Gemm g{P.h, P.wt_in[l], T_, N, D_};
        pg8::StaticOrder S; S.init(T_, N, gridDim.x, blockIdx.x);
        const int pm0 = rstd_table(P.ssp, S, shm);
        EpiStoreBf16 E{P.p, N, (l & 1) ? 0 : 2048, P.ssp, (const PG8_LAS float*)(lds + 131072), pm0};
        pg8::gemm_phase<EpiStoreBf16, pg8::StaticOrder, false>(lds, g, S, E, nullptr);
    } break;
    case OP_GEMM_UP: {
        pg8::Gemm g{P.h, P.wt_up[l], T_, F2_, D_};
        CgOrder S; S.init(T_, F2_, gridDim.x, blockIdx.x); S.tab = P.cgtab + (size_t)l * 44 * 1024; S.ldsb = lds;
        (void)rstd_table(P.ssp, S, shm);
        EpiGate E{P.gated, P.edge, (const PG8_LAS float*)(lds + LDS_RT), (const PG8_LAS float*)(lds + LDS_CGT)};
        pg8::gemm_phase<EpiGate, CgOrder, false>(lds, g, S, E, nullptr);
    } break;
    case OP_GEMM_OUT: {
        pg8::Gemm g{P.y, P.wt_out[l], T_, D_, D_};
        pg8::StaticOrder S; S.init(T_, D_, gridDim.x, blockIdx.x);
        EpiResid E{l == 0 ? P.in[0] : P.x, P.x, P.h, P.ssp};
        pg8::gemm_phase<EpiResid, pg8::StaticOrder, false>(lds, g, S, E, nullptr);
    } break;
    case OP_GEMM_DOWN: {
        pg8::Gemm g{P.gated, P.wt_down[l], T_, D_, F_};
        pg8::StaticOrder S; S.init(T_, D_, gridDim.x, blockIdx.x);
        EpiResid E{P.x, P.x, l == 3 ? (u16*)nullptr : P.h, P.ssp};
        pg8::gemm_phase<EpiResid, pg8::StaticOrder, false>(lds, g, S, E, nullptr);
    } break;
    case OP_EVEN_A: {
        for (int it = blockIdx.x; it < 256; it += gridDim.x) gmlp_item(P, i, it, shm);
        for (int tile = blockIdx.x; tile < 48 * 256; tile += 8 * gridDim.x)
            tr_tile<8>(P.p, 5120, 2048, 48, P.pT, (size_t)4 * L_, (size_t)L_, P.in[13] + (size_t)i * 3 * 3072, P.in[14] + (size_t)i * 3072, 3072, tile, gridDim.x, 48 * 256, shm);
    } break;
    case OP_HC: {
        {
            uint4* zp = (uint4*)((u16*)shm + 64 + 2 * FS);
            __syncthreads();
            unsigned z0 = 0u; asm volatile("" : "+v"(z0));
            for (int e = opaque_tid(); e < (2 * 4 * HU_B) / 8; e += 512) zp[e] = make_uint4(z0, z0, z0, z0);
            __syncthreads();
        }
        for (int c = blockIdx.x; c < 1024; c += gridDim.x) hconv_item(P, i, c, shm);
    } break;
    case OP_HB: {
        for (int tile = blockIdx.x; tile < 4096; tile += 8 * gridDim.x) trback_tile<8>(P.yT, P.y, tile, gridDim.x, 4096, shm);
    } break;
    case OP_ODD_PREP: {
        rotary_phase(P);
        for (int tile = blockIdx.x; tile < 16 * 256; tile += 8 * gridDim.x)
            tr_tile<8>(P.p, 6144, 2048, 16, P.vcT, (size_t)L_, (size_t)1024 * L_, nullptr, nullptr, 0, tile, gridDim.x, 16 * 256, shm);
        for (int tile = blockIdx.x; tile < 16 * 256; tile += 8 * gridDim.x)
            tr_tile<8>(P.p, 6144, 5120, 16, P.vdT, (size_t)L_, (size_t)1024 * L_, nullptr, nullptr, 0, tile, gridDim.x, 16 * 256, shm, true);
    } break;
    case OP_ATTN: {
        const float lam_init = 0.8f - 0.6f * expf(-0.3f * (float)l);
        for (int it = blockIdx.x; it < 1024; it += gridDim.x) {
            const int rnd = it / (int)gridDim.x, cidx = it - rnd * (int)gridDim.x;
            const int itm = (gridDim.x == 256) ? (((rnd * 8 + (cidx & 7)) << 5) + (cidx >> 3)) : it;
            dattn_item(P, i, lam_init, itm, shm);
        }
        const int wid = opaque_tid() >> 6;
        float* rpl = (float*)shm;
        __syncthreads();
        for (int e = opaque_tid(); e < 8 * 465; e += 512) rpl[e] = P.in[23][(size_t)i * 8 * 465 + e];
        __syncthreads();
        for (int wg = blockIdx.x; wg < 1024; wg += gridDim.x) {
            int bb, row, hp;
            if (gridDim.x == 256) { const int rnd = wg >> 8, cidx = wg & 255, pr = (cidx & 7) * 2 + (rnd >> 1); bb = pr >> 2; hp = pr & 3; row = (rnd & 1) * 32 + (cidx >> 3); }
            else { hp = wg & 3; row = (wg >> 2) & 63; bb = wg >> 8; }
            nattn_wgitem(P, i, bb, row, hp, rpl, shm);
        }
#ifdef PROBE_NA
        for (int wg = blockIdx.x; wg < 1024; wg += gridDim.x) {
            const int rnd = wg >> 8, cidx = wg & 255, pr = (cidx & 7) * 2 + (rnd >> 1); const int bb = pr >> 2, hp = pr & 3, row = (rnd & 1) * 32 + (cidx >> 3);
            const int id = (bb << 11) | (row << 5) | (((hp << 1) | (wid >> 2)) << 2) | (wid & 3);
            nattn_witem(P, i, id, rpl);
        }
#endif
#ifdef PROBE_DA
        for (int it = blockIdx.x; it < 1024; it += gridDim.x) dattn_item(P, i, lam_init, it, shm);
#endif
    } break;
    case OP_CG: cgfix_phase(P, l); break;

    }
}

#if MEGA
__global__ __launch_bounds__(512, 2) void k_mega(Params P) {
    extern __shared__ __attribute__((aligned(16))) u8 shm[];
    cg::grid_group grid = cg::this_grid();
    volatile LAS unsigned* xst = (volatile LAS unsigned*)((LAS u8*)shm + LDS_XST);
    if (threadIdx.x < 4) xst[threadIdx.x] = 0u;
    __syncthreads();
    (void)xcd_barrier_post(P.bar, xst);
#define XSYNC() do { XcdBarrier b_; b_.bar = P.bar; b_.x = xb_xcc_id(); b_.st = xst; xcd_barrier(b_); } while (0)
#ifndef PROBE_MASK
#define PROBE_MASK 0
#endif
#define RUNP(OP, L) do { for (int r_ = 0; r_ < (((PROBE_MASK >> (OP)) & 1) ? 2 : 1); ++r_) { run_op<OP>(P, (L), 0, shm); XSYNC(); } } while (0)
    run_op<OP_PRE>(P, 0, 0, shm);
    if (P.nsteps == -12345) grid.sync();
    XSYNC();
    if ((PROBE_MASK >> OP_PRE) & 1) { run_op<OP_PRE>(P, 0, 0, shm); XSYNC(); }
    RUNP(OP_HF2, 0);
#pragma unroll 1
    for (int l = 0; l < 4; ++l) {
        RUNP(OP_GEMM_IN, l);
        if ((l & 1) == 0) { RUNP(OP_EVEN_A, l); RUNP(OP_HC, l); RUNP(OP_HB, l); }
        else { run_op<OP_ODD_PREP>(P, l, 0, shm); XSYNC(); RUNP(OP_ATTN, l); }
        run_op<OP_GEMM_OUT>(P, l, 0, shm); XSYNC();
        RUNP(OP_GEMM_UP, l);
        RUNP(OP_CG, l);
        run_op<OP_GEMM_DOWN>(P, l, 0, shm); XSYNC();
    }
    run_op<OP_NORM>(P, 3, 2, shm);
}
#else
__global__ __launch_bounds__(512, 2) void k_step(Params P, int step) {
    extern __shared__ __attribute__((aligned(16))) u8 shm[];
    const int l = P.lyr[step], a = P.arg[step];
    switch (P.ops[step]) {
    case OP_PRE: run_op<OP_PRE>(P, l, a, shm); break; case OP_HF2: run_op<OP_HF2>(P, l, a, shm); break; case OP_NORM: run_op<OP_NORM>(P, l, a, shm); break;
    case OP_GEMM_IN: run_op<OP_GEMM_IN>(P, l, a, shm); break; case OP_EVEN_A: run_op<OP_EVEN_A>(P, l, a, shm); break; case OP_HC: run_op<OP_HC>(P, l, a, shm); break;
    case OP_HB: run_op<OP_HB>(P, l, a, shm); break; case OP_ODD_PREP: run_op<OP_ODD_PREP>(P, l, a, shm); break; case OP_ATTN: run_op<OP_ATTN>(P, l, a, shm); break;
    case OP_GEMM_OUT: run_op<OP_GEMM_OUT>(P, l, a, shm); break; case OP_GEMM_UP: run_op<OP_GEMM_UP>(P, l, a, shm); break; case OP_CG: run_op<OP_CG>(P, l, a, shm); break;
    case OP_GEMM_DOWN: run_op<OP_GEMM_DOWN>(P, l, a, shm); break;
    }
}
#endif

extern "C" void kernel_launch(void* const* d_in, const int* in_sizes, int n_in, void* d_out, int out_size, void* d_ws, size_t ws_size, hipStream_t stream) {
    Params P; std::memset((void*)&P, 0, sizeof(P));
    for (int k = 0; k < 26; ++k) P.in[k] = (const float*)d_in[k];
    P.x = (float*)d_out;
    char* ws = (char*)d_ws; size_t off = 0;
    auto take = [&](size_t bytes) { char* r = ws + off; off += (bytes + 255) & ~(size_t)255; return r; };
    int nm = 0, t0 = 0;
    auto addw = [&](const float* src, int K, int N, u16* dst, const float* g) { P.cw_src[nm] = src; P.cw_dst[nm] = dst; P.cw_g[nm] = g; P.cw_perm[nm] = (N == F2_) ? 1 : 0; P.cw_K[nm] = K; P.cw_N[nm] = N; P.cw_t0[nm] = t0; t0 += (K / 64) * (N / 256); ++nm; };
    for (int l = 0; l < 4; ++l) {
        const int N = (l & 1) ? 6144 : 5120, i = l >> 1;
        P.wt_in[l] = (u16*)take((size_t)N * D_ * 2);
        P.wt_out[l] = (u16*)take((size_t)D_ * D_ * 2);
        P.wt_up[l] = (u16*)take((size_t)F2_ * D_ * 2);
        P.wt_down[l] = (u16*)take((size_t)D_ * F_ * 2);
        addw(((l & 1) ? P.in[22] : P.in[9]) + (size_t)i * D_ * N, D_, N, P.wt_in[l], P.in[1] + (size_t)l * D_);
        addw(P.in[3] + (size_t)l * D_ * D_, D_, D_, P.wt_out[l], nullptr);
        addw(P.in[4] + (size_t)l * D_ * F2_, D_, F2_, P.wt_up[l], P.in[2] + (size_t)l * D_);
        addw(P.in[7] + (size_t)l * F_ * D_, F_, D_, P.wt_down[l], nullptr);
    }
    P.cw_t0[16] = t0; P.cw_t0[17] = 0;
    P.h = (u16*)take((size_t)T_ * D_ * 2);
    P.y = (u16*)take((size_t)T_ * D_ * 2);
    char* r1 = take((size_t)T_ * F2_ * 2);
    P.up = (u16*)r1; P.p = (u16*)r1;
    P.pT = (u16*)(r1 + (size_t)T_ * 6144 * 2); P.yT = (u16*)(r1 + (size_t)T_ * 6144 * 2 + (size_t)3072 * T_ * 2);
    P.vcT = (u16*)(r1 + (size_t)T_ * 6144 * 2); P.vdT = (u16*)(r1 + (size_t)T_ * 6144 * 2 + (size_t)1024 * T_ * 2);
    P.gated = (u16*)take((size_t)T_ * F_ * 2);
    P.filt = (u16*)take((size_t)4096 * FS * 2);
    P.invn = (float*)take(4096 * 4);
    P.h2tab = (float*)take((size_t)2 * L_ * 64 * 4);
    P.ssp = (float*)take((size_t)T_ * 32 * 4);
    P.bar = (unsigned*)take((size_t)XCD_BAR_WORDS * 4);
    P.edge = (u16*)take((size_t)(T_ / 64) * 4 * F2_ * 2);
    P.cgtab = (float*)take((size_t)4 * 44 * 1024 * 4);
    if (off > ws_size) { fprintf(stderr, "workspace too small: need %zu have %zu\n", off, ws_size); }
    int ns = 0;
#ifndef PROBE_SET
#define PROBE_SET_ 0
#else
#define PROBE_SET_ PROBE_SET
#endif
    auto add = [&](int op, int l, int a) { P.ops[ns] = op; P.lyr[ns] = l; P.arg[ns] = a; P.rep[ns] = (((PROBE_SET_ >> op) & 1) && !(op == OP_NORM && a == 2)) ? 2 : 1; ++ns; };
    add(OP_PRE, 0, 0); add(OP_HF2, 0, 0);
    for (int l = 0; l < 4; ++l) {
        add(OP_GEMM_IN, l, 0);
        if ((l & 1) == 0) { add(OP_EVEN_A, l, 0); add(OP_HC, l, 0); add(OP_HB, l, 0); }
        else { add(OP_ODD_PREP, l, 0); add(OP_ATTN, l, 0); }
        add(OP_GEMM_OUT, l, 0); add(OP_GEMM_UP, l, 0); add(OP_CG, l, 0); add(OP_GEMM_DOWN, l, 0);
        if (l == 3) add(OP_NORM, l, 2);
    }
    P.nsteps = ns;
#if MEGA
    static int grid_blocks = 0;
    if (!grid_blocks) {
        (void)hipFuncSetAttribute((const void*)k_mega, hipFuncAttributeMaxDynamicSharedMemorySize, LDS_BYTES);
        int dev = 0, cus = 0, per_cu = 0;
        (void)hipGetDevice(&dev);
        (void)hipDeviceGetAttribute(&cus, hipDeviceAttributeMultiprocessorCount, dev);
        (void)hipOccupancyMaxActiveBlocksPerMultiprocessor(&per_cu, k_mega, 512, LDS_BYTES);
        if (per_cu < 1) per_cu = 1;
        grid_blocks = cus * 1;
    }
    (void)hipMemsetAsync(P.bar, 0, (size_t)XCD_BAR_WORDS * 4, stream);
    void* args[] = {&P};
    hipError_t e = hipLaunchCooperativeKernel((void*)k_mega, dim3(grid_blocks), dim3(512), args, LDS_BYTES, stream);
    if (e != hipSuccess) fprintf(stderr, "cooperative launch failed: %s (grid %d)\n", hipGetErrorString(e), grid_blocks);
#else
    static int inited = 0;
    if (!inited) { (void)hipFuncSetAttribute((const void*)k_step, hipFuncAttributeMaxDynamicSharedMemorySize, LDS_BYTES); inited = 1; }
    for (int s = 0; s < ns; ++s) k_step<<<256, 512, LDS_BYTES, stream>>>(P, s);
#endif
}
```

```cpp
#include <hip/hip_runtime.h>
#include <hip/hip_cooperative_groups.h>
#include <cstdio>
#include <cstring>
namespace cg = cooperative_groups;
#ifndef MEGA
#define MEGA 1
#endif
__device__ __forceinline__ int opaque_tid() { int t = (int)threadIdx.x; asm volatile("" : "+v"(t)); return t; }
namespace pg8 {
#define PG8_LAS __attribute__((address_space(3)))
typedef unsigned short bf16_t;
typedef short bf16x8 __attribute__((ext_vector_type(8)));
typedef float f32x4 __attribute__((ext_vector_type(4)));
typedef unsigned u32x4 __attribute__((ext_vector_type(4)));
constexpr int BM = 256, BK = 64, HALF = 128, HTB = HALF * BK * 2  , STAGE_BYTES = 8 * HTB, NXCD = 8, WGM = 8;

__host__ __device__ __forceinline__ int lds_byte(int r, int c) { const int st = (r >> 4) * 2 + (c >> 5), rr = r & 15, cc = c & 31, ob = rr * 64 + cc * 2; return st * 1024 + (ob ^ (((ob >> 9) & 1) << 5)); }
__host__ __device__ __forceinline__ void stage_rc(int b, int& R, int& C) { const int st = b / 1024, sb = b % 1024, swz = sb ^ (((sb >> 9) & 1) << 5); R = (st >> 1) * 16 + swz / 64; C = (st & 1) * 32 + (swz % 64) / 2; }
__host__ __device__ __forceinline__ int perm32(int rho) { const int n = rho >> 4, i = rho & 15; return 8 * (i >> 2) + 4 * n + (i & 3); }

struct Unit { int pm, pn; };
struct Gemm { const bf16_t* A; const bf16_t* Bt; int M, N, K; };

struct StaticOrder {
    int nM, nN, nwg, G, c;
    __host__ __device__ void init(int M, int N, int G_, int c_) { nM = M / BM; nN = N / BM; nwg = nM * nN; G = G_; c = c_; }
    __host__ __device__ bool next(int i, Unit& u) const {
        const long L = (long)i * G + c; if (L >= nwg) return false;
        int wgid = (int)L; { const int q = nwg / NXCD, r = nwg % NXCD, xcd = wgid % NXCD, off = wgid / NXCD; wgid = (xcd < r ? xcd * (q + 1) : r * (q + 1) + (xcd - r) * q) + off; }
        const int nig = WGM * nN, gid = wgid / nig, fm = gid * WGM, gsz = (nM - fm) < WGM ? (nM - fm) : WGM;
        u.pm = fm + ((wgid % nig) % gsz); u.pn = (wgid % nig) / gsz; return true;
    }
    __device__ __forceinline__ void a_ready(const Unit&) const {}
    __device__ __forceinline__ void done(const Unit&) const {}
};
typedef __bf16 bf16x2_cv __attribute__((ext_vector_type(2)));
typedef float f32x2_cv __attribute__((ext_vector_type(2)));
__device__ __forceinline__ unsigned cvt_pk_bf16(float lo, float hi) { f32x2_cv f = {lo, hi}; bf16x2_cv b = __builtin_convertvector(f, bf16x2_cv); return __builtin_bit_cast(unsigned, b); }
typedef float f32x2 __attribute__((ext_vector_type(2)));
__device__ __forceinline__ f32x2 gelu_pk(f32x2 v) {
    const f32x2 av = __builtin_elementwise_abs(v), d = av * 0.2316418882f + 1.0f;
    f32x2 t; t.x = __builtin_amdgcn_rcpf(d.x); t.y = __builtin_amdgcn_rcpf(d.y);
    f32x2 q = t * 0.5307027145f + (-0.7265760135f); q = q * t + 0.7107068705f; q = q * t + (-0.142248368f); q = q * t + 0.127414796f; q = q * t;
    const f32x2 s = (v * v) * (-0.72134752044f);
    f32x2 e; e.x = __builtin_amdgcn_exp2f(s.x); e.y = __builtin_amdgcn_exp2f(s.y);
    const f32x2 m = v * (q * e), r = v - m;
    f32x2 o; o.x = v.x < 0.f ? m.x : r.x; o.y = v.y < 0.f ? m.y : r.y; return o;
}

template <class Epi, class Sched, bool STAMP = false>
__device__ __forceinline__ void gemm_phase(PG8_LAS unsigned char* lds, const Gemm g, const Sched& S, const Epi& E, unsigned long long* stamps) {
    const int tid = opaque_tid(), wid = __builtin_amdgcn_readfirstlane(tid >> 6), lane = tid & 63, wr = wid >> 2, wc = wid & 3, fr = lane & 15, fq = lane >> 4;
    const int K = g.K, nt = K / BK;
    int ts_lo = 0, ts_hi = 0, nts = 0; const unsigned long long rt_entry = STAMP ? (unsigned long long)wall_clock64() : 0ull;
#define PG8_STAMP() do { if (STAMP && wid == 0 && nts < 64) { const unsigned long long _c = (unsigned long long)clock64(); \
        ts_lo = (lane == nts) ? (int)(unsigned)_c : ts_lo; ts_hi = (lane == nts) ? (int)(unsigned)(_c >> 32) : ts_hi; ++nts; } } while (0)
    PG8_STAMP();
    unsigned voffA[2], voffB[2];
#pragma unroll
    for (int i = 0; i < 2; ++i) { int R, C; stage_rc(tid * 16 + i * 8192, R, C); const int Rb = Epi::PERM ? ((R & ~31) + perm32(R & 31)) : R;
        voffA[i] = (unsigned)(R * K + C) * 2u; voffB[i] = (unsigned)(Rb * K + C) * 2u; }
    const size_t kstep = (size_t)(BK * 2);
    const size_t hstep = (size_t)HALF * K * 2;
    const size_t tstep = 2 * hstep;
    const unsigned ldsw = (unsigned)wid * 1024u;
    const int aoff = lds_byte(wr * 64 + fr, fq * 8), boff = lds_byte(wc * 32 + fr, fq * 8);
#define PG8_SA(b, h) (((b) * 2 + (h)) * HTB)
#define PG8_SB(b, h) ((4 + (b) * 2 + (h)) * HTB)
#define PG8_STAGE(bufoff, gbase, voff) do { _Pragma("unroll") for (int _i = 0; _i < 2; ++_i) \
        __builtin_amdgcn_global_load_lds((const unsigned*)((const char*)(gbase) + (voff)[_i]), (PG8_LAS unsigned*)(lds + (bufoff) + ldsw + _i * 8192), 16, 0, 0); } while (0)
#define PG8_LDA(dst, b, h) do { _Pragma("unroll") for (int m = 0; m < 4; ++m) _Pragma("unroll") for (int k = 0; k < 2; ++k) dst[m][k] = *(const PG8_LAS bf16x8*)(lds + PG8_SA(b, h) + aoff + m * 2048 + k * 1024); } while (0)
#define PG8_LDB(dst, b, h) do { _Pragma("unroll") for (int n = 0; n < 2; ++n) _Pragma("unroll") for (int k = 0; k < 2; ++k) dst[n][k] = *(const PG8_LAS bf16x8*)(lds + PG8_SB(b, h) + boff + n * 2048 + k * 1024); } while (0)
#define PG8_MMA(ai, bj, At, Bt) do { __builtin_amdgcn_s_setprio(1); _Pragma("unroll") for (int m = 0; m < 4; ++m) _Pragma("unroll") for (int n = 0; n < 2; ++n) _Pragma("unroll") for (int k = 0; k < 2; ++k) \
        acc[ai][bj][m][n] = __builtin_amdgcn_mfma_f32_16x16x32_bf16(Bt[n][k], At[m][k], acc[ai][bj][m][n], 0, 0, 0); __builtin_amdgcn_s_setprio(0); } while (0)
#define PG8_WAIT_V(n) asm volatile("s_waitcnt vmcnt(" #n ")" ::: "memory")
#define PG8_WAIT_L(n) asm volatile("s_waitcnt lgkmcnt(" #n ")" ::: "memory")
#define PG8_BAR __builtin_amdgcn_s_barrier()
#define PG8_SCHED __builtin_amdgcn_sched_barrier(0)
    Unit cur, nxt; int ui = 0;
    if (!S.next(0, cur)) return;
    f32x4 acc[2][2][4][2];
#pragma unroll
    for (int a = 0; a < 2; ++a)
#pragma unroll
        for (int b = 0; b < 2; ++b)
#pragma unroll
            for (int m = 0; m < 4; ++m)
#pragma unroll
                for (int n = 0; n < 2; ++n) acc[a][b][m][n] = (f32x4){0.f, 0.f, 0.f, 0.f};
    bf16x8 At[4][2], B0[2][2], B1[2][2];
    const char* cA = (const char*)g.A + (size_t)cur.pm * tstep; const char* cB = (const char*)g.Bt + (size_t)cur.pn * tstep;
    S.a_ready(cur);
    PG8_STAGE(PG8_SB(0, 0), cB, voffB); PG8_STAGE(PG8_SA(0, 0), cA, voffA); PG8_STAGE(PG8_SB(0, 1), cB + hstep, voffB); PG8_STAGE(PG8_SA(0, 1), cA + hstep, voffA);
    if (wr == 1) PG8_BAR;
    PG8_WAIT_V(4); PG8_BAR;
    PG8_STAGE(PG8_SB(1, 0), cB + kstep, voffB); PG8_STAGE(PG8_SA(1, 0), cA + kstep, voffA); PG8_STAGE(PG8_SB(1, 1), cB + hstep + kstep, voffB);
    PG8_WAIT_V(6); PG8_BAR;
    PG8_STAMP();
    for (;;) {
        const bool has_next = S.next(ui + 1, nxt);
        const char* nA = has_next ? (const char*)g.A + (size_t)nxt.pm * tstep : cA; const char* nB = has_next ? (const char*)g.Bt + (size_t)nxt.pn * tstep : cB;
        for (int t = 0; t < nt; t += 2) {
            const bool last = (t == nt - 2);
            const char* a1 = cA + (size_t)(t + 1) * kstep;
            const char* a2 = last ? nA : cA + (size_t)(t + 2) * kstep; const char* b2 = last ? nB : cB + (size_t)(t + 2) * kstep;
            const char* a3 = a2 + kstep; const char* b3 = b2 + kstep;
            if (last && has_next) S.a_ready(nxt);
            PG8_LDB(B0, 0, 0); PG8_SCHED; PG8_LDA(At, 0, 0); PG8_STAGE(PG8_SA(1, 1), a1 + hstep, voffA);
            PG8_WAIT_L(8); PG8_BAR; PG8_WAIT_L(0); PG8_MMA(0, 0, At, B0); PG8_BAR; PG8_SCHED;
            PG8_LDB(B1, 0, 1); PG8_STAGE(PG8_SB(0, 0), b2, voffB);
            PG8_BAR; PG8_WAIT_L(0); PG8_MMA(0, 1, At, B1); PG8_BAR;
            PG8_LDA(At, 0, 1); PG8_STAGE(PG8_SA(0, 0), a2, voffA);
            PG8_BAR; PG8_WAIT_L(0); PG8_MMA(1, 0, At, B0); PG8_BAR; PG8_SCHED;
            PG8_STAGE(PG8_SB(0, 1), b2 + hstep, voffB);
            PG8_WAIT_V(6); PG8_BAR; PG8_MMA(1, 1, At, B1); PG8_BAR;
            PG8_LDB(B0, 1, 0); PG8_SCHED; PG8_LDA(At, 1, 0); PG8_STAGE(PG8_SA(0, 1), a2 + hstep, voffA);
            PG8_WAIT_L(8); PG8_BAR; PG8_WAIT_L(0); PG8_MMA(0, 0, At, B0); PG8_BAR; PG8_SCHED;
            PG8_LDB(B1, 1, 1); PG8_STAGE(PG8_SB(1, 0), b3, voffB);
            PG8_BAR; PG8_WAIT_L(0); PG8_MMA(0, 1, At, B1); PG8_BAR;
            PG8_LDA(At, 1, 1); PG8_STAGE(PG8_SA(1, 0), a3, voffA);
            PG8_BAR; PG8_WAIT_L(0); PG8_MMA(1, 0, At, B0); PG8_BAR; PG8_SCHED;
            PG8_STAGE(PG8_SB(1, 1), b3 + hstep, voffB);
            PG8_WAIT_V(6); PG8_BAR; PG8_MMA(1, 1, At, B1); PG8_BAR;
        }
        PG8_STAMP();
        if constexpr (!Epi::AFTER_DRAIN) { E(acc, cur, wr, wc, fr, fq); S.done(cur); }
        PG8_STAMP();
        if (!has_next) break;
#pragma unroll
        for (int a = 0; a < 2; ++a)
#pragma unroll
            for (int b = 0; b < 2; ++b)
#pragma unroll
                for (int m = 0; m < 4; ++m)
#pragma unroll
                    for (int n = 0; n < 2; ++n) acc[a][b][m][n] = (f32x4){0.f, 0.f, 0.f, 0.f};
        cur = nxt; cA = nA; cB = nB; ++ui;
    }
    PG8_WAIT_V(0);
    if (wr == 0) PG8_BAR;
    PG8_BAR;
    if constexpr (Epi::AFTER_DRAIN) { E.fused(acc, cur, wr, wc, fr, fq, lds, wid, lane); S.done(cur); }
    PG8_STAMP();
    if (STAMP && wid == 0) { stamps[lane] = lane < nts ? (((unsigned long long)(unsigned)ts_hi << 32) | (unsigned)ts_lo) : 0ull;
        if (lane == 62) stamps[62] = rt_entry; if (lane == 63) stamps[63] = (unsigned long long)wall_clock64(); }
#undef PG8_STAMP
#undef PG8_SA
#undef PG8_SB
#undef PG8_STAGE
#undef PG8_LDA
#undef PG8_LDB
#undef PG8_MMA
#undef PG8_WAIT_V
#undef PG8_WAIT_L
#undef PG8_BAR
#undef PG8_SCHED
}
}
#define XB_TMO      128
#define XB_XCNT(j)  (256  + 64 * (j))
#define XB_XSUB(j)  (1280 + 64 * (j))
#define XB_XGEN(j)  (2304 + 64 * (j))
#define XB_TOP      3328
#define XB_TOPGEN   3392
#define XCD_BAR_WORDS 3456
#define XB_SPIN_CAP (1u << 18)
#define LAS __attribute__((address_space(3)))

__device__ __forceinline__ unsigned xb_ld(unsigned* p)              { return __hip_atomic_load(p, __ATOMIC_RELAXED, __HIP_MEMORY_SCOPE_AGENT); }
__device__ __forceinline__ unsigned xb_add(unsigned* p, unsigned v) { return __hip_atomic_fetch_add(p, v, __ATOMIC_RELAXED, __HIP_MEMORY_SCOPE_AGENT); }
__device__ __forceinline__ unsigned xb_xcc_id() { return (unsigned)__builtin_amdgcn_s_getreg((3 << 11) | 20) & 0xFu; }
#define XB_SPIN(cond, bar) do { unsigned _sp = 0; while (cond) { __builtin_amdgcn_s_sleep(1); \
    if ((++_sp & 255u) == 0u) { if (xb_ld(&(bar)[XB_TMO])) break; if (_sp > XB_SPIN_CAP) { atomicAdd(&(bar)[XB_TMO], 1u); break; } } } } while (0)

struct XcdBarrier {
    unsigned* bar; unsigned x;
    volatile LAS unsigned* st;
};

__device__ __forceinline__ XcdBarrier xcd_barrier_post(unsigned* bar, volatile LAS unsigned* st) {
    XcdBarrier b; b.bar = bar; b.x = xb_xcc_id(); b.st = st;
    if (threadIdx.x == 0) (void)xb_add(&bar[XB_XCNT(b.x)], 1u);
    return b;
}
__device__ __forceinline__ void xcd_barrier_complete(unsigned* bar, unsigned x, unsigned& nloc, unsigned& nx) {
    const unsigned G = gridDim.x * gridDim.y * gridDim.z;
    unsigned sum, cnt, mine, sp = 0u;
    for (;;) {
        sum = 0u; cnt = 0u; mine = 0u;
#pragma unroll
        for (unsigned j = 0; j < 16; ++j) { const unsigned c = xb_ld(&bar[XB_XCNT(j)]); sum += c; cnt += (c > 0u) ? 1u : 0u; mine = (j == x) ? c : mine; }
        if (sum == G) break;
        __builtin_amdgcn_s_sleep(1);
        if ((++sp & 255u) == 0u) { if (xb_ld(&bar[XB_TMO])) break; if (sp > XB_SPIN_CAP) { atomicAdd(&bar[XB_TMO], 1u); break; } }
    }
    nloc = mine > 0u ? mine : 1u; nx = cnt > 0u ? cnt : 1u;
}

__device__ __forceinline__ void xcd_barrier(const XcdBarrier& b) {
    asm volatile("s_waitcnt vmcnt(0)" ::: "memory");
    __syncthreads();
    if (threadIdx.x == 0) {
        unsigned* bar = b.bar;
        __builtin_amdgcn_s_waitcnt(0);
        unsigned nloc = b.st[0], nx = b.st[1];
        if (nloc == 0u) { xcd_barrier_complete(bar, b.x, nloc, nx); b.st[0] = nloc; b.st[1] = nx; }
        const unsigned old = xb_add(&bar[XB_XSUB(b.x)], 1u);
        const unsigned gen = old / nloc;
        if (old + 1u == (gen + 1u) * nloc) {
            __builtin_amdgcn_fence(__ATOMIC_RELEASE, "agent");
            asm volatile("s_waitcnt vmcnt(0)" ::: "memory");
            const unsigned og = xb_add(&bar[XB_TOP], 1u);
            const unsigned tg = og / nx;
            if (og + 1u == (tg + 1u) * nx) xb_add(&bar[XB_TOPGEN], 1u);
            else XB_SPIN(xb_ld(&bar[XB_TOPGEN]) == tg, bar);
            __builtin_amdgcn_fence(__ATOMIC_ACQUIRE, "agent");
            xb_add(&bar[XB_XGEN(b.x)], 1u);
            asm volatile("s_waitcnt vmcnt(0)" ::: "memory");
        } else {
            XB_SPIN(xb_ld(&bar[XB_XGEN(b.x)]) == gen, bar);
            __builtin_amdgcn_fence(__ATOMIC_ACQUIRE, "agent");
            asm volatile("s_waitcnt vmcnt(0)" ::: "memory");
        }
    }
    __syncthreads();
}

using pg8::bf16x8; using pg8::f32x4; using pg8::u32x4; using pg8::f32x2; using pg8::cvt_pk_bf16; using pg8::gelu_pk;
typedef float f32x16 __attribute__((ext_vector_type(16)));
typedef unsigned u32x2 __attribute__((ext_vector_type(2)));
typedef unsigned short u16;
typedef unsigned char u8;

constexpr int T_ = 16384, D_ = 2048, L_ = 4096, F_ = 5632, F2_ = 11264;
constexpr int FS = 8208;
constexpr int LDS_BYTES = 131072 + 1024 + 16 + 8192;
constexpr int MAXSTEPS = 64;

enum { OP_PRE = 0, OP_HF2, OP_NORM, OP_GEMM_IN, OP_EVEN_A, OP_HC, OP_HB, OP_ODD_PREP, OP_ATTN, OP_GEMM_OUT, OP_GEMM_UP, OP_CG, OP_GEMM_DOWN };

struct Params {
    const float* in[26];
    float* x;
    u16* wt_in[4]; u16* wt_out[4]; u16* wt_up[4]; u16* wt_down[4];
    u16* h; u16* p; u16* y; u16* up; u16* gated;
    u16* pT; u16* yT; u16* vcT; u16* vdT;
    u16* filt; float* invn; float* h2tab;
    const float* cw_src[16]; u16* cw_dst[16]; const float* cw_g[16]; float* ssp; unsigned* bar;
    int cw_K[16]; int cw_N[16]; int cw_t0[18]; int cw_perm[16]; u16* edge; float* cgtab;
    int nsteps; int pad0;
    int ops[MAXSTEPS]; int lyr[MAXSTEPS]; int arg[MAXSTEPS]; int rep[MAXSTEPS];
};

union V8 { bf16x8 v; unsigned u[4]; uint4 q; };

__device__ __forceinline__ float bflo(unsigned w) { return __uint_as_float(w << 16); }
__device__ __forceinline__ float bfhi(unsigned w) { return __uint_as_float(w & 0xffff0000u); }
__device__ __forceinline__ float bf2f(u16 b) { return __uint_as_float(((unsigned)b) << 16); }
__device__ __forceinline__ u16 f2bf(float f) { unsigned u = __float_as_uint(f); u += 0x7FFFu + ((u >> 16) & 1u); return (u16)(u >> 16); }
__device__ __forceinline__ unsigned pk2(float a, float b) { return (unsigned)f2bf(a) | ((unsigned)f2bf(b) << 16); }
__device__ __forceinline__ float sx(float v, int o) {
    const int l = opaque_tid() & 63;
    return __builtin_bit_cast(float, __builtin_amdgcn_ds_bpermute((l ^ o) << 2, __builtin_bit_cast(int, v)));
}
__device__ __forceinline__ float wave_sum(float v) {
#pragma unroll
    for (int o = 32; o >= 1; o >>= 1) v += sx(v, o);
    return v;
}
#define MFMA16(a, b, c) __builtin_amdgcn_mfma_f32_16x16x32_bf16((a), (b), (c), 0, 0, 0)
#define MFMA32(a, b, c) __builtin_amdgcn_mfma_f32_32x32x16_bf16((a), (b), (c), 0, 0, 0)

struct EpiStoreBf16 {
    static constexpr bool PERM = true, AFTER_DRAIN = false;
    u16* O; int ldc; int gelu_cols; const float* SSP; const PG8_LAS float* rt; int pm0;
    __device__ __forceinline__ void operator()(const f32x4 (&acc)[2][2][4][2], const pg8::Unit& u, int wr, int wc, int fr, int fq) const {
        const int row0 = u.pm * 256 + wr * 64 + fr, col0 = u.pn * 256 + wc * 32 + 8 * fq;
        const bool act = (u.pn * 256) < gelu_cols;
#pragma unroll
        for (int ai = 0; ai < 2; ++ai)
#pragma unroll
            for (int m = 0; m < 4; ++m) {
                float rstd;
                if (u.pm == pm0) rstd = rt[wr * 64 + ai * 128 + m * 16 + fr];
                else {
                    const float4* sp = (const float4*)(SSP + (size_t)(row0 + ai * 128 + m * 16) * 32 + fq * 8);
                    const float4 sa = sp[0], sb = sp[1];
                    float ssum = (sa.x + sa.y) + (sa.z + sa.w) + (sb.x + sb.y) + (sb.z + sb.w);
                    ssum += sx(ssum, 16); ssum += sx(ssum, 32);
                    rstd = rsqrtf(ssum * (1.0f / D_) + 1e-6f);
                }
                u16* rowp = O + (size_t)(row0 + ai * 128 + m * 16) * ldc + col0;
#pragma unroll
                for (int bj = 0; bj < 2; ++bj) {
                    f32x4 v0 = acc[ai][bj][m][0] * rstd, v1 = acc[ai][bj][m][1] * rstd;
                    if (act) {
                        f32x2 a = gelu_pk((f32x2){v0[0], v0[1]}), b = gelu_pk((f32x2){v0[2], v0[3]}), c = gelu_pk((f32x2){v1[0], v1[1]}), d = gelu_pk((f32x2){v1[2], v1[3]});
                        v0 = (f32x4){a.x, a.y, b.x, b.y}; v1 = (f32x4){c.x, c.y, d.x, d.y};
                    }
                    u32x4 w; w.x = cvt_pk_bf16(v0[0], v0[1]); w.y = cvt_pk_bf16(v0[2], v0[3]); w.z = cvt_pk_bf16(v1[0], v1[1]); w.w = cvt_pk_bf16(v1[2], v1[3]);
                    *(u32x4*)(rowp + bj * 128) = w;
                }
            }
    }
};
struct EpiResid {
    static constexpr bool PERM = false, AFTER_DRAIN = false;
    const float* R; float* X; u16* XB; float* SSP;
    __device__ __forceinline__ void operator()(const f32x4 (&acc)[2][2][4][2], const pg8::Unit& u, int wr, int wc, int fr, int fq) const {
        const int row0 = u.pm * 256 + wr * 64 + fr, col0 = u.pn * 256 + wc * 32 + 4 * fq;
#pragma unroll
        for (int ai = 0; ai < 2; ++ai)
#pragma unroll
            for (int m = 0; m < 4; ++m) {
                const size_t off = (size_t)(row0 + ai * 128 + m * 16) * D_ + col0;
                float ss = 0.f;
#pragma unroll
                for (int bj = 0; bj < 2; ++bj)
#pragma unroll
                    for (int n = 0; n < 2; ++n) {
                        const f32x4 r = *(const f32x4*)(R + off + bj * 128 + n * 16);
                        const f32x4 v = acc[ai][bj][m][n] + r;
                        *(f32x4*)(X + off + bj * 128 + n * 16) = v;
                        if (XB) { ss += v[0] * v[0] + v[1] * v[1] + v[2] * v[2] + v[3] * v[3];
                            u32x2 w; w.x = cvt_pk_bf16(v[0], v[1]); w.y = cvt_pk_bf16(v[2], v[3]); *(u32x2*)(XB + off + bj * 128 + n * 16) = w; }
                    }
                if (XB) { ss += sx(ss, 16); ss += sx(ss, 32);
                    if (fq == 0) SSP[(size_t)(row0 + ai * 128 + m * 16) * 32 + u.pn * 4 + wc] = ss; }
            }
    }
};

__device__ __forceinline__ float dpp_ror1(float x) { return __builtin_bit_cast(float, __builtin_amdgcn_update_dpp(0, __builtin_bit_cast(int, x), 0x121, 0xf, 0xf, false)); }
__device__ __forceinline__ float dpp_ror15(float x) { return __builtin_bit_cast(float, __builtin_amdgcn_update_dpp(0, __builtin_bit_cast(int, x), 0x12F, 0xf, 0xf, false)); }
constexpr int LDS_RT = 131072, LDS_XST = 132096, LDS_CGT = 132112;
struct EpiGate {
    static constexpr bool PERM = true, AFTER_DRAIN = false;
    u16* G; u16* EDGE; const PG8_LAS float* rt; const PG8_LAS float* cgt;
    __device__ __forceinline__ void operator()(const f32x4 (&acc)[2][2][4][2], const pg8::Unit& u, int wr, int wc, int fr_in, int fq_in) const {
        const int lane_ = opaque_tid() & 63; const int fr = lane_ & 15, fq = lane_ >> 4;
        (void)fr_in; (void)fq_in;
        const PG8_LAS float* tb = cgt + ((u.pn >> 2) & 1) * 1024;
        const int cb = wc * 32 + 8 * fq;
        const int rowblk0 = u.pm * 256 + wr * 64;
#pragma unroll
        for (int n = 0; n < 2; ++n) {
            const int fcol = u.pn * 128 + cb + 4 * n;
#pragma unroll
            for (int ai = 0; ai < 2; ++ai) {
                float rs[4];
#pragma unroll
                for (int m = 0; m < 4; ++m) rs[m] = rt[wr * 64 + ai * 128 + m * 16 + fr];
                f32x4 o[4], eg[2], ev[2];
#pragma unroll
                for (int j = 0; j < 4; ++j) {
                    float W[4][2];
#pragma unroll
                    for (int k = 0; k < 4; ++k) { W[k][0] = tb[k * 256 + cb + 4 * n + j]; W[k][1] = tb[k * 256 + 128 + cb + 4 * n + j]; }
                    float g[4], v[4], gr[4], gl[4], vr[4], vl[4];
#pragma unroll
                    for (int m = 0; m < 4; ++m) { g[m] = acc[ai][0][m][n][j] * rs[m]; v[m] = acc[ai][1][m][n][j] * rs[m];
                        gr[m] = dpp_ror1(g[m]); gl[m] = dpp_ror15(g[m]); vr[m] = dpp_ror1(v[m]); vl[m] = dpp_ror15(v[m]); }
#pragma unroll
                    for (int m = 0; m < 4; ++m) {
                        const float gp = (fr == 0) ? (m > 0 ? gr[m > 0 ? m - 1 : 0] : 0.f) : gr[m];
                        const float gn = (fr == 15) ? (m < 3 ? gl[m < 3 ? m + 1 : 3] : 0.f) : gl[m];
                        const float vp = (fr == 0) ? (m > 0 ? vr[m > 0 ? m - 1 : 0] : 0.f) : vr[m];
                        const float vn = (fr == 15) ? (m < 3 ? vl[m < 3 ? m + 1 : 3] : 0.f) : vl[m];
                        const float cgv = W[0][0] * gp + W[1][0] * g[m] + W[2][0] * gn + W[3][0];
                        const float cvv = W[0][1] * vp + W[1][1] * v[m] + W[2][1] * vn + W[3][1];
                        o[m][j] = cgv * __builtin_amdgcn_rcpf(1.0f + __expf(-cgv)) * cvv;
                    }
                    eg[0][j] = g[0]; eg[1][j] = g[3]; ev[0][j] = v[0]; ev[1][j] = v[3];
                }
#pragma unroll
                for (int m = 0; m < 4; ++m) {
                    const bool skip = (m == 0 && fr == 0) || (m == 3 && fr == 15);
                    if (!skip) { u32x2 w; w.x = cvt_pk_bf16(o[m][0], o[m][1]); w.y = cvt_pk_bf16(o[m][2], o[m][3]);
                        *(u32x2*)(G + (size_t)(rowblk0 + ai * 128 + m * 16 + fr) * F_ + fcol) = w; }
                }
                const int blk = (rowblk0 + ai * 128) >> 6;
                if (fr < 2) { u16* ep = EDGE + (size_t)(blk * 4 + fr) * F2_ + fcol;
                    u32x2 w; w.x = cvt_pk_bf16(eg[0][0], eg[0][1]); w.y = cvt_pk_bf16(eg[0][2], eg[0][3]); *(u32x2*)ep = w;
                    u32x2 x; x.x = cvt_pk_bf16(ev[0][0], ev[0][1]); x.y = cvt_pk_bf16(ev[0][2], ev[0][3]); *(u32x2*)(ep + F_) = x; }
                if (fr >= 14) { u16* ep = EDGE + (size_t)(blk * 4 + fr - 12) * F2_ + fcol;
                    u32x2 w; w.x = cvt_pk_bf16(eg[1][0], eg[1][1]); w.y = cvt_pk_bf16(eg[1][2], eg[1][3]); *(u32x2*)ep = w;
                    u32x2 x; x.x = cvt_pk_bf16(ev[1][0], ev[1][1]); x.y = cvt_pk_bf16(ev[1][2], ev[1][3]); *(u32x2*)(ep + F_) = x; }
            }
        }
    }
};
struct CgOrder : pg8::StaticOrder {
    const float* tab; PG8_LAS u8* ldsb;
    __device__ __forceinline__ void a_ready(const pg8::Unit& u) const {
        const int t = opaque_tid(), wid = __builtin_amdgcn_readfirstlane(t >> 6), lane = t & 63;
        if (wid < 4) {
            const float* src = tab + (size_t)u.pn * 1024 + wid * 256 + lane * 4;
            __builtin_amdgcn_global_load_lds((const unsigned*)src, (PG8_LAS unsigned*)(ldsb + LDS_CGT + ((u.pn >> 2) & 1) * 4096 + wid * 1024), 16, 0, 0);
        }
    }
    __device__ __forceinline__ void done(const pg8::Unit&) const {}
};

__device__ __forceinline__ void convT_tile(const float* __restrict__ W, int K, int N, u16* __restrict__ Wt, const float* __restrict__ gk, int permF, int tile, u8* shm) {
    unsigned* tl = (unsigned*)shm;
    const int tid = opaque_tid(), wid = tid >> 6, lane = tid & 63;
    const int nN = N >> 8, kt = tile / nN, nt = tile - kt * nN, k0 = kt * 64, n0 = nt * 256;
    float v[8][4];
#pragma unroll
    for (int r = 0; r < 8; ++r)
#pragma unroll
        for (int e = 0; e < 4; ++e) v[r][e] = W[(size_t)(k0 + wid * 8 + r) * N + (permF ? ((e >> 1) * F_ + 128 * nt + lane + 64 * (e & 1)) : (n0 + lane + 64 * e))];
    if (gk) {
#pragma unroll
        for (int r = 0; r < 8; ++r) { const float g = gk[k0 + wid * 8 + r];
#pragma unroll
            for (int e = 0; e < 4; ++e) v[r][e] *= g; }
    }
#pragma unroll
    for (int rp = 0; rp < 4; ++rp)
#pragma unroll
        for (int e = 0; e < 4; ++e) tl[(lane + 64 * e) * 33 + wid * 4 + rp] = cvt_pk_bf16(v[2 * rp][e], v[2 * rp + 1][e]);
    __syncthreads();
#pragma unroll
    for (int i = 0; i < 4; ++i) {
        const int id = i * 512 + tid, n = id >> 3, kc = id & 7;
        uint4 w; w.x = tl[n * 33 + kc * 4]; w.y = tl[n * 33 + kc * 4 + 1]; w.z = tl[n * 33 + kc * 4 + 2]; w.w = tl[n * 33 + kc * 4 + 3];
        *(uint4*)(Wt + (size_t)(n0 + n) * K + k0 + kc * 8) = w;
    }
    __syncthreads();
}

__device__ __forceinline__ void norm_phase(const float* x, const float* __restrict__ g, u16* h, float* outf) {
    const int wid = opaque_tid() >> 6, lane = opaque_tid() & 63;
    for (int row = blockIdx.x * 8 + wid; row < T_; row += gridDim.x * 8) {
        const float* xr = x + (size_t)row * D_;
        float4 v[8]; float ss = 0.f;
#pragma unroll
        for (int i = 0; i < 8; ++i) { v[i] = *(const float4*)(xr + i * 256 + lane * 4); ss += v[i].x * v[i].x + v[i].y * v[i].y + v[i].z * v[i].z + v[i].w * v[i].w; }
        ss = wave_sum(ss);
        const float rstd = rsqrtf(ss * (1.0f / D_) + 1e-6f);
#pragma unroll
        for (int i = 0; i < 8; ++i) {
            const float4 gg = *(const float4*)(g + i * 256 + lane * 4);
            const float a = v[i].x * rstd * gg.x, b = v[i].y * rstd * gg.y, c = v[i].z * rstd * gg.z, d = v[i].w * rstd * gg.w;
            if (outf) *(float4*)(outf + (size_t)row * D_ + i * 256 + lane * 4) = make_float4(a, b, c, d);
            else { u32x2 w; w.x = cvt_pk_bf16(a, b); w.y = cvt_pk_bf16(c, d); *(u32x2*)(h + (size_t)row * D_ + i * 256 + lane * 4) = w; }
        }
    }
}

__device__ __forceinline__ void xprep_phase(const float* x, u16* xb, float* ssp) {
    const int wid = opaque_tid() >> 6, lane = opaque_tid() & 63;
    for (int row = blockIdx.x * 8 + wid; row < T_; row += gridDim.x * 8) {
        const float* xr = x + (size_t)row * D_;
        float ss = 0.f;
#pragma unroll
        for (int i = 0; i < 8; ++i) { const float4 v = *(const float4*)(xr + i * 256 + lane * 4); ss += v.x * v.x + v.y * v.y + v.z * v.z + v.w * v.w;
            u32x2 w; w.x = cvt_pk_bf16(v.x, v.y); w.y = cvt_pk_bf16(v.z, v.w); *(u32x2*)(xb + (size_t)row * D_ + i * 256 + lane * 4) = w; }
        ss = wave_sum(ss);
        if (lane < 32) ssp[(size_t)row * 32 + lane] = lane == 0 ? ss : 0.f;
    }
}

__device__ __forceinline__ void hf1_phase(const Params& P) {
    const int wid = opaque_tid() >> 6, lane = opaque_tid() & 63;
    for (int idx = blockIdx.x * 8 + wid; idx < 2 * L_; idx += gridDim.x * 8) {
        const int i = idx >> 12, t = idx & 4095;
        const float* w1 = P.in[15] + i * 33 * 64; const float* b1 = P.in[16] + i * 64;
        const float* w2 = P.in[17] + i * 64 * 64; const float* b2 = P.in[18] + i * 64;
        const float* fr = P.in[20] + i * 128;
        const float tn = (float)t / 4095.0f;
        const float w = (6.283185307179586f * (float)t) / 4096.0f;
        float acc = b1[lane] + tn * w1[lane];
        {
            const float band = 1e-4f + (float)(lane & 15) * ((15.0f - 1e-4f) / 15.0f);
            const float a = w * band;
            const float zv = ((lane & 16) == 0) ? cosf(a) : -sinf(a);
#pragma unroll 8
            for (int k = 0; k < 32; ++k) acc += __shfl(zv, k) * w1[(1 + k) * 64 + lane];
        }
        const float h1 = sinf(fr[lane] * acc);
        float acc2 = b2[lane];
#pragma unroll 8
        for (int k = 0; k < 64; ++k) acc2 += __shfl(h1, k) * w2[k * 64 + lane];
        ((u16*)P.h2tab)[(size_t)idx * 64 + lane] = f2bf(sinf(fr[64 + lane] * acc2));
    }
}

__device__ __forceinline__ void hf2_item(const Params& P, int id, u8* shm) {
    u16* w3s = (u16*)shm;
    float* red = (float*)(shm + 4096);
    const int tid = opaque_tid(), wid = tid >> 6, lane = tid & 63, n = lane & 15, quad = lane >> 4;
    const int cb = id & 127, o = (id >> 7) & 1, i = id >> 8;
    const float* w3 = P.in[19] + (size_t)i * 64 * 4096;
    __syncthreads();
#pragma unroll
    for (int j = 0; j < 2; ++j) { const int e = j * 512 + tid, k = e >> 4, col = e & 15; w3s[col * 72 + k] = f2bf(w3[(size_t)k * 4096 + o * 2048 + (col >> 3) * 1024 + cb * 8 + (col & 7)]); }
    __syncthreads();
    const bf16x8 b0 = *(const bf16x8*)(w3s + n * 72 + 8 * quad), b1 = *(const bf16x8*)(w3s + n * 72 + 32 + 8 * quad);
    const int dir = n >> 3, e8 = n & 7, ch = cb * 8 + e8;
    const float delta = 3.0701134573253945f + (15.350567286626973f - 3.0701134573253945f) * ((float)ch / 1023.0f);
    u16* fb = P.filt + ((size_t)(i * 2 + o) * 1024 + ch) * FS;
    const u16* hb = (const u16*)P.h2tab + (size_t)i * 4096 * 64;
    float asum = 0.f;
#pragma unroll 2
    for (int tile = wid; tile < 256; tile += 8) {
        const u16* hp = hb + (size_t)(tile * 16 + n) * 64 + 8 * quad;
        const bf16x8 a0 = *(const bf16x8*)hp, a1 = *(const bf16x8*)(hp + 32);
        f32x4 acc = (f32x4){0.f, 0.f, 0.f, 0.f};
        acc = MFMA16(a0, b0, acc); acc = MFMA16(a1, b1, acc);
        const int t0 = tile * 16 + 4 * quad;
        float v[4];
#pragma unroll
        for (int j = 0; j < 4; ++j) { const float tn = (float)(t0 + j) / 4095.0f; v[j] = acc[j] * expf(-tn * delta); }
        if (dir == 0) {
#pragma unroll
            for (int j = 0; j < 4; ++j) { fb[4096 - (t0 + j)] = f2bf(v[j]); asum += fabsf(v[j]); }
        } else {
            u32x2 w; w.x = cvt_pk_bf16(v[0], v[1]); w.y = cvt_pk_bf16(v[2], v[3]);
            if (t0 == 0) { fb[4097] = f2bf(v[1]); fb[4098] = f2bf(v[2]); fb[4099] = f2bf(v[3]); asum += fabsf(v[1]) + fabsf(v[2]) + fabsf(v[3]); }
            else { *(u32x2*)(fb + 4096 + t0) = w; asum += (fabsf(v[0]) + fabsf(v[1])) + (fabsf(v[2]) + fabsf(v[3])); }
        }
    }
    if (tid < 8 * 17) { const int e = tid / 17, j = tid % 17; (P.filt + ((size_t)(i * 2 + o) * 1024 + cb * 8 + e) * FS)[j == 0 ? 0 : 8191 + j] = 0; }
    asum += sx(asum, 16); asum += sx(asum, 32); asum += sx(asum, 8);
    if (lane < 8) red[wid * 8 + lane] = asum;
    __syncthreads();
    if (tid < 8) { float s = 0.f; for (int w = 0; w < 8; ++w) s += red[w * 8 + tid]; P.invn[(i * 2 + o) * 1024 + cb * 8 + tid] = 1.0f / s; }
}

template <int NT>
__device__ __forceinline__ void tr_tile(const u16* __restrict__ src, int src_ld, int col0, int nct, u16* __restrict__ dst, size_t ch_stride, size_t b_stride,
                                        const float* cw, const float* cb, int cw_ld, int tile0, int tstride, int ntot, u8* shm, bool perm = false) {
    const int tid = opaque_tid();
    const int row = tid >> 3, chunk = tid & 7;
    u32x4 w[NT], hw[NT];
#pragma unroll
    for (int k = 0; k < NT; ++k) {
        const int tile = tile0 + k * tstride;
        w[k] = (u32x4){0u, 0u, 0u, 0u}; hw[k] = (u32x4){0u, 0u, 0u, 0u};
        if (tile < ntot) {
            const int ct = tile % nct, bs = tile / nct, st = bs & 63, b = bs >> 6, s0 = st * 64, c0 = ct * 64;
            w[k] = *(const u32x4*)(src + (size_t)(b * L_ + s0 + row) * src_ld + col0 + c0 + chunk * 8);
            if (tid < 16) { const int hr = tid >> 3, s = hr ? s0 + 64 : s0 - 1;
                if (s >= 0 && s < L_) hw[k] = *(const u32x4*)(src + (size_t)(b * L_ + s) * src_ld + col0 + c0 + chunk * 8); }
        }
    }
#pragma unroll
    for (int k = 0; k < NT; ++k) {
        unsigned* tl = (unsigned*)shm + k * (66 * 33 + 2);
        unsigned* d = tl + (row + 1) * 33 + chunk * 4; d[0] = w[k].x; d[1] = w[k].y; d[2] = w[k].z; d[3] = w[k].w;
        if (tid < 16) { const int hr = tid >> 3; unsigned* hd = tl + (hr ? 65 : 0) * 33 + chunk * 4; hd[0] = hw[k].x; hd[1] = hw[k].y; hd[2] = hw[k].z; hd[3] = hw[k].w; }
    }
    __syncthreads();
#pragma unroll
    for (int k = 0; k < NT; ++k) {
        const int tile = tile0 + k * tstride;
        if (tile < ntot) {
            const u16* tl16 = (const u16*)((unsigned*)shm + k * (66 * 33 + 2));
            const int ct = tile % nct, bs = tile / nct, st = bs & 63, b = bs >> 6, s0 = st * 64, c0 = ct * 64;
            const int ch = tid >> 3, sc = tid & 7;
            float o[8];
            if (cw) {
                const float w0 = cw[c0 + ch], w1 = cw[cw_ld + c0 + ch], w2 = cw[2 * cw_ld + c0 + ch], bb = cb[c0 + ch];
                float r[10];
#pragma unroll
                for (int j = 0; j < 10; ++j) r[j] = bf2f(tl16[(sc * 8 + j) * 66 + ch]);
#pragma unroll
                for (int j = 0; j < 8; ++j) o[j] = w0 * r[j] + w1 * r[j + 1] + w2 * r[j + 2] + bb;
            } else {
#pragma unroll
                for (int j = 0; j < 8; ++j) o[j] = bf2f(tl16[(sc * 8 + j + 1) * 66 + ch]);
            }
            uint4 wv; wv.x = cvt_pk_bf16(o[0], o[1]); wv.y = cvt_pk_bf16(o[2], o[3]); wv.z = cvt_pk_bf16(o[4], o[5]); wv.w = cvt_pk_bf16(o[6], o[7]);
            u16* dp = dst + (size_t)(c0 + ch) * ch_stride + (size_t)b * b_stride + s0;
            if (!perm) *(uint4*)(dp + sc * 8) = wv;
            else { u32x2 lo; lo.x = wv.x; lo.y = wv.y; u32x2 hi; hi.x = wv.z; hi.y = wv.w;
                *(u32x2*)(dp + 16 * (sc >> 1) + 4 * (sc & 1)) = lo; *(u32x2*)(dp + 16 * (sc >> 1) + 8 + 4 * (sc & 1)) = hi; }
        }
    }
    __syncthreads();
}

template <int NT>
__device__ __forceinline__ void trback_tile(const u16* __restrict__ yT, u16* __restrict__ y, int tile0, int tstride, int ntot, u8* shm) {
    const int tid = opaque_tid();
    u32x4 w[NT];
#pragma unroll
    for (int k = 0; k < NT; ++k) {
        const int tile = tile0 + k * tstride;
        w[k] = (u32x4){0u, 0u, 0u, 0u};
        if (tile < ntot) { const int ct = tile & 15, bs = tile >> 4, st = bs & 63, b = bs >> 6, t0 = st * 64, c0 = ct * 64; const int c = tid >> 3, chunk = tid & 7;
            w[k] = *(const u32x4*)(yT + ((size_t)(c0 + c) * 4 + b) * L_ + t0 + chunk * 8); }
    }
#pragma unroll
    for (int k = 0; k < NT; ++k) { const int c = tid >> 3, chunk = tid & 7; unsigned* d = (unsigned*)shm + k * (64 * 33 + 2) + c * 33 + chunk * 4; d[0] = w[k].x; d[1] = w[k].y; d[2] = w[k].z; d[3] = w[k].w; }
    __syncthreads();
#pragma unroll
    for (int k = 0; k < NT; ++k) {
        const int tile = tile0 + k * tstride;
        if (tile < ntot) {
            const u16* tl16 = (const u16*)((unsigned*)shm + k * (64 * 33 + 2));
            const int ct = tile & 15, bs = tile >> 4, st = bs & 63, b = bs >> 6, t0 = st * 64, c0 = ct * 64;
            const int t = tid >> 3, cc = tid & 7;
            unsigned short e[8];
#pragma unroll
            for (int j = 0; j < 8; ++j) e[j] = tl16[(cc * 8 + j) * 66 + t];
            uint4 wv; wv.x = e[0] | ((unsigned)e[1] << 16); wv.y = e[2] | ((unsigned)e[3] << 16); wv.z = e[4] | ((unsigned)e[5] << 16); wv.w = e[6] | ((unsigned)e[7] << 16);
            *(uint4*)(y + (size_t)(b * L_ + t0 + t) * D_ + 1024 + c0 + cc * 8) = wv;
        }
    }
    __syncthreads();
}

constexpr int HU_B = 5792, HU_J = 72, HU_P = 7;
__device__ __forceinline__ void hc_loadF(V8& f, const u16* Fo  , int j) {
    const unsigned* fp = (const unsigned*)(Fo - 16 * j);
    f.u[0] = fp[0]; f.u[1] = fp[1]; f.u[2] = fp[2]; f.u[3] = fp[3];
}
__device__ __forceinline__ void hc_loadB(V8 (&bv)[2][2], const u16* Uo, int m, int wid, int n, int quad) {
#pragma unroll
    for (int nt = 0; nt < 2; ++nt) {
        const int ii = 4 * (2 * wid + nt) + (n >> 2), b = n & 3, j = ii - m;
        const u16* up = Uo + b * HU_B + (j + HU_P) * HU_J + 8 * quad;
#pragma unroll
        for (int ks = 0; ks < 2; ++ks) bv[ks][nt].q = *(const uint4*)(up + 32 * ks);
    }
}
template <int PAR>
__device__ __forceinline__ void hc_step(V8 (&F)[16], f32x4 (&acc)[4][2], const V8 (&bc)[2][2], V8 (&bn)[2][2], const u16* Fo, const u16* Uo, int m, int wid, int n, int quad, int sh) {
    V8 nf[4];
#pragma unroll
    for (int e = 0; e < 4; ++e) hc_loadF(nf[e], Fo, 4 * (m + 1) + e);
    hc_loadB(bn, Uo, m + 1, wid, n, quad);
    __builtin_amdgcn_s_setprio(1);
#pragma unroll
    for (int ks = 0; ks < 2; ++ks)
#pragma unroll
        for (int mt = 0; mt < 4; ++mt) {
            const int slot = (PAR * 4 + mt - 2 * ks) & 15;
            acc[mt][0] = MFMA16(F[slot].v, bc[ks][0].v, acc[mt][0]);
            acc[mt][1] = MFMA16(F[slot].v, bc[ks][1].v, acc[mt][1]);
        }
    __builtin_amdgcn_s_setprio(0);
#pragma unroll
    for (int e = 0; e < 4; ++e) F[(PAR * 4 + 4 + e) & 15] = nf[e];
}

__device__ __forceinline__ void hconv_item(const Params& P, int i, int c, u8* shm) {
    u16* FA = (u16*)shm + 64; u16* FB = FA + FS; u16* U = FB + FS; u16* Z = U + 4 * HU_B;
    const int tid = opaque_tid(), wid = tid >> 6, lane = tid & 63, n = lane & 15, quad = lane >> 4;
    __syncthreads();
    {
        const uint4* su = (const uint4*)(P.pT + (size_t)c * 4 * L_);
#pragma unroll
        for (int j = 0; j < 4; ++j) { const int cidx = j * 512 + tid, bb = cidx >> 9, tt = (cidx & 511) * 8; *(uint4*)(U + bb * HU_B + ((tt >> 6) + HU_P) * HU_J + (tt & 63)) = su[cidx]; }
    }
    __syncthreads();
    const float skip0 = P.in[21][(i * 2 + 0) * 1024 + c], skip1 = P.in[21][(i * 2 + 1) * 1024 + c];
    const float in0 = P.invn[(i * 2 + 0) * 1024 + c], in1 = P.invn[(i * 2 + 1) * 1024 + c];
    const int sh = (n & 1) * 16;
#pragma unroll 1
    for (int o = 0; o < 2; ++o) {
        {
            const uint4* sf = (const uint4*)(P.filt + ((size_t)(i * 2 + o) * 1024 + c) * FS);
            for (int j = tid; j < FS / 8; j += 512) ((uint4*)FA)[j] = sf[j];
            __syncthreads();
            const unsigned* fa = (const unsigned*)FA; unsigned* fb = (unsigned*)FB;
            for (int k = tid; k < FS / 2; k += 512) fb[k] = __builtin_amdgcn_alignbit(fa[k + 1], fa[k], 16);
            __syncthreads();
        }
        const u16* Fo = ((n & 1) ? FB : FA) + ((4096 - n + 8 * quad) & ~1); const u16* Uo = o ? Z : U;
        f32x4 acc[4][2];
#pragma unroll
        for (int mt = 0; mt < 4; ++mt) { acc[mt][0] = (f32x4){0.f, 0.f, 0.f, 0.f}; acc[mt][1] = (f32x4){0.f, 0.f, 0.f, 0.f}; }
        V8 F[16];
#pragma unroll
        for (int e = 0; e < 16; ++e) F[e].q = make_uint4(0, 0, 0, 0);
        const int mb = 8 * wid - 64;
        V8 ba[2][2], bb[2][2];
        const u16* gsrc = P.pT + ((size_t)((o ? 2048 : 1024) + c) * 4) * L_;
        u32x2 ggp[2][4];
#pragma unroll
        for (int nt = 0; nt < 2; ++nt) { const int ii = 4 * (2 * wid + nt) + (n >> 2), b = n & 3;
#pragma unroll
            for (int mt = 0; mt < 4; ++mt) ggp[nt][mt] = *(const u32x2*)(gsrc + (size_t)b * L_ + 64 * ii + 16 * mt + 4 * quad); }
#pragma unroll
        for (int e = 0; e < 4; ++e) hc_loadF(F[e], Fo, 4 * mb + e);
        hc_loadB(ba, Uo, mb, wid, n, quad);
#pragma unroll 1
        for (int kk = 0; kk < 18; ++kk) {
            const int m0 = mb + 4 * kk;
            hc_step<0>(F, acc, ba, bb, Fo, Uo, m0, wid, n, quad, sh);
            hc_step<1>(F, acc, bb, ba, Fo, Uo, m0 + 1, wid, n, quad, sh);
            hc_step<2>(F, acc, ba, bb, Fo, Uo, m0 + 2, wid, n, quad, sh);
            hc_step<3>(F, acc, bb, ba, Fo, Uo, m0 + 3, wid, n, quad, sh);
        }
        const float sk = o ? skip1 : skip0, inn = o ? in1 : in0;
#pragma unroll
        for (int nt = 0; nt < 2; ++nt) {
            const int ii = 4 * (2 * wid + nt) + (n >> 2), b = n & 3;
#pragma unroll
            for (int mt = 0; mt < 4; ++mt) {
                const int t0 = 64 * ii + 16 * mt + 4 * quad;
                const int uidx = b * HU_B + ((t0 >> 6) + HU_P) * HU_J + (t0 & 63);
                const u32x2 uu = *(const u32x2*)(Uo + uidx);
                const u32x2 gg = ggp[nt][mt];
                const float r0 = bflo(gg.x) * (acc[mt][nt][0] * inn + sk * bflo(uu.x));
                const float r1 = bfhi(gg.x) * (acc[mt][nt][1] * inn + sk * bfhi(uu.x));
                const float r2 = bflo(gg.y) * (acc[mt][nt][2] * inn + sk * bflo(uu.y));
                const float r3 = bfhi(gg.y) * (acc[mt][nt][3] * inn + sk * bfhi(uu.y));
                u32x2 w; w.x = cvt_pk_bf16(r0, r1); w.y = cvt_pk_bf16(r2, r3);
                if (o == 0) *(u32x2*)(Z + uidx) = w;
                else *(u32x2*)(P.yT + ((size_t)c * 4 + b) * L_ + t0) = w;
            }
        }
        __syncthreads();
    }
}

__device__ __forceinline__ void gmlp_item(const Params& P, int i, int item, u8* shm) {
    float* rs = (float*)shm; u16* Ws = (u16*)(shm + 512); u16* Vt = Ws + 128 * 136;
    const int tid = opaque_tid(), wid = tid >> 6, lane = tid & 63, n = lane & 15, quad = lane >> 4;
    const int bc = item >> 1, gh = item & 1, tok0 = bc * 128;
    const u16* p = P.p;
    __syncthreads();
    {
        const int q = tid >> 2, part = tid & 3; float ss = 0.f;
        const uint4* vp = (const uint4*)(p + (size_t)(tok0 + q) * 5120 + 1024 + part * 256);
#pragma unroll 4
        for (int j = 0; j < 32; ++j) { const uint4 w = vp[j];
            ss += bflo(w.x) * bflo(w.x) + bfhi(w.x) * bfhi(w.x) + bflo(w.y) * bflo(w.y) + bfhi(w.y) * bfhi(w.y) + bflo(w.z) * bflo(w.z) + bfhi(w.z) * bfhi(w.z) + bflo(w.w) * bflo(w.w) + bfhi(w.w) * bfhi(w.w); }
        ss += sx(ss, 1); ss += sx(ss, 2);
        if (part == 0) rs[q] = rsqrtf(ss * (1.0f / 1024.0f) + 1e-6f);
    }
    __syncthreads();
    const float* gain = P.in[10] + i * 1024;
    for (int gi = 0; gi < 4; ++gi) {
        const int g = gh * 4 + gi;
        const float* ws = P.in[11] + ((size_t)(i * 8 + g)) * 16384;
#pragma unroll
        for (int j = 0; j < 8; ++j) { const int e4 = (j * 512 + tid) * 4; const float4 w = *(const float4*)(ws + e4); const int pp = e4 >> 7, qq = e4 & 127;
            u32x2 o; o.x = cvt_pk_bf16(w.x, w.y); o.y = cvt_pk_bf16(w.z, w.w); *(u32x2*)(Ws + pp * 136 + qq) = o; }
#pragma unroll
        for (int j = 0; j < 4; ++j) { const int id = j * 512 + tid, qq = id >> 4, dc = id & 15;
            const uint4 w = *(const uint4*)(p + (size_t)(tok0 + qq) * 5120 + 1024 + g * 128 + dc * 8);
            const float r = rs[qq]; const float* gp = gain + g * 128 + dc * 8;
            Vt[(dc * 8 + 0) * 136 + qq] = f2bf(bflo(w.x) * r * gp[0]); Vt[(dc * 8 + 1) * 136 + qq] = f2bf(bfhi(w.x) * r * gp[1]);
            Vt[(dc * 8 + 2) * 136 + qq] = f2bf(bflo(w.y) * r * gp[2]); Vt[(dc * 8 + 3) * 136 + qq] = f2bf(bfhi(w.y) * r * gp[3]);
            Vt[(dc * 8 + 4) * 136 + qq] = f2bf(bflo(w.z) * r * gp[4]); Vt[(dc * 8 + 5) * 136 + qq] = f2bf(bfhi(w.z) * r * gp[5]);
            Vt[(dc * 8 + 6) * 136 + qq] = f2bf(bflo(w.w) * r * gp[6]); Vt[(dc * 8 + 7) * 136 + qq] = f2bf(bfhi(w.w) * r * gp[7]); }
        __syncthreads();
        f32x4 acc[8];
#pragma unroll
        for (int dt = 0; dt < 8; ++dt) acc[dt] = (f32x4){0.f, 0.f, 0.f, 0.f};
#pragma unroll
        for (int ks = 0; ks < 4; ++ks) {
            const bf16x8 bfr = *(const bf16x8*)(Ws + (16 * wid + n) * 136 + 32 * ks + 8 * quad);
#pragma unroll
            for (int dt = 0; dt < 8; ++dt) { const bf16x8 afr = *(const bf16x8*)(Vt + (16 * dt + n) * 136 + 32 * ks + 8 * quad); acc[dt] = MFMA16(afr, bfr, acc[dt]); }
        }
        const int pp = 16 * wid + n;
        const float bsv = P.in[12][(i * 8 + g) * 128 + pp];
#pragma unroll
        for (int dt = 0; dt < 8; ++dt) {
            const int d = g * 128 + 16 * dt + 4 * quad;
            const u32x2 uu = *(const u32x2*)(p + (size_t)(tok0 + pp) * 5120 + d);
            u32x2 w; w.x = cvt_pk_bf16(bflo(uu.x) * (acc[dt][0] + bsv), bfhi(uu.x) * (acc[dt][1] + bsv)); w.y = cvt_pk_bf16(bflo(uu.y) * (acc[dt][2] + bsv), bfhi(uu.y) * (acc[dt][3] + bsv));
            *(u32x2*)(P.y + (size_t)(tok0 + pp) * D_ + d) = w;
        }
        __syncthreads();
    }
}

__device__ __forceinline__ void rotary_phase(const Params& P) {
    const int nth = gridDim.x * 512;
    for (int idx2 = blockIdx.x * 512 + opaque_tid(); idx2 < T_ * 8; idx2 += nth) {
        const int idx = idx2 >> 1, ghalf = idx2 & 1;
        const int tok = idx >> 2, dq = idx & 3, pos = tok & 4095;
        float cs[8], sn[8];
#pragma unroll
        for (int e = 0; e < 8; ++e) { const float inv = exp2f(-(float)(dq * 8 + e) * 0.41524101186092029f); const float ang = (float)pos * inv; cs[e] = cosf(ang); sn[e] = sinf(ang); }
        u16* base = P.p + (size_t)tok * 6144 + 3072;
#pragma unroll 2
        for (int g16 = 0; g16 < 16; ++g16) {
            const int grp = ghalf * 16 + g16;
            u16* gp = base + (grp >> 4) * 1024 + (grp & 15) * 64 + dq * 8;
            const float sc = (grp < 16) ? 0.125f * 1.4426950408889634f : 1.0f;
            const uint4 a = *(const uint4*)gp, b = *(const uint4*)(gp + 32);
            const unsigned aw[4] = {a.x, a.y, a.z, a.w}, bw[4] = {b.x, b.y, b.z, b.w};
            unsigned oa[4], ob[4];
#pragma unroll
            for (int j = 0; j < 4; ++j) {
                const float x1l = bflo(aw[j]), x1h = bfhi(aw[j]), x2l = bflo(bw[j]), x2h = bfhi(bw[j]);
                oa[j] = cvt_pk_bf16((x1l * cs[2 * j] - x2l * sn[2 * j]) * sc, (x1h * cs[2 * j + 1] - x2h * sn[2 * j + 1]) * sc);
                ob[j] = cvt_pk_bf16((x1l * sn[2 * j] + x2l * cs[2 * j]) * sc, (x1h * sn[2 * j + 1] + x2h * cs[2 * j + 1]) * sc);
            }
            *(uint4*)gp = make_uint4(oa[0], oa[1], oa[2], oa[3]); *(uint4*)(gp + 32) = make_uint4(ob[0], ob[1], ob[2], ob[3]);
        }
    }
}

__device__ __forceinline__ void nattn_witem(const Params& P, int io, int id, const float* rpl  ) {
    const int lane = opaque_tid() & 63, n = lane & 15, quad = lane >> 4;
    const int qb = id & 3, h = (id >> 2) & 7, r = (id >> 5) & 63, b = id >> 11;
    const int rs = min(max(r - 4, 0), 56);
    const int cw = qb == 0 ? 0 : qb == 1 ? 8 : qb == 2 ? 24 : 32;
    const int c = 16 * qb + n, cs = min(max(c - 8, 0), 48);
    const u16* pb = P.p + (size_t)b * L_ * 6144;
    bf16x8 qf[4];
#pragma unroll
    for (int ks = 0; ks < 4; ++ks) qf[ks] = *(const bf16x8*)(pb + (size_t)(r * 64 + c) * 6144 + h * 128 + 32 * ks + 8 * quad);
    f32x4 S[16];
    const int krow = 8 * (n >> 2) + (n & 3);
#pragma unroll
    for (int half = 0; half < 2; ++half) {
        bf16x8 kf[8][4];
#pragma unroll
        for (int t8 = 0; t8 < 8; ++t8) {
            const int kt = half * 8 + t8, kr = kt >> 1, ct = kt & 1;
            const u16* kp = pb + (size_t)((rs + kr) * 64 + cw + krow + 4 * ct) * 6144 + 1024 + h * 128 + 8 * quad;
#pragma unroll
            for (int ks = 0; ks < 4; ++ks) kf[t8][ks] = *(const bf16x8*)(kp + 32 * ks);
        }
#pragma unroll
        for (int t8 = 0; t8 < 8; ++t8) {
            f32x4 acc = (f32x4){0.f, 0.f, 0.f, 0.f};
#pragma unroll
            for (int ks = 0; ks < 4; ++ks) acc = MFMA16(kf[t8][ks], qf[ks], acc);
            S[half * 8 + t8] = acc;
        }
    }
    const float* rp = rpl + h * 465;
    float mx = -1e30f;
#pragma unroll
    for (int kt = 0; kt < 16; ++kt) {
        const int kr = kt >> 1, ct = kt & 1, relr = rs + kr - r + 7;
#pragma unroll
        for (int j = 0; j < 4; ++j) {
            const int kc = cw + 8 * quad + 4 * ct + j; const bool valid = (kc >= cs) && (kc < cs + 16);
            const int relc = min(max(kc - c + 15, 0), 30);
            const float v = valid ? S[kt][j] * 0.08838834764831845f + rp[relr * 31 + relc] : -1e30f;
            S[kt][j] = v; mx = fmaxf(mx, v);
        }
    }
    mx = fmaxf(mx, sx(mx, 16)); mx = fmaxf(mx, sx(mx, 32));
    float sum = 0.f;
#pragma unroll
    for (int kt = 0; kt < 16; ++kt)
#pragma unroll
        for (int j = 0; j < 4; ++j) { const float v = S[kt][j]; const float e = (v > -1e29f) ? __expf(v - mx) : 0.f; S[kt][j] = e; sum += e; }
    sum += sx(sum, 16); sum += sx(sum, 32);
    f32x4 O[8];
#pragma unroll
    for (int dt = 0; dt < 8; ++dt) O[dt] = (f32x4){0.f, 0.f, 0.f, 0.f};
    const u16* vb = P.vcT + ((size_t)(b * 8 + h) * 128) * L_;
#pragma unroll
    for (int kq = 0; kq < 2; ++kq) {
        bf16x8 av[4][8];
#pragma unroll
        for (int k4 = 0; k4 < 4; ++k4) {
            const int tok0 = (rs + kq * 4 + k4) * 64 + cw + 8 * quad;
#pragma unroll
            for (int dt = 0; dt < 8; ++dt) av[k4][dt] = *(const bf16x8*)(vb + (size_t)(16 * dt + n) * L_ + tok0);
        }
#pragma unroll
        for (int k4 = 0; k4 < 4; ++k4) {
            const int kr = kq * 4 + k4;
            V8 pf; pf.u[0] = cvt_pk_bf16(S[2 * kr][0], S[2 * kr][1]); pf.u[1] = cvt_pk_bf16(S[2 * kr][2], S[2 * kr][3]);
            pf.u[2] = cvt_pk_bf16(S[2 * kr + 1][0], S[2 * kr + 1][1]); pf.u[3] = cvt_pk_bf16(S[2 * kr + 1][2], S[2 * kr + 1][3]);
#pragma unroll
            for (int dt = 0; dt < 8; ++dt) O[dt] = MFMA16(av[k4][dt], pf.v, O[dt]);
        }
    }
    const float inv = 1.0f / sum;
    u16* yp = P.y + (size_t)(b * L_ + r * 64 + c) * D_ + h * 128 + 4 * quad;
#pragma unroll
    for (int dt = 0; dt < 8; ++dt) { u32x2 w; w.x = cvt_pk_bf16(O[dt][0] * inv, O[dt][1] * inv); w.y = cvt_pk_bf16(O[dt][2] * inv, O[dt][3] * inv); *(u32x2*)(yp + 16 * dt) = w; }
}

constexpr int NA_ST = 18432;
template <int S_>
__device__ __forceinline__ void na_load_stage(u32x4 (&w)[4], const u16* pb, const u16* vb2, int rs, int h0, int tid) {
    constexpr int kr = S_ & 7;
    if (S_ < 8) {
#pragma unroll
        for (int j = 0; j < 4; ++j) { const int id = j * 512 + tid, tok = id >> 5, c16 = id & 31;
            w[j] = *(const u32x4*)(pb + (size_t)((rs + kr) * 64 + tok) * 6144 + 1024 + h0 * 128 + c16 * 8); }
    } else {
#pragma unroll
        for (int j = 0; j < 4; ++j) { const int id = j * 512 + tid, rowi = id >> 3, c = id & 7;
            w[j] = *(const u32x4*)(vb2 + (size_t)rowi * L_ + (rs + kr) * 64 + c * 8); }
    }
}
template <int S_>
__device__ __forceinline__ void na_write_stage(const u32x4 (&w)[4], u16* buf, int tid) {
    if (S_ < 8) {
#pragma unroll
        for (int j = 0; j < 4; ++j) { const int id = j * 512 + tid, tok = id >> 5, c16 = id & 31; *(u32x4*)(buf + ((c16 >> 4) * 64 + tok) * 136 + (c16 & 15) * 8) = w[j]; }
    } else {
#pragma unroll
        for (int j = 0; j < 4; ++j) { const int id = j * 512 + tid, rowi = id >> 3, c = id & 7; *(u32x4*)(buf + rowi * 72 + c * 8) = w[j]; }
    }
}
__device__ __forceinline__ void nattn_wgitem(const Params& P, int io, int bb, int r, int hp, const float* rpl, u8* shm) {
    const int tid = opaque_tid(), wid = tid >> 6, lane = tid & 63, n = lane & 15, quad = lane >> 4;
    const int hh = wid >> 2, qb = wid & 3, h0 = hp * 2, h = h0 + hh, b = bb;
    const int rs = min(max(r - 4, 0), 56);
    const int cw = qb == 0 ? 0 : qb == 1 ? 8 : qb == 2 ? 24 : 32;
    const int c = 16 * qb + n, cs = min(max(c - 8, 0), 48);
    const u16* pb = P.p + (size_t)b * L_ * 6144;
    const u16* vb2 = P.vcT + ((size_t)(b * 8 + h0) * 128) * L_;
    u16* SB = (u16*)(shm + 16384);
    bf16x8 qf[4];
#pragma unroll
    for (int ks = 0; ks < 4; ++ks) qf[ks] = *(const bf16x8*)(pb + (size_t)(r * 64 + c) * 6144 + h * 128 + 32 * ks + 8 * quad);
    const int krow = 8 * (n >> 2) + (n & 3);
    f32x4 S[16], O[8];
#pragma unroll
    for (int dt = 0; dt < 8; ++dt) O[dt] = (f32x4){0.f, 0.f, 0.f, 0.f};
    float inv = 0.f;
    u32x4 w0[4], w1[4], w2[4];
    __syncthreads();
    na_load_stage<0>(w0, pb, vb2, rs, h0, tid);
    na_load_stage<1>(w1, pb, vb2, rs, h0, tid);
    na_load_stage<2>(w2, pb, vb2, rs, h0, tid);
    na_write_stage<0>(w0, SB, tid);
    __syncthreads();
#define NA_STAGE(S_) do { \
        if ((S_) + 3 < 16) na_load_stage<((S_) + 3) & 15>(((S_) % 3) == 0 ? w0 : ((S_) % 3) == 1 ? w1 : w2, pb, vb2, rs, h0, tid); \
        const u16* buf = SB + ((S_) & 1) * NA_ST; \
        if ((S_) < 8) { \
            _Pragma("unroll") for (int ct = 0; ct < 2; ++ct) { \
                const u16* kp = buf + (hh * 64 + cw + krow + 4 * ct) * 136 + 8 * quad; \
                f32x4 acc = (f32x4){0.f, 0.f, 0.f, 0.f}; \
                _Pragma("unroll") for (int ks = 0; ks < 4; ++ks) { const bf16x8 kf = *(const bf16x8*)(kp + 32 * ks); acc = MFMA16(kf, qf[ks], acc); } \
                S[((S_) & 7) * 2 + ct] = acc; } \
        } else { \
            constexpr int kr = (S_) & 7; \
            V8 pf; pf.u[0] = cvt_pk_bf16(S[2 * kr][0], S[2 * kr][1]); pf.u[1] = cvt_pk_bf16(S[2 * kr][2], S[2 * kr][3]); \
            pf.u[2] = cvt_pk_bf16(S[2 * kr + 1][0], S[2 * kr + 1][1]); pf.u[3] = cvt_pk_bf16(S[2 * kr + 1][2], S[2 * kr + 1][3]); \
            _Pragma("unroll") for (int dt = 0; dt < 8; ++dt) { const bf16x8 av = *(const bf16x8*)(buf + (hh * 128 + 16 * dt + n) * 72 + cw + 8 * quad); O[dt] = MFMA16(av, pf.v, O[dt]); } \
        } \
        if ((S_) == 7) { \
            const float* rp = rpl + h * 465; \
            float mx = -1e30f; \
            _Pragma("unroll") for (int kt = 0; kt < 16; ++kt) { const int kr2 = kt >> 1, ct = kt & 1, relr = rs + kr2 - r + 7; \
                _Pragma("unroll") for (int j = 0; j < 4; ++j) { const int kc = cw + 8 * quad + 4 * ct + j; const bool valid = (kc >= cs) && (kc < cs + 16); \
                    const int relc = min(max(kc - c + 15, 0), 30); \
                    const float v = valid ? S[kt][j] * 0.08838834764831845f + rp[relr * 31 + relc] : -1e30f; S[kt][j] = v; mx = fmaxf(mx, v); } } \
            mx = fmaxf(mx, sx(mx, 16)); mx = fmaxf(mx, sx(mx, 32)); \
            float sum = 0.f; \
            _Pragma("unroll") for (int kt = 0; kt < 16; ++kt) _Pragma("unroll") for (int j = 0; j < 4; ++j) { const float v = S[kt][j]; const float e = (v > -1e29f) ? __expf(v - mx) : 0.f; S[kt][j] = e; sum += e; } \
            sum += sx(sum, 16); sum += sx(sum, 32); inv = 1.0f / sum; \
        } \
        if ((S_) + 1 < 16) na_write_stage<((S_) + 1) & 15>((((S_) + 1) % 3) == 0 ? w0 : (((S_) + 1) % 3) == 1 ? w1 : w2, SB + (((S_) + 1) & 1) * NA_ST, tid); \
        __syncthreads(); \
    } while (0)
    NA_STAGE(0); NA_STAGE(1); NA_STAGE(2); NA_STAGE(3); NA_STAGE(4); NA_STAGE(5); NA_STAGE(6); NA_STAGE(7);
    NA_STAGE(8); NA_STAGE(9); NA_STAGE(10); NA_STAGE(11); NA_STAGE(12); NA_STAGE(13); NA_STAGE(14); NA_STAGE(15);
#undef NA_STAGE
    u16* yp = P.y + (size_t)(b * L_ + r * 64 + c) * D_ + h * 128 + 4 * quad;
#pragma unroll
    for (int dt = 0; dt < 8; ++dt) { u32x2 wv; wv.x = cvt_pk_bf16(O[dt][0] * inv, O[dt][1] * inv); wv.y = cvt_pk_bf16(O[dt][2] * inv, O[dt][3] * inv); *(u32x2*)(yp + 16 * dt) = wv; }
}

constexpr int DA_BUFE = (128 + 128) * 72;
__device__ __forceinline__ void da_iter(const int kt, u32x4 (&wr)[4], u32x4 (&ld)[4], f32x16 (&O)[4], V8 (&pf)[2][2], float& mrun, float& lrun, const bf16x8 (&qf)[4],
                                        u16* SB, const u16* kg0, const u16* vg0, const int mw, const int l31, const int kh, const int lrow, const int lch) {
    constexpr int BUFE = DA_BUFE;
        const u16* Ks = SB + (kt & 1) * BUFE; const u16* Vs = Ks + 128 * 72;
        {
            const int kn = kt + 2 < 64 ? kt + 2 : 63, vn = kt + 1 < 64 ? kt + 1 : 63;
            const u16* kg = kg0 + (size_t)kn * 64 * 6144; const u16* vg = vg0 + vn * 64;
            ld[0] = *(const u32x4*)(kg); ld[1] = *(const u32x4*)(kg + 64); ld[2] = *(const u32x4*)(vg); ld[3] = *(const u32x4*)(vg + (size_t)64 * L_);
        }
        f32x16 s0, s1;
        const float nm = -mrun;
#pragma unroll
        for (int r = 0; r < 16; ++r) { s0[r] = nm; s1[r] = nm; }
        {
            bf16x8 a0[4], a1[4];
#pragma unroll
            for (int ks = 0; ks < 4; ++ks) { a0[ks] = *(const bf16x8*)(Ks + (mw * 64 + l31) * 72 + 16 * ks + 8 * kh); a1[ks] = *(const bf16x8*)(Ks + (mw * 64 + 32 + l31) * 72 + 16 * ks + 8 * kh); }
#pragma unroll
            for (int ks = 0; ks < 4; ++ks) { s0 = MFMA32(a0[ks], qf[ks], s0); s1 = MFMA32(a1[ks], qf[ks], s1); }
        }
        bf16x8 av[2][4];
#pragma unroll
        for (int dt = 0; dt < 4; ++dt) av[0][dt] = *(const bf16x8*)(Vs + (32 * dt + l31) * 72 + 8 * kh);
        float mx = fmaxf(s0[0], s1[0]);
#pragma unroll
        for (int r = 1; r < 16; ++r) mx = fmaxf(fmaxf(mx, s0[r]), s1[r]);
        mx = fmaxf(mx, sx(mx, 32));
        const bool resc = (kt == 0) || (__builtin_amdgcn_ballot_w64(mx > 8.0f) != 0ull);
        float alpha = 1.0f;
        if (resc) {
            const float delta = (kt == 0) ? mx : fmaxf(mx, 0.f);
            alpha = (kt == 0) ? 0.f : __builtin_amdgcn_exp2f(-delta);
#pragma unroll
            for (int r = 0; r < 16; ++r) { s0[r] -= delta; s1[r] -= delta; }
            lrun *= alpha; mrun += delta;
        }
        V8 pn[2][2];
        float ps = 0.f;
#pragma unroll
        for (int tt = 0; tt < 2; ++tt)
#pragma unroll
            for (int ip = 0; ip < 2; ++ip) {
                const int gq = tt * 2 + ip;
                if (gq < 3) {
#pragma unroll
                    for (int dt = 0; dt < 4; ++dt) av[(gq + 1) & 1][dt] = *(const bf16x8*)(Vs + (32 * dt + l31) * 72 + 16 * (gq + 1) + 8 * kh);
                }
#pragma unroll
                for (int dt = 0; dt < 4; ++dt) O[dt] = MFMA32(av[gq & 1][dt], pf[tt][ip].v, O[dt]);
#pragma unroll
                for (int j = 0; j < 4; ++j) {
                    float e0, e1;
                    if (tt == 0) { e0 = __builtin_amdgcn_exp2f(s0[8 * ip + 2 * j]); e1 = __builtin_amdgcn_exp2f(s0[8 * ip + 2 * j + 1]); }
                    else { e0 = __builtin_amdgcn_exp2f(s1[8 * ip + 2 * j]); e1 = __builtin_amdgcn_exp2f(s1[8 * ip + 2 * j + 1]); }
                    ps += e0 + e1;
                    pn[tt][ip].u[j] = cvt_pk_bf16(e0, e1);
                }
            }
        ps += sx(ps, 32);
        lrun += ps;
        if (resc) {
#pragma unroll
            for (int dt = 0; dt < 4; ++dt)
#pragma unroll
                for (int r = 0; r < 16; ++r) O[dt][r] *= alpha;
        }
#pragma unroll
        for (int a = 0; a < 2; ++a)
#pragma unroll
            for (int c = 0; c < 2; ++c) pf[a][c] = pn[a][c];
        {
            u16* nb = SB + ((kt + 1) & 1) * BUFE;
            *(u32x4*)(nb + lrow * 72 + lch * 8) = wr[0]; *(u32x4*)(nb + (64 + lrow) * 72 + lch * 8) = wr[1];
            *(u32x4*)(nb + (128 + lrow) * 72 + lch * 8) = wr[2]; *(u32x4*)(nb + (192 + lrow) * 72 + lch * 8) = wr[3];
        }
        __syncthreads();
}

__device__ __forceinline__ void da_iter_b(const int kt, u32x4 (&wr)[4], u32x4 (&ld)[4], f32x16 (&O)[4], V8 (&pf)[2][2], float& mrun, float& lrun, const bf16x8 (&qf)[4],
                                          u16* SB, const u16* kg0, const u16* vg0, const int mw, const int l31, const int kh, const int lrow, const int lch) {
    constexpr int BUFE = DA_BUFE;
    const u16* Ks = SB + (kt & 1) * BUFE; const u16* Vs = Ks + 128 * 72;
    {
        const int kn = kt + 2 < 64 ? kt + 2 : 63, vn = kt + 1 < 64 ? kt + 1 : 63;
        const u16* kg = kg0 + (size_t)kn * 64 * 6144; const u16* vg = vg0 + vn * 64;
        ld[0] = *(const u32x4*)(kg); ld[1] = *(const u32x4*)(kg + 64); ld[2] = *(const u32x4*)(vg); ld[3] = *(const u32x4*)(vg + (size_t)64 * L_);
    }
    {
        bf16x8 av[2][4];
#pragma unroll
        for (int dt = 0; dt < 4; ++dt) av[0][dt] = *(const bf16x8*)(Vs + (32 * dt + l31) * 72 + 8 * kh);
#pragma unroll
        for (int gq = 0; gq < 4; ++gq) {
            if (gq < 3) {
#pragma unroll
                for (int dt = 0; dt < 4; ++dt) av[(gq + 1) & 1][dt] = *(const bf16x8*)(Vs + (32 * dt + l31) * 72 + 16 * (gq + 1) + 8 * kh);
            }
#pragma unroll
            for (int dt = 0; dt < 4; ++dt) O[dt] = MFMA32(av[gq & 1][dt], pf[gq >> 1][gq & 1].v, O[dt]);
        }
    }
    f32x16 s0, s1;
    const float nm = -mrun;
#pragma unroll
    for (int r = 0; r < 16; ++r) { s0[r] = nm; s1[r] = nm; }
    {
        bf16x8 a0[4], a1[4];
#pragma unroll
        for (int ks = 0; ks < 4; ++ks) { a0[ks] = *(const bf16x8*)(Ks + (mw * 64 + l31) * 72 + 16 * ks + 8 * kh); a1[ks] = *(const bf16x8*)(Ks + (mw * 64 + 32 + l31) * 72 + 16 * ks + 8 * kh); }
#pragma unroll
        for (int ks = 0; ks < 4; ++ks) { s0 = MFMA32(a0[ks], qf[ks], s0); s1 = MFMA32(a1[ks], qf[ks], s1); }
    }
    float mx = fmaxf(s0[0], s1[0]);
#pragma unroll
    for (int r = 1; r < 16; ++r) mx = fmaxf(fmaxf(mx, s0[r]), s1[r]);
    mx = fmaxf(mx, sx(mx, 32));
    const bool resc = (kt == 0) || (__builtin_amdgcn_ballot_w64(mx > 8.0f) != 0ull);
    if (resc) {
        const float delta = (kt == 0) ? mx : fmaxf(mx, 0.f);
        const float alpha = (kt == 0) ? 0.f : __builtin_amdgcn_exp2f(-delta);
#pragma unroll
        for (int r = 0; r < 16; ++r) { s0[r] -= delta; s1[r] -= delta; }
        lrun *= alpha; mrun += delta;
#pragma unroll
        for (int dt = 0; dt < 4; ++dt)
#pragma unroll
            for (int r = 0; r < 16; ++r) O[dt][r] *= alpha;
    }
    float ps = 0.f;
#pragma unroll
    for (int ip = 0; ip < 2; ++ip)
#pragma unroll
        for (int j = 0; j < 4; ++j) {
            const float e0 = __builtin_amdgcn_exp2f(s0[8 * ip + 2 * j]), e1 = __builtin_amdgcn_exp2f(s0[8 * ip + 2 * j + 1]);
            const float f0 = __builtin_amdgcn_exp2f(s1[8 * ip + 2 * j]), f1 = __builtin_amdgcn_exp2f(s1[8 * ip + 2 * j + 1]);
            ps += (e0 + e1) + (f0 + f1);
            pf[0][ip].u[j] = cvt_pk_bf16(e0, e1); pf[1][ip].u[j] = cvt_pk_bf16(f0, f1);
        }
    ps += sx(ps, 32);
    lrun += ps;
    {
        u16* nb = SB + ((kt + 1) & 1) * BUFE;
        *(u32x4*)(nb + lrow * 72 + lch * 8) = wr[0]; *(u32x4*)(nb + (64 + lrow) * 72 + lch * 8) = wr[1];
        *(u32x4*)(nb + (128 + lrow) * 72 + lch * 8) = wr[2]; *(u32x4*)(nb + (192 + lrow) * 72 + lch * 8) = wr[3];
    }
    __syncthreads();
}

__device__ __forceinline__ void da_iter2(const int kt, f32x16 (&sc)[2], f32x16 (&sn)[2], u32x4 (&wr)[4], u32x4 (&ld)[4], f32x16 (&O)[4], V8 (&pf)[2][2], float& mrun, float& lrun,
                                         const bf16x8 (&qf)[4], u16* SB, const u16* kg0, const u16* vg0, const int mw, const int l31, const int kh, const int lrow, const int lch) {
    constexpr int BUFE = DA_BUFE;
    const u16* Ks = SB + (kt & 1) * BUFE; const u16* Vs = Ks + 128 * 72;
    {
        const int kn = kt + 3 < 64 ? kt + 3 : 63, vn = kt + 1 < 64 ? kt + 1 : 63;
        const u16* kg = kg0 + (size_t)kn * 64 * 6144; const u16* vg = vg0 + vn * 64;
        ld[0] = *(const u32x4*)(kg); ld[1] = *(const u32x4*)(kg + 64); ld[2] = *(const u32x4*)(vg); ld[3] = *(const u32x4*)(vg + (size_t)64 * L_);
    }
    {
        bf16x8 a0[4], a1[4];
#pragma unroll
        for (int ks = 0; ks < 4; ++ks) { a0[ks] = *(const bf16x8*)(Ks + (mw * 64 + l31) * 72 + 16 * ks + 8 * kh); a1[ks] = *(const bf16x8*)(Ks + (mw * 64 + 32 + l31) * 72 + 16 * ks + 8 * kh); }
        f32x16 z;
#pragma unroll
        for (int r = 0; r < 16; ++r) z[r] = 0.f;
        sn[0] = MFMA32(a0[0], qf[0], z); sn[1] = MFMA32(a1[0], qf[0], z);
#pragma unroll
        for (int ks = 1; ks < 4; ++ks) { sn[0] = MFMA32(a0[ks], qf[ks], sn[0]); sn[1] = MFMA32(a1[ks], qf[ks], sn[1]); }
    }
    float mx = fmaxf(sc[0][0], sc[1][0]);
#pragma unroll
    for (int r = 1; r < 16; ++r) mx = fmaxf(fmaxf(mx, sc[0][r]), sc[1][r]);
    mx = fmaxf(mx, sx(mx, 32));
    const bool resc = (kt == 0) || (__builtin_amdgcn_ballot_w64(mx - mrun > 8.0f) != 0ull);
    float alpha = 1.0f;
    if (resc) {
        const float mnew = (kt == 0) ? mx : fmaxf(mrun, mx);
        alpha = (kt == 0) ? 0.f : __builtin_amdgcn_exp2f(mrun - mnew);
        lrun *= alpha; mrun = mnew;
    }
    V8 pn[2][2];
    float ps = 0.f;
    bf16x8 av[2][4];
#pragma unroll
    for (int dt = 0; dt < 4; ++dt) av[0][dt] = *(const bf16x8*)(Vs + (32 * dt + l31) * 72 + 8 * kh);
#pragma unroll
    for (int tt = 0; tt < 2; ++tt)
#pragma unroll
        for (int ip = 0; ip < 2; ++ip) {
            const int gq = tt * 2 + ip;
            if (gq < 3) {
#pragma unroll
                for (int dt = 0; dt < 4; ++dt) av[(gq + 1) & 1][dt] = *(const bf16x8*)(Vs + (32 * dt + l31) * 72 + 16 * (gq + 1) + 8 * kh);
            }
#pragma unroll
            for (int dt = 0; dt < 4; ++dt) O[dt] = MFMA32(av[gq & 1][dt], pf[tt][ip].v, O[dt]);
#pragma unroll
            for (int j = 0; j < 4; ++j) {
                const float e0 = __builtin_amdgcn_exp2f(sc[tt][8 * ip + 2 * j] - mrun), e1 = __builtin_amdgcn_exp2f(sc[tt][8 * ip + 2 * j + 1] - mrun);
                ps += e0 + e1;
                pn[tt][ip].u[j] = cvt_pk_bf16(e0, e1);
            }
        }
    ps += sx(ps, 32);
    lrun += ps;
    if (resc) {
#pragma unroll
        for (int dt = 0; dt < 4; ++dt)
#pragma unroll
            for (int r = 0; r < 16; ++r) O[dt][r] *= alpha;
    }
#pragma unroll
    for (int a = 0; a < 2; ++a)
#pragma unroll
        for (int c = 0; c < 2; ++c) pf[a][c] = pn[a][c];
    {
        u16* nb = SB + ((kt + 1) & 1) * BUFE;
        *(u32x4*)(nb + lrow * 72 + lch * 8) = wr[0]; *(u32x4*)(nb + (64 + lrow) * 72 + lch * 8) = wr[1];
        *(u32x4*)(nb + (128 + lrow) * 72 + lch * 8) = wr[2]; *(u32x4*)(nb + (192 + lrow) * 72 + lch * 8) = wr[3];
    }
    __syncthreads();
}

__device__ __forceinline__ void dattn_item(const Params& P, int io, float lam_init, int item, u8* shm) {
    const int tid = opaque_tid(), wid = tid >> 6, lane = tid & 63, l31 = lane & 31, kh = lane >> 5, mw = wid >> 2, qw = wid & 3;
    const int qb = item & 31, h = (item >> 5) & 7, b = item >> 8;
    const float* lp = P.in[24] + io * 256;
    const float sa = wave_sum(lp[lane] * lp[64 + lane]), sc = wave_sum(lp[128 + lane] * lp[192 + lane]);
    const float lam = expf(sa) - expf(sc) + lam_init;
    const int tq = qb * 128 + 32 * qw + l31;
    const u16* pb = P.p + (size_t)b * L_ * 6144;
    const u16* qrow = pb + (size_t)tq * 6144 + 3072 + h * 128 + mw * 64;
    bf16x8 qf[4];
#pragma unroll
    for (int ks = 0; ks < 4; ++ks) qf[ks] = *(const bf16x8*)(qrow + 16 * ks + 8 * kh);
    f32x16 O[4];
#pragma unroll
    for (int dt = 0; dt < 4; ++dt)
#pragma unroll
        for (int r = 0; r < 16; ++r) O[dt][r] = 0.f;
    float mrun = 0.f, lrun = 0.f;
    constexpr int BUFE = (128 + 128) * 72;
    u16* SB = (u16*)shm;
    const u16* vb = P.vdT + ((size_t)(b * 8 + h) * 128) * L_;
    const int lrow = tid >> 3, lch = tid & 7;
    const u16* kg0 = pb + (size_t)lrow * 6144 + 4096 + h * 128 + lch * 8;
    const u16* vg0 = vb + (size_t)lrow * L_ + lch * 8;
    u32x4 wA[4], wB[4];
    f32x16 sA[2], sB[2];
    __syncthreads();
    {
        const u32x4 k0a = *(const u32x4*)(kg0), k0b = *(const u32x4*)(kg0 + 64);
        const u32x4 k1a = *(const u32x4*)(kg0 + (size_t)64 * 6144), k1b = *(const u32x4*)(kg0 + (size_t)64 * 6144 + 64);
        wA[0] = *(const u32x4*)(kg0 + (size_t)128 * 6144); wA[1] = *(const u32x4*)(kg0 + (size_t)128 * 6144 + 64); wA[2] = *(const u32x4*)(vg0); wA[3] = *(const u32x4*)(vg0 + (size_t)64 * L_);
        u16* B1 = SB + DA_BUFE;
        *(u32x4*)(B1 + lrow * 72 + lch * 8) = k0a; *(u32x4*)(B1 + (64 + lrow) * 72 + lch * 8) = k0b;
        *(u32x4*)(SB + lrow * 72 + lch * 8) = k1a; *(u32x4*)(SB + (64 + lrow) * 72 + lch * 8) = k1b;
        *(uint4*)(SB + (128 + lrow) * 72 + lch * 8) = make_uint4(0, 0, 0, 0); *(uint4*)(SB + (192 + lrow) * 72 + lch * 8) = make_uint4(0, 0, 0, 0);
    }
    __syncthreads();
    {
        const u16* Ks = SB + DA_BUFE;
        bf16x8 a0[4], a1[4];
#pragma unroll
        for (int ks = 0; ks < 4; ++ks) { a0[ks] = *(const bf16x8*)(Ks + (mw * 64 + l31) * 72 + 16 * ks + 8 * kh); a1[ks] = *(const bf16x8*)(Ks + (mw * 64 + 32 + l31) * 72 + 16 * ks + 8 * kh); }
#pragma unroll
        for (int r = 0; r < 16; ++r) { sA[0][r] = 0.f; sA[1][r] = 0.f; }
#pragma unroll
        for (int ks = 0; ks < 4; ++ks) { sA[0] = MFMA32(a0[ks], qf[ks], sA[0]); sA[1] = MFMA32(a1[ks], qf[ks], sA[1]); }
    }
    __syncthreads();
    V8 pf[2][2];
#pragma unroll
    for (int a = 0; a < 2; ++a)
#pragma unroll
        for (int c = 0; c < 2; ++c) pf[a][c].q = make_uint4(0, 0, 0, 0);
#pragma unroll 1
    for (int kt2 = 0; kt2 < 64; kt2 += 2) {
        da_iter2(kt2, sA, sB, wA, wB, O, pf, mrun, lrun, qf, SB, kg0, vg0, mw, l31, kh, lrow, lch);
        da_iter2(kt2 + 1, sB, sA, wB, wA, O, pf, mrun, lrun, qf, SB, kg0, vg0, mw, l31, kh, lrow, lch);
    }
    {
        const u16* Vs = SB + 128 * 72;
#pragma unroll
        for (int tt = 0; tt < 2; ++tt)
#pragma unroll
            for (int ip = 0; ip < 2; ++ip)
#pragma unroll
                for (int dt = 0; dt < 4; ++dt) {
                    const bf16x8 av = *(const bf16x8*)(Vs + (32 * dt + l31) * 72 + 32 * tt + 16 * ip + 8 * kh);
                    O[dt] = MFMA32(av, pf[tt][ip].v, O[dt]);
                }
    }
    __syncthreads();
    float* comb = (float*)shm;
    const float inv = 1.0f / lrun;
    if (mw == 1) {
#pragma unroll
        for (int dt = 0; dt < 4; ++dt)
#pragma unroll
            for (int i4 = 0; i4 < 4; ++i4) {
                const int d = 32 * dt + 8 * i4 + 4 * kh;
                *(float4*)(comb + (32 * qw + l31) * 132 + d) = make_float4(O[dt][4 * i4] * inv, O[dt][4 * i4 + 1] * inv, O[dt][4 * i4 + 2] * inv, O[dt][4 * i4 + 3] * inv);
            }
    }
    __syncthreads();
    if (mw == 0) {
        float ss = 0.f;
#pragma unroll
        for (int dt = 0; dt < 4; ++dt)
#pragma unroll
            for (int i4 = 0; i4 < 4; ++i4) {
                const int d = 32 * dt + 8 * i4 + 4 * kh;
                const float4 o1 = *(const float4*)(comb + (32 * qw + l31) * 132 + d);
                const float a0 = O[dt][4 * i4] * inv - lam * o1.x, a1 = O[dt][4 * i4 + 1] * inv - lam * o1.y, a2 = O[dt][4 * i4 + 2] * inv - lam * o1.z, a3 = O[dt][4 * i4 + 3] * inv - lam * o1.w;
                O[dt][4 * i4] = a0; O[dt][4 * i4 + 1] = a1; O[dt][4 * i4 + 2] = a2; O[dt][4 * i4 + 3] = a3;
                ss += a0 * a0 + a1 * a1 + a2 * a2 + a3 * a3;
            }
        ss += sx(ss, 32);
        const float rstd = rsqrtf(ss * (1.0f / 128.0f) + 1e-6f) * (1.0f - lam_init);
        const float* sg = P.in[25] + io * 128;
        u16* yp = P.y + (size_t)(b * L_ + tq) * D_ + 1024 + h * 128;
#pragma unroll
        for (int dt = 0; dt < 4; ++dt)
#pragma unroll
            for (int i4 = 0; i4 < 4; ++i4) {
                const int d = 32 * dt + 8 * i4 + 4 * kh;
                const float4 g4 = *(const float4*)(sg + d);
                u32x2 w; w.x = cvt_pk_bf16(O[dt][4 * i4] * rstd * g4.x, O[dt][4 * i4 + 1] * rstd * g4.y); w.y = cvt_pk_bf16(O[dt][4 * i4 + 2] * rstd * g4.z, O[dt][4 * i4 + 3] * rstd * g4.w);
                *(u32x2*)(yp + d) = w;
            }
    }
}

__device__ __forceinline__ void cgfix_phase(const Params& P, int l) {
    const float* cw = P.in[5] + (size_t)l * 3 * F2_; const float* cb = P.in[6] + (size_t)l * F2_;
    const int nth = gridDim.x * 512;
    for (int idx = blockIdx.x * 512 + opaque_tid(); idx < 257 * 2 * 704; idx += nth) {
        const int chunk = idx % 704, t = idx / 704, which = t & 1, k = t >> 1, f0 = chunk * 8;
        const int row = which ? 64 * k : 64 * k - 1;
        if (row < 0 || row >= T_) continue;
        const int s0 = row & 4095;
        const int rp = row - 1, rn = row + 1;
        const u16* ec = P.edge + (size_t)((row >> 6) * 4 + ((row & 63) < 2 ? (row & 63) : (row & 63) - 60)) * F2_ + f0;
        const uint4 zero = make_uint4(0, 0, 0, 0);
        uint4 pg = zero, pv = zero, ng = zero, nv = zero;
        if (s0 > 0) { const u16* ep = P.edge + (size_t)((rp >> 6) * 4 + ((rp & 63) < 2 ? (rp & 63) : (rp & 63) - 60)) * F2_ + f0; pg = *(const uint4*)ep; pv = *(const uint4*)(ep + F_); }
        if (s0 < 4095) { const u16* en = P.edge + (size_t)((rn >> 6) * 4 + ((rn & 63) < 2 ? (rn & 63) : (rn & 63) - 60)) * F2_ + f0; ng = *(const uint4*)en; nv = *(const uint4*)(en + F_); }
        const uint4 cg_ = *(const uint4*)ec, cv = *(const uint4*)(ec + F_);
        const unsigned a0[4] = {pg.x, pg.y, pg.z, pg.w}, a1[4] = {cg_.x, cg_.y, cg_.z, cg_.w}, a2[4] = {ng.x, ng.y, ng.z, ng.w};
        const unsigned c0[4] = {pv.x, pv.y, pv.z, pv.w}, c1[4] = {cv.x, cv.y, cv.z, cv.w}, c2[4] = {nv.x, nv.y, nv.z, nv.w};
        unsigned ow[4];
#pragma unroll
        for (int j = 0; j < 4; ++j) {
            const int fa = f0 + 2 * j, fb = fa + 1;
            const float gl = cw[fa] * bflo(a0[j]) + cw[F2_ + fa] * bflo(a1[j]) + cw[2 * F2_ + fa] * bflo(a2[j]) + cb[fa];
            const float gh = cw[fb] * bfhi(a0[j]) + cw[F2_ + fb] * bfhi(a1[j]) + cw[2 * F2_ + fb] * bfhi(a2[j]) + cb[fb];
            const float vl = cw[F_ + fa] * bflo(c0[j]) + cw[F2_ + F_ + fa] * bflo(c1[j]) + cw[2 * F2_ + F_ + fa] * bflo(c2[j]) + cb[F_ + fa];
            const float vh = cw[F_ + fb] * bfhi(c0[j]) + cw[F2_ + F_ + fb] * bfhi(c1[j]) + cw[2 * F2_ + F_ + fb] * bfhi(c2[j]) + cb[F_ + fb];
            ow[j] = cvt_pk_bf16(gl / (1.0f + __expf(-gl)) * vl, gh / (1.0f + __expf(-gh)) * vh);
        }
        *(uint4*)(P.gated + (size_t)row * F_ + f0) = make_uint4(ow[0], ow[1], ow[2], ow[3]);
    }
}
__device__ __forceinline__ void cgtab_phase(const Params& P) {
    const int nth = gridDim.x * 512;
    for (int idx = blockIdx.x * 512 + opaque_tid(); idx < 4 * 44 * 1024; idx += nth) {
        const int c = idx & 255, k = (idx >> 8) & 3, pn = (idx >> 10) % 44, l = idx / (44 * 1024);
        const int col = (c >> 7) * F_ + 128 * pn + (c & 127);
        P.cgtab[idx] = k < 3 ? P.in[5][((size_t)l * 3 + k) * F2_ + col] : P.in[6][(size_t)l * F2_ + col];
    }
}

__device__ __forceinline__ int rstd_table(const float* ssp, const pg8::StaticOrder& S, u8* shm) {
    PG8_LAS float* rt = (PG8_LAS float*)((PG8_LAS u8*)shm + 131072);
    pg8::Unit u0; if (!S.next(0, u0)) return -1;
    const int tid = opaque_tid();
    const float4* sp = (const float4*)(ssp + (size_t)(u0.pm * 256 + (tid >> 1)) * 32 + (tid & 1) * 16);
    const float4 a = sp[0], b = sp[1], c = sp[2], d = sp[3];
    float s = ((a.x + a.y) + (a.z + a.w)) + ((b.x + b.y) + (b.z + b.w)) + ((c.x + c.y) + (c.z + c.w)) + ((d.x + d.y) + (d.z + d.w));
    s += sx(s, 1);
    if ((tid & 1) == 0) rt[tid >> 1] = rsqrtf(s * (1.0f / D_) + 1e-6f);
    __syncthreads();
    return u0.pm;
}

template <int OP>
__device__ __forceinline__ void run_op(const Params& P, const int l, const int which, u8* shm) {
    constexpr int op = OP; const int i = l >> 1;
    PG8_LAS u8* lds = (PG8_LAS u8*)shm;
    switch (op) {
    case OP_PRE: {
        const int total = P.cw_t0[16];
        for (int tile = blockIdx.x; tile < total; tile += gridDim.x) {
            int mi = 0;
#pragma unroll 1
            for (int k = 1; k < 16; ++k) if (tile >= P.cw_t0[k]) mi = k;
            convT_tile(P.cw_src[mi], P.cw_K[mi], P.cw_N[mi], P.cw_dst[mi], P.cw_g[mi], P.cw_perm[mi], tile - P.cw_t0[mi], shm);
        }
        hf1_phase(P);
        cgtab_phase(P);
        xprep_phase(P.in[0], P.h, P.ssp);
    } break;
    case OP_HF2: {
        for (int id = blockIdx.x; id < 512; id += gridDim.x) hf2_item(P, id, shm);
    } break;
    case OP_NORM: {
        if (which == 0) norm_phase(P.x, P.in[1] + l * D_, P.h, nullptr);
        else if (which == 1) norm_phase(P.x, P.in[2] + l * D_, P.h, nullptr);
        else norm_phase(P.x, P.in[8], nullptr, P.x);
    } break;
    case OP_GEMM_IN: {
        const int N = (l & 1) ? 6144 : 5120;
        pg8::Gemm g{P.h, P.wt_in[l], T_, N, D_};
        pg8::StaticOrder S; S.init(T_, N, gridDim.x, blockIdx.x);
        const int pm0 = rstd_table(P.ssp, S, shm);
        EpiStoreBf16 E{P.p, N, (l & 1) ? 0 : 2048, P.ssp, (const PG8_LAS float*)(lds + 131072), pm0};
        pg8::gemm_phase<EpiStoreBf16, pg8::StaticOrder, false>(lds, g, S, E, nullptr);
    } break;
    case OP_GEMM_UP: {
        pg8::Gemm g{P.h, P.wt_up[l], T_, F2_, D_};
        CgOrder S; S.init(T_, F2_, gridDim.x, blockIdx.x); S.tab = P.cgtab + (size_t)l * 44 * 1024; S.ldsb = lds;
        (void)rstd_table(P.ssp, S, shm);
        EpiGate E{P.gated, P.edge, (const PG8_LAS float*)(lds + LDS_RT), (const PG8_LAS float*)(lds + LDS_CGT)};
        pg8::gemm_phase<EpiGate, CgOrder, false>(lds, g, S, E, nullptr);
    } break;
    case OP_GEMM_OUT: {
        pg8::Gemm g{P.y, P.wt_out[l], T_, D_, D_};
        pg8::StaticOrder S; S.init(T_, D_, gridDim.x, blockIdx.x);
        EpiResid E{l == 0 ? P.in[0] : P.x, P.x, P.h, P.ssp};
        pg8::gemm_phase<EpiResid, pg8::StaticOrder, false>(lds, g, S, E, nullptr);
    } break;
    case OP_GEMM_DOWN: {
        pg8::Gemm g{P.gated, P.wt_down[l], T_, D_, F_};
        pg8::StaticOrder S; S.init(T_, D_, gridDim.x, blockIdx.x);
        EpiResid E{P.x, P.x, l == 3 ? (u16*)nullptr : P.h, P.ssp};
        pg8::gemm_phase<EpiResid, pg8::StaticOrder, false>(lds, g, S, E, nullptr);
    } break;
    case OP_EVEN_A: {
        for (int it = blockIdx.x; it < 256; it += gridDim.x) gmlp_item(P, i, it, shm);
        for (int tile = blockIdx.x; tile < 48 * 256; tile += 8 * gridDim.x)
            tr_tile<8>(P.p, 5120, 2048, 48, P.pT, (size_t)4 * L_, (size_t)L_, P.in[13] + (size_t)i * 3 * 3072, P.in[14] + (size_t)i * 3072, 3072, tile, gridDim.x, 48 * 256, shm);
    } break;
    case OP_HC: {
        {
            uint4* zp = (uint4*)((u16*)shm + 64 + 2 * FS);
            __syncthreads();
            unsigned z0 = 0u; asm volatile("" : "+v"(z0));
            for (int e = opaque_tid(); e < (2 * 4 * HU_B) / 8; e += 512) zp[e] = make_uint4(z0, z0, z0, z0);
            __syncthreads();
        }
        for (int c = blockIdx.x; c < 1024; c += gridDim.x) hconv_item(P, i, c, shm);
    } break;
    case OP_HB: {
        for (int tile = blockIdx.x; tile < 4096; tile += 8 * gridDim.x) trback_tile<8>(P.yT, P.y, tile, gridDim.x, 4096, shm);
    } break;
    case OP_ODD_PREP: {
        rotary_phase(P);
        for (int tile = blockIdx.x; tile < 16 * 256; tile += 8 * gridDim.x)
            tr_tile<8>(P.p, 6144, 2048, 16, P.vcT, (size_t)L_, (size_t)1024 * L_, nullptr, nullptr, 0, tile, gridDim.x, 16 * 256, shm);
        for (int tile = blockIdx.x; tile < 16 * 256; tile += 8 * gridDim.x)
            tr_tile<8>(P.p, 6144, 5120, 16, P.vdT, (size_t)L_, (size_t)1024 * L_, nullptr, nullptr, 0, tile, gridDim.x, 16 * 256, shm, true);
    } break;
    case OP_ATTN: {
        const float lam_init = 0.8f - 0.6f * expf(-0.3f * (float)l);
        for (int it = blockIdx.x; it < 1024; it += gridDim.x) {
            const int rnd = it / (int)gridDim.x, cidx = it - rnd * (int)gridDim.x;
            const int itm = (gridDim.x == 256) ? (((rnd * 8 + (cidx & 7)) << 5) + (cidx >> 3)) : it;
            dattn_item(P, i, lam_init, itm, shm);
        }
        const int wid = opaque_tid() >> 6;
        float* rpl = (float*)shm;
        __syncthreads();
        for (int e = opaque_tid(); e < 8 * 465; e += 512) rpl[e] = P.in[23][(size_t)i * 8 * 465 + e];
        __syncthreads();
        for (int wg = blockIdx.x; wg < 1024; wg += gridDim.x) {
            int bb, row, hp;
            if (gridDim.x == 256) { const int rnd = wg >> 8, cidx = wg & 255, pr = (cidx & 7) * 2 + (rnd >> 1); bb = pr >> 2; hp = pr & 3; row = (rnd & 1) * 32 + (cidx >> 3); }
            else { hp = wg & 3; row = (wg >> 2) & 63; bb = wg >> 8; }
            nattn_wgitem(P, i, bb, row, hp, rpl, shm);
        }
#ifdef PROBE_NA
        for (int wg = blockIdx.x; wg < 1024; wg += gridDim.x) {
            const int rnd = wg >> 8, cidx = wg & 255, pr = (cidx & 7) * 2 + (rnd >> 1); const int bb = pr >> 2, hp = pr & 3, row = (rnd & 1) * 32 + (cidx >> 3);
            const int id = (bb << 11) | (row << 5) | (((hp << 1) | (wid >> 2)) << 2) | (wid & 3);
            nattn_witem(P, i, id, rpl);
        }
#endif
#ifdef PROBE_DA
        for (int it = blockIdx.x; it < 1024; it += gridDim.x) dattn_item(P, i, lam_init, it, shm);
#endif
    } break;
    case OP_CG: cgfix_phase(P, l); break;

    }
}

#if MEGA
__global__ __launch_bounds__(512, 2) void k_mega(Params P) {
    extern __shared__ __attribute__((aligned(16))) u8 shm[];
    cg::grid_group grid = cg::this_grid();
    volatile LAS unsigned* xst = (volatile LAS unsigned*)((LAS u8*)shm + LDS_XST);
    if (threadIdx.x < 4) xst[threadIdx.x] = 0u;
    __syncthreads();
    (void)xcd_barrier_post(P.bar, xst);
#define XSYNC() do { XcdBarrier b_; b_.bar = P.bar; b_.x = xb_xcc_id(); b_.st = xst; xcd_barrier(b_); } while (0)
#ifndef PROBE_MASK
#define PROBE_MASK 0
#endif
#define RUNP(OP, L) do { for (int r_ = 0; r_ < (((PROBE_MASK >> (OP)) & 1) ? 2 : 1); ++r_) { run_op<OP>(P, (L), 0, shm); XSYNC(); } } while (0)
    run_op<OP_PRE>(P, 0, 0, shm);
    if (P.nsteps == -12345) grid.sync();
    XSYNC();
    if ((PROBE_MASK >> OP_PRE) & 1) { run_op<OP_PRE>(P, 0, 0, shm); XSYNC(); }
    RUNP(OP_HF2, 0);
#pragma unroll 1
    for (int l = 0; l < 4; ++l) {
        RUNP(OP_GEMM_IN, l);
        if ((l & 1) == 0) { RUNP(OP_EVEN_A, l); RUNP(OP_HC, l); RUNP(OP_HB, l); }
        else { run_op<OP_ODD_PREP>(P, l, 0, shm); XSYNC(); RUNP(OP_ATTN, l); }
        run_op<OP_GEMM_OUT>(P, l, 0, shm); XSYNC();
        RUNP(OP_GEMM_UP, l);
        RUNP(OP_CG, l);
        run_op<OP_GEMM_DOWN>(P, l, 0, shm); XSYNC();
    }
    run_op<OP_NORM>(P, 3, 2, shm);
}
#else
__global__ __launch_bounds__(512, 2) void k_step(Params P, int step) {
    extern __shared__ __attribute__((aligned(16))) u8 shm[];
    const int l = P.lyr[step], a = P.arg[step];
    switch (P.ops[step]) {
    case OP_PRE: run_op<OP_PRE>(P, l, a, shm); break; case OP_HF2: run_op<OP_HF2>(P, l, a, shm); break; case OP_NORM: run_op<OP_NORM>(P, l, a, shm); break;
    case OP_GEMM_IN: run_op<OP_GEMM_IN>(P, l, a, shm); break; case OP_EVEN_A: run_op<OP_EVEN_A>(P, l, a, shm); break; case OP_HC: run_op<OP_HC>(P, l, a, shm); break;
    case OP_HB: run_op<OP_HB>(P, l, a, shm); break; case OP_ODD_PREP: run_op<OP_ODD_PREP>(P, l, a, shm); break; case OP_ATTN: run_op<OP_ATTN>(P, l, a, shm); break;
    case OP_GEMM_OUT: run_op<OP_GEMM_OUT>(P, l, a, shm); break; case OP_GEMM_UP: run_op<OP_GEMM_UP>(P, l, a, shm); break; case OP_CG: run_op<OP_CG>(P, l, a, shm); break;
    case OP_GEMM_DOWN: run_op<OP_GEMM_DOWN>(P, l, a, shm); break;
    }
}
#endif

extern "C" void kernel_launch(void* const* d_in, const int* in_sizes, int n_in, void* d_out, int out_size, void* d_ws, size_t ws_size, hipStream_t stream) {
    Params P; std::memset((void*)&P, 0, sizeof(P));
    for (int k = 0; k < 26; ++k) P.in[k] = (const float*)d_in[k];
    P.x = (float*)d_out;
    char* ws = (char*)d_ws; size_t off = 0;
    auto take = [&](size_t bytes) { char* r = ws + off; off += (bytes + 255) & ~(size_t)255; return r; };
    int nm = 0, t0 = 0;
    auto addw = [&](const float* src, int K, int N, u16* dst, const float* g) { P.cw_src[nm] = src; P.cw_dst[nm] = dst; P.cw_g[nm] = g; P.cw_perm[nm] = (N == F2_) ? 1 : 0; P.cw_K[nm] = K; P.cw_N[nm] = N; P.cw_t0[nm] = t0; t0 += (K / 64) * (N / 256); ++nm; };
    for (int l = 0; l < 4; ++l) {
        const int N = (l & 1) ? 6144 : 5120, i = l >> 1;
        P.wt_in[l] = (u16*)take((size_t)N * D_ * 2);
        P.wt_out[l] = (u16*)take((size_t)D_ * D_ * 2);
        P.wt_up[l] = (u16*)take((size_t)F2_ * D_ * 2);
        P.wt_down[l] = (u16*)take((size_t)D_ * F_ * 2);
        addw(((l & 1) ? P.in[22] : P.in[9]) + (size_t)i * D_ * N, D_, N, P.wt_in[l], P.in[1] + (size_t)l * D_);
        addw(P.in[3] + (size_t)l * D_ * D_, D_, D_, P.wt_out[l], nullptr);
        addw(P.in[4] + (size_t)l * D_ * F2_, D_, F2_, P.wt_up[l], P.in[2] + (size_t)l * D_);
        addw(P.in[7] + (size_t)l * F_ * D_, F_, D_, P.wt_down[l], nullptr);
    }
    P.cw_t0[16] = t0; P.cw_t0[17] = 0;
    P.h = (u16*)take((size_t)T_ * D_ * 2);
    P.y = (u16*)take((size_t)T_ * D_ * 2);
    char* r1 = take((size_t)T_ * F2_ * 2);
    P.up = (u16*)r1; P.p = (u16*)r1;
    P.pT = (u16*)(r1 + (size_t)T_ * 6144 * 2); P.yT = (u16*)(r1 + (size_t)T_ * 6144 * 2 + (size_t)3072 * T_ * 2);
    P.vcT = (u16*)(r1 + (size_t)T_ * 6144 * 2); P.vdT = (u16*)(r1 + (size_t)T_ * 6144 * 2 + (size_t)1024 * T_ * 2);
    P.gated = (u16*)take((size_t)T_ * F_ * 2);
    P.filt = (u16*)take((size_t)4096 * FS * 2);
    P.invn = (float*)take(4096 * 4);
    P.h2tab = (float*)take((size_t)2 * L_ * 64 * 4);
    P.ssp = (float*)take((size_t)T_ * 32 * 4);
    P.bar = (unsigned*)take((size_t)XCD_BAR_WORDS * 4);
    P.edge = (u16*)take((size_t)(T_ / 64) * 4 * F2_ * 2);
    P.cgtab = (float*)take((size_t)4 * 44 * 1024 * 4);
    if (off > ws_size) { fprintf(stderr, "workspace too small: need %zu have %zu\n", off, ws_size); }
    int ns = 0;
#ifndef PROBE_SET
#define PROBE_SET_ 0
#else
#define PROBE_SET_ PROBE_SET
#endif
    auto add = [&](int op, int l, int a) { P.ops[ns] = op; P.lyr[ns] = l; P.arg[ns] = a; P.rep[ns] = (((PROBE_SET_ >> op) & 1) && !(op == OP_NORM && a == 2)) ? 2 : 1; ++ns; };
    add(OP_PRE, 0, 0); add(OP_HF2, 0, 0);
    for (int l = 0; l < 4; ++l) {
        add(OP_GEMM_IN, l, 0);
        if ((l & 1) == 0) { add(OP_EVEN_A, l, 0); add(OP_HC, l, 0); add(OP_HB, l, 0); }
        else { add(OP_ODD_PREP, l, 0); add(OP_ATTN, l, 0); }
        add(OP_GEMM_OUT, l, 0); add(OP_GEMM_UP, l, 0); add(OP_CG, l, 0); add(OP_GEMM_DOWN, l, 0);
        if (l == 3) add(OP_NORM, l, 2);
    }
    P.nsteps = ns;
#if MEGA
    static int grid_blocks = 0;
    if (!grid_blocks) {
        (void)hipFuncSetAttribute((const void*)k_mega, hipFuncAttributeMaxDynamicSharedMemorySize, LDS_BYTES);
        int dev = 0, cus = 0, per_cu = 0;
        (void)hipGetDevice(&dev);
        (void)hipDeviceGetAttribute(&cus, hipDeviceAttributeMultiprocessorCount, dev);
        (void)hipOccupancyMaxActiveBlocksPerMultiprocessor(&per_cu, k_mega, 512, LDS_BYTES);
        if (per_cu < 1) per_cu = 1;
        grid_blocks = cus * 1;
    }
    (void)hipMemsetAsync(P.bar, 0, (size_t)XCD_BAR_WORDS * 4, stream);
    void* args[] = {&P};
    hipError_t e = hipLaunchCooperativeKernel((void*)k_mega, dim3(grid_blocks), dim3(512), args, LDS_BYTES, stream);
    if (e != hipSuccess) fprintf(stderr, "cooperative launch failed: %s (grid %d)\n", hipGetErrorString(e), grid_blocks);
#else
    static int inited = 0;
    if (!inited) { (void)hipFuncSetAttribute((const void*)k_step, hipFuncAttributeMaxDynamicSharedMemorySize, LDS_BYTES); inited = 1; }
    for (int s = 0; s < ns; ++s) k_step<<<256, 512, LDS_BYTES, stream>>>(P, s);
#endif
}
```

```cpp
#include <hip/hip_runtime.h>
#include <hip/hip_cooperative_groups.h>
#include <cstdio>
#include <cstring>
namespace cg = cooperative_groups;
#ifndef MEGA
#define MEGA 1
#endif
__device__ __forceinline__ int opaque_tid() { int t = (int)threadIdx.x; asm volatile("" : "+v"(t)); return t; }
namespace pg8 {
#define PG8_LAS __attribute__((address_space(3)))
typedef unsigned short bf16_t;
typedef short bf16x8 __attribute__((ext_vector_type(8)));
typedef float f32x4 __attribute__((ext_vector_type(4)));
typedef unsigned u32x4 __attribute__((ext_vector_type(4)));
constexpr int BM = 256, BK = 64, HALF = 128, HTB = HALF * BK * 2  , STAGE_BYTES = 8 * HTB, NXCD = 8, WGM = 8;

__host__ __device__ __forceinline__ int lds_byte(int r, int c) { const int st = (r >> 4) * 2 + (c >> 5), rr = r & 15, cc = c & 31, ob = rr * 64 + cc * 2; return st * 1024 + (ob ^ (((ob >> 9) & 1) << 5)); }
__host__ __device__ __forceinline__ void stage_rc(int b, int& R, int& C) { const int st = b / 1024, sb = b % 1024, swz = sb ^ (((sb >> 9) & 1) << 5); R = (st >> 1) * 16 + swz / 64; C = (st & 1) * 32 + (swz % 64) / 2; }
__host__ __device__ __forceinline__ int perm32(int rho) { const int n = rho >> 4, i = rho & 15; return 8 * (i >> 2) + 4 * n + (i & 3); }

struct Unit { int pm, pn; };
struct Gemm { const bf16_t* A; const bf16_t* Bt; int M, N, K; };

struct StaticOrder {
    int nM, nN, nwg, G, c;
    __host__ __device__ void init(int M, int N, int G_, int c_) { nM = M / BM; nN = N / BM; nwg = nM * nN; G = G_; c = c_; }
    __host__ __device__ bool next(int i, Unit& u) const {
        const long L = (long)i * G + c; if (L >= nwg) return false;
        int wgid = (int)L; { const int q = nwg / NXCD, r = nwg % NXCD, xcd = wgid % NXCD, off = wgid / NXCD; wgid = (xcd < r ? xcd * (q + 1) : r * (q + 1) + (xcd - r) * q) + off; }
        const int nig = WGM * nN, gid = wgid / nig, fm = gid * WGM, gsz = (nM - fm) < WGM ? (nM - fm) : WGM;
        u.pm = fm + ((wgid % nig) % gsz); u.pn = (wgid % nig) / gsz; return true;
    }
    __device__ __forceinline__ void a_ready(const Unit&) const {}
    __device__ __forceinline__ void done(const Unit&) const {}
};
typedef __bf16 bf16x2_cv __attribute__((ext_vector_type(2)));
typedef float f32x2_cv __attribute__((ext_vector_type(2)));
__device__ __forceinline__ unsigned cvt_pk_bf16(float lo, float hi) { f32x2_cv f = {lo, hi}; bf16x2_cv b = __builtin_convertvector(f, bf16x2_cv); return __builtin_bit_cast(unsigned, b); }
typedef float f32x2 __attribute__((ext_vector_type(2)));
__device__ __forceinline__ f32x2 gelu_pk(f32x2 v) {
    const f32x2 av = __builtin_elementwise_abs(v), d = av * 0.2316418882f + 1.0f;
    f32x2 t; t.x = __builtin_amdgcn_rcpf(d.x); t.y = __builtin_amdgcn_rcpf(d.y);
    f32x2 q = t * 0.5307027145f + (-0.7265760135f); q = q * t + 0.7107068705f; q = q * t + (-0.142248368f); q = q * t + 0.127414796f; q = q * t;
    const f32x2 s = (v * v) * (-0.72134752044f);
    f32x2 e; e.x = __builtin_amdgcn_exp2f(s.x); e.y = __builtin_amdgcn_exp2f(s.y);
    const f32x2 m = v * (q * e), r = v - m;
    f32x2 o; o.x = v.x < 0.f ? m.x : r.x; o.y = v.y < 0.f ? m.y : r.y; return o;
}

template <class Epi, class Sched, bool STAMP = false>
__device__ __forceinline__ void gemm_phase(PG8_LAS unsigned char* lds, const Gemm g, const Sched& S, const Epi& E, unsigned long long* stamps) {
    const int tid = opaque_tid(), wid = __builtin_amdgcn_readfirstlane(tid >> 6), lane = tid & 63, wr = wid >> 2, wc = wid & 3, fr = lane & 15, fq = lane >> 4;
    const int K = g.K, nt = K / BK;
    int ts_lo = 0, ts_hi = 0, nts = 0; const unsigned long long rt_entry = STAMP ? (unsigned long long)wall_clock64() : 0ull;
#define PG8_STAMP() do { if (STAMP && wid == 0 && nts < 64) { const unsigned long long _c = (unsigned long long)clock64(); \
        ts_lo = (lane == nts) ? (int)(unsigned)_c : ts_lo; ts_hi = (lane == nts) ? (int)(unsigned)(_c >> 32) : ts_hi; ++nts; } } while (0)
    PG8_STAMP();
    unsigned voffA[2], voffB[2];
#pragma unroll
    for (int i = 0; i < 2; ++i) { int R, C; stage_rc(tid * 16 + i * 8192, R, C); const int Rb = Epi::PERM ? ((R & ~31) + perm32(R & 31)) : R;
        voffA[i] = (unsigned)(R * K + C) * 2u; voffB[i] = (unsigned)(Rb * K + C) * 2u; }
    const size_t kstep = (size_t)(BK * 2);
    const size_t hstep = (size_t)HALF * K * 2;
    const size_t tstep = 2 * hstep;
    const unsigned ldsw = (unsigned)wid * 1024u;
    const int aoff = lds_byte(wr * 64 + fr, fq * 8), boff = lds_byte(wc * 32 + fr, fq * 8);
#define PG8_SA(b, h) (((b) * 2 + (h)) * HTB)
#define PG8_SB(b, h) ((4 + (b) * 2 + (h)) * HTB)
#define PG8_STAGE(bufoff, gbase, voff) do { _Pragma("unroll") for (int _i = 0; _i < 2; ++_i) \
        __builtin_amdgcn_global_load_lds((const unsigned*)((const char*)(gbase) + (voff)[_i]), (PG8_LAS unsigned*)(lds + (bufoff) + ldsw + _i * 8192), 16, 0, 0); } while (0)
#define PG8_LDA(dst, b, h) do { _Pragma("unroll") for (int m = 0; m < 4; ++m) _Pragma("unroll") for (int k = 0; k < 2; ++k) dst[m][k] = *(const PG8_LAS bf16x8*)(lds + PG8_SA(b, h) + aoff + m * 2048 + k * 1024); } while (0)
#define PG8_LDB(dst, b, h) do { _Pragma("unroll") for (int n = 0; n < 2; ++n) _Pragma("unroll") for (int k = 0; k < 2; ++k) dst[n][k] = *(const PG8_LAS bf16x8*)(lds + PG8_SB(b, h) + boff + n * 2048 + k * 1024); } while (0)
#define PG8_MMA(ai, bj, At, Bt) do { __builtin_amdgcn_s_setprio(1); _Pragma("unroll") for (int m = 0; m < 4; ++m) _Pragma("unroll") for (int n = 0; n < 2; ++n) _Pragma("unroll") for (int k = 0; k < 2; ++k) \
        acc[ai][bj][m][n] = __builtin_amdgcn_mfma_f32_16x16x32_bf16(Bt[n][k], At[m][k], acc[ai][bj][m][n], 0, 0, 0); __builtin_amdgcn_s_setprio(0); } while (0)
#define PG8_WAIT_V(n) asm volatile("s_waitcnt vmcnt(" #n ")" ::: "memory")
#define PG8_WAIT_L(n) asm volatile("s_waitcnt lgkmcnt(" #n ")" ::: "memory")
#define PG8_BAR __builtin_amdgcn_s_barrier()
#define PG8_SCHED __builtin_amdgcn_sched_barrier(0)
    Unit cur, nxt; int ui = 0;
    if (!S.next(0, cur)) return;
    f32x4 acc[2][2][4][2];
#pragma unroll
    for (int a = 0; a < 2; ++a)
#pragma unroll
        for (int b = 0; b < 2; ++b)
#pragma unroll
            for (int m = 0; m < 4; ++m)
#pragma unroll
                for (int n = 0; n < 2; ++n) acc[a][b][m][n] = (f32x4){0.f, 0.f, 0.f, 0.f};
    bf16x8 At[4][2], B0[2][2], B1[2][2];
    const char* cA = (const char*)g.A + (size_t)cur.pm * tstep; const char* cB = (const char*)g.Bt + (size_t)cur.pn * tstep;
    S.a_ready(cur);
    PG8_STAGE(PG8_SB(0, 0), cB, voffB); PG8_STAGE(PG8_SA(0, 0), cA, voffA); PG8_STAGE(PG8_SB(0, 1), cB + hstep, voffB); PG8_STAGE(PG8_SA(0, 1), cA + hstep, voffA);
    if (wr == 1) PG8_BAR;
    PG8_WAIT_V(4); PG8_BAR;
    PG8_STAGE(PG8_SB(1, 0), cB + kstep, voffB); PG8_STAGE(PG8_SA(1, 0), cA + kstep, voffA); PG8_STAGE(PG8_SB(1, 1), cB + hstep + kstep, voffB);
    PG8_WAIT_V(6); PG8_BAR;
    PG8_STAMP();
    for (;;) {
        const bool has_next = S.next(ui + 1, nxt);
        const char* nA = has_next ? (const char*)g.A + (size_t)nxt.pm * tstep : cA; const char* nB = has_next ? (const char*)g.Bt + (size_t)nxt.pn * tstep : cB;
        for (int t = 0; t < nt; t += 2) {
            const bool last = (t == nt - 2);
            const char* a1 = cA + (size_t)(t + 1) * kstep;
            const char* a2 = last ? nA : cA + (size_t)(t + 2) * kstep; const char* b2 = last ? nB : cB + (size_t)(t + 2) * kstep;
            const char* a3 = a2 + kstep; const char* b3 = b2 + kstep;
            if (last && has_next) S.a_ready(nxt);
            PG8_LDB(B0, 0, 0); PG8_SCHED; PG8_LDA(At, 0, 0); PG8_STAGE(PG8_SA(1, 1), a1 + hstep, voffA);
            PG8_WAIT_L(8); PG8_BAR; PG8_WAIT_L(0); PG8_MMA(0, 0, At, B0); PG8_BAR; PG8_SCHED;
            PG8_LDB(B1, 0, 1); PG8_STAGE(PG8_SB(0, 0), b2, voffB);
            PG8_BAR; PG8_WAIT_L(0); PG8_MMA(0, 1, At, B1); PG8_BAR;
            PG8_LDA(At, 0, 1); PG8_STAGE(PG8_SA(0, 0), a2, voffA);
            PG8_BAR; PG8_WAIT_L(0); PG8_MMA(1, 0, At, B0); PG8_BAR; PG8_SCHED;
            PG8_STAGE(PG8_SB(0, 1), b2 + hstep, voffB);
            PG8_WAIT_V(6); PG8_BAR; PG8_MMA(1, 1, At, B1); PG8_BAR;
            PG8_LDB(B0, 1, 0); PG8_SCHED; PG8_LDA(At, 1, 0); PG8_STAGE(PG8_SA(0, 1), a2 + hstep, voffA);
            PG8_WAIT_L(8); PG8_BAR; PG8_WAIT_L(0); PG8_MMA(0, 0, At, B0); PG8_BAR; PG8_SCHED;
            PG8_LDB(B1, 1, 1); PG8_STAGE(PG8_SB(1, 0), b3, voffB);
            PG8_BAR; PG8_WAIT_L(0); PG8_MMA(0, 1, At, B1); PG8_BAR;
            PG8_LDA(At, 1, 1); PG8_STAGE(PG8_SA(1, 0), a3, voffA);
            PG8_BAR; PG8_WAIT_L(0); PG8_MMA(1, 0, At, B0); PG8_BAR; PG8_SCHED;
            PG8_STAGE(PG8_SB(1, 1), b3 + hstep, voffB);
            PG8_WAIT_V(6); PG8_BAR; PG8_MMA(1, 1, At, B1); PG8_BAR;
        }
        PG8_STAMP();
        if constexpr (!Epi::AFTER_DRAIN) { E(acc, cur, wr, wc, fr, fq); S.done(cur); }
        PG8_STAMP();
        if (!has_next) break;
#pragma unroll
        for (int a = 0; a < 2; ++a)
#pragma unroll
            for (int b = 0; b < 2; ++b)
#pragma unroll
                for (int m = 0; m < 4; ++m)
#pragma unroll
                    for (int n = 0; n < 2; ++n) acc[a][b][m][n] = (f32x4){0.f, 0.f, 0.f, 0.f};
        cur = nxt; cA = nA; cB = nB; ++ui;
    }
    PG8_WAIT_V(0);
    if (wr == 0) PG8_BAR;
    PG8_BAR;
    if constexpr (Epi::AFTER_DRAIN) { E.fused(acc, cur, wr, wc, fr, fq, lds, wid, lane); S.done(cur); }
    PG8_STAMP();
    if (STAMP && wid == 0) { stamps[lane] = lane < nts ? (((unsigned long long)(unsigned)ts_hi << 32) | (unsigned)ts_lo) : 0ull;
        if (lane == 62) stamps[62] = rt_entry; if (lane == 63) stamps[63] = (unsigned long long)wall_clock64(); }
#undef PG8_STAMP
#undef PG8_SA
#undef PG8_SB
#undef PG8_STAGE
#undef PG8_LDA
#undef PG8_LDB
#undef PG8_MMA
#undef PG8_WAIT_V
#undef PG8_WAIT_L
#undef PG8_BAR
#undef PG8_SCHED
}
}
#define XB_TMO      128
#define XB_XCNT(j)  (256  + 64 * (j))
#define XB_XSUB(j)  (1280 + 64 * (j))
#define XB_XGEN(j)  (2304 + 64 * (j))
#define XB_TOP      3328
#define XB_TOPGEN   3392
#define XCD_BAR_WORDS 3456
#define XB_SPIN_CAP (1u << 18)
#define LAS __attribute__((address_space(3)))

__device__ __forceinline__ unsigned xb_ld(unsigned* p)              { return __hip_atomic_load(p, __ATOMIC_RELAXED, __HIP_MEMORY_SCOPE_AGENT); }
__device__ __forceinline__ unsigned xb_add(unsigned* p, unsigned v) { return __hip_atomic_fetch_add(p, v, __ATOMIC_RELAXED, __HIP_MEMORY_SCOPE_AGENT); }
__device__ __forceinline__ unsigned xb_xcc_id() { return (unsigned)__builtin_amdgcn_s_getreg((3 << 11) | 20) & 0xFu; }
#define XB_SPIN(cond, bar) do { unsigned _sp = 0; while (cond) { __builtin_amdgcn_s_sleep(1); \
    if ((++_sp & 255u) == 0u) { if (xb_ld(&(bar)[XB_TMO])) break; if (_sp > XB_SPIN_CAP) { atomicAdd(&(bar)[XB_TMO], 1u); break; } } } } while (0)

struct XcdBarrier {
    unsigned* bar; unsigned x;
    volatile LAS unsigned* st;
};

__device__ __forceinline__ XcdBarrier xcd_barrier_post(unsigned* bar, volatile LAS unsigned* st) {
    XcdBarrier b; b.bar = bar; b.x = xb_xcc_id(); b.st = st;
    if (threadIdx.x == 0) (void)xb_add(&bar[XB_XCNT(b.x)], 1u);
    return b;
}
__device__ __forceinline__ void xcd_barrier_complete(unsigned* bar, unsigned x, unsigned& nloc, unsigned& nx) {
    const unsigned G = gridDim.x * gridDim.y * gridDim.z;
    unsigned sum, cnt, mine, sp = 0u;
    for (;;) {
        sum = 0u; cnt = 0u; mine = 0u;
#pragma unroll
        for (unsigned j = 0; j < 16; ++j) { const unsigned c = xb_ld(&bar[XB_XCNT(j)]); sum += c; cnt += (c > 0u) ? 1u : 0u; mine = (j == x) ? c : mine; }
        if (sum == G) break;
        __builtin_amdgcn_s_sleep(1);
        if ((++sp & 255u) == 0u) { if (xb_ld(&bar[XB_TMO])) break; if (sp > XB_SPIN_CAP) { atomicAdd(&bar[XB_TMO], 1u); break; } }
    }
    nloc = mine > 0u ? mine : 1u; nx = cnt > 0u ? cnt : 1u;
}

__device__ __forceinline__ void xcd_barrier(const XcdBarrier& b) {
    asm volatile("s_waitcnt vmcnt(0)" ::: "memory");
    __syncthreads();
    if (threadIdx.x == 0) {
        unsigned* bar = b.bar;
        __builtin_amdgcn_s_waitcnt(0);
        unsigned nloc = b.st[0], nx = b.st[1];
        if (nloc == 0u) { xcd_barrier_complete(bar, b.x, nloc, nx); b.st[0] = nloc; b.st[1] = nx; }
        const unsigned old = xb_add(&bar[XB_XSUB(b.x)], 1u);
        const unsigned gen = old / nloc;
        if (old + 1u == (gen + 1u) * nloc) {
            __builtin_amdgcn_fence(__ATOMIC_RELEASE, "agent");
            asm volatile("s_waitcnt vmcnt(0)" ::: "memory");
            const unsigned og = xb_add(&bar[XB_TOP], 1u);
            const unsigned tg = og / nx;
            if (og + 1u == (tg + 1u) * nx) xb_add(&bar[XB_TOPGEN], 1u);
            else XB_SPIN(xb_ld(&bar[XB_TOPGEN]) == tg, bar);
            __builtin_amdgcn_fence(__ATOMIC_ACQUIRE, "agent");
            xb_add(&bar[XB_XGEN(b.x)], 1u);
            asm volatile("s_waitcnt vmcnt(0)" ::: "memory");
        } else {
            XB_SPIN(xb_ld(&bar[XB_XGEN(b.x)]) == gen, bar);
            __builtin_amdgcn_fence(__ATOMIC_ACQUIRE, "agent");
            asm volatile("s_waitcnt vmcnt(0)" ::: "memory");
        }
    }
    __syncthreads();
}

using pg8::bf16x8; using pg8::f32x4; using pg8::u32x4; using pg8::f32x2; using pg8::cvt_pk_bf16; using pg8::gelu_pk;
typedef float f32x16 __attribute__((ext_vector_type(16)));
typedef unsigned u32x2 __attribute__((ext_vector_type(2)));
typedef unsigned short u16;
typedef unsigned char u8;

constexpr int T_ = 16384, D_ = 2048, L_ = 4096, F_ = 5632, F2_ = 11264;
constexpr int FS = 8208;
constexpr int LDS_BYTES = 131072 + 1024 + 16 + 8192;
constexpr int MAXSTEPS = 64;

enum { OP_PRE = 0, OP_HF2, OP_NORM, OP_GEMM_IN, OP_EVEN_A, OP_HC, OP_HB, OP_ODD_PREP, OP_ATTN, OP_GEMM_OUT, OP_GEMM_UP, OP_CG, OP_GEMM_DOWN };

struct Params {
    const float* in[26];
    float* x;
    u16* wt_in[4]; u16* wt_out[4]; u16* wt_up[4]; u16* wt_down[4];
    u16* h; u16* p; u16* y; u16* up; u16* gated;
    u16* pT; u16* yT; u16* vcT; u16* vdT;
    u16* filt; float* invn; float* h2tab;
    const float* cw_src[16]; u16* cw_dst[16]; const float* cw_g[16]; float* ssp; unsigned* bar;
    int cw_K[16]; int cw_N[16]; int cw_t0[18]; int cw_perm[16]; u16* edge; float* cgtab;
    int nsteps; int pad0;
    int ops[MAXSTEPS]; int lyr[MAXSTEPS]; int arg[MAXSTEPS]; int rep[MAXSTEPS];
};

union V8 { bf16x8 v; unsigned u[4]; uint4 q; };

__device__ __forceinline__ float bflo(unsigned w) { return __uint_as_float(w << 16); }
__device__ __forceinline__ float bfhi(unsigned w) { return __uint_as_float(w & 0xffff0000u); }
__device__ __forceinline__ float bf2f(u16 b) { return __uint_as_float(((unsigned)b) << 16); }
__device__ __forceinline__ u16 f2bf(float f) { unsigned u = __float_as_uint(f); u += 0x7FFFu + ((u >> 16) & 1u); return (u16)(u >> 16); }
__device__ __forceinline__ unsigned pk2(float a, float b) { return (unsigned)f2bf(a) | ((unsigned)f2bf(b) << 16); }
__device__ __forceinline__ float sx(float v, int o) {
    const int l = opaque_tid() & 63;
    return __builtin_bit_cast(float, __builtin_amdgcn_ds_bpermute((l ^ o) << 2, __builtin_bit_cast(int, v)));
}
__device__ __forceinline__ float wave_sum(float v) {
#pragma unroll
    for (int o = 32; o >= 1; o >>= 1) v += sx(v, o);
    return v;
}
#define MFMA16(a, b, c) __builtin_amdgcn_mfma_f32_16x16x32_bf16((a), (b), (c), 0, 0, 0)
#define MFMA32(a, b, c) __builtin_amdgcn_mfma_f32_32x32x16_bf16((a), (b), (c), 0, 0, 0)

struct EpiStoreBf16 {
    static constexpr bool PERM = true, AFTER_DRAIN = false;
    u16* O; int ldc; int gelu_cols; const float* SSP; const PG8_LAS float* rt; int pm0;
    __device__ __forceinline__ void operator()(const f32x4 (&acc)[2][2][4][2], const pg8::Unit& u, int wr, int wc, int fr, int fq) const {
        const int row0 = u.pm * 256 + wr * 64 + fr, col0 = u.pn * 256 + wc * 32 + 8 * fq;
        const bool act = (u.pn * 256) < gelu_cols;
#pragma unroll
        for (int ai = 0; ai < 2; ++ai)
#pragma unroll
            for (int m = 0; m < 4; ++m) {
                float rstd;
                if (u.pm == pm0) rstd = rt[wr * 64 + ai * 128 + m * 16 + fr];
                else {
                    const float4* sp = (const float4*)(SSP + (size_t)(row0 + ai * 128 + m * 16) * 32 + fq * 8);
                    const float4 sa = sp[0], sb = sp[1];
                    float ssum = (sa.x + sa.y) + (sa.z + sa.w) + (sb.x + sb.y) + (sb.z + sb.w);
                    ssum += sx(ssum, 16); ssum += sx(ssum, 32);
                    rstd = rsqrtf(ssum * (1.0f / D_) + 1e-6f);
                }
                u16* rowp = O + (size_t)(row0 + ai * 128 + m * 16) * ldc + col0;
#pragma unroll
                for (int bj = 0; bj < 2; ++bj) {
                    f32x4 v0 = acc[ai][bj][m][0] * rstd, v1 = acc[ai][bj][m][1] * rstd;
                    if (act) {
                        f32x2 a = gelu_pk((f32x2){v0[0], v0[1]}), b = gelu_pk((f32x2){v0[2], v0[3]}), c = gelu_pk((f32x2){v1[0], v1[1]}), d = gelu_pk((f32x2){v1[2], v1[3]});
                        v0 = (f32x4){a.x, a.y, b.x, b.y}; v1 = (f32x4){c.x, c.y, d.x, d.y};
                    }
                    u32x4 w; w.x = cvt_pk_bf16(v0[0], v0[1]); w.y = cvt_pk_bf16(v0[2], v0[3]); w.z = cvt_pk_bf16(v1[0], v1[1]); w.w = cvt_pk_bf16(v1[2], v1[3]);
                    *(u32x4*)(rowp + bj * 128) = w;
                }
            }
    }
};
struct EpiResid {
    static constexpr bool PERM = false, AFTER_DRAIN = false;
    const float* R; float* X; u16* XB; float* SSP;
    __device__ __forceinline__ void operator()(const f32x4 (&acc)[2][2][4][2], const pg8::Unit& u, int wr, int wc, int fr, int fq) const {
        const int row0 = u.pm * 256 + wr * 64 + fr, col0 = u.pn * 256 + wc * 32 + 4 * fq;
#pragma unroll
        for (int ai = 0; ai < 2; ++ai)
#pragma unroll
            for (int m = 0; m < 4; ++m) {
                const size_t off = (size_t)(row0 + ai * 128 + m * 16) * D_ + col0;
                float ss = 0.f;
#pragma unroll
                for (int bj = 0; bj < 2; ++bj)
#pragma unroll
                    for (int n = 0; n < 2; ++n) {
                        const f32x4 r = *(const f32x4*)(R + off + bj * 128 + n * 16);
                        const f32x4 v = acc[ai][bj][m][n] + r;
                        *(f32x4*)(X + off + bj * 128 + n * 16) = v;
                        if (XB) { ss += v[0] * v[0] + v[1] * v[1] + v[2] * v[2] + v[3] * v[3];
                            u32x2 w; w.x = cvt_pk_bf16(v[0], v[1]); w.y = cvt_pk_bf16(v[2], v[3]); *(u32x2*)(XB + off + bj * 128 + n * 16) = w; }
                    }
                if (XB) { ss += sx(ss, 16); ss += sx(ss, 32);
                    if (fq == 0) SSP[(size_t)(row0 + ai * 128 + m * 16) * 32 + u.pn * 4 + wc] = ss; }
            }
    }
};

__device__ __forceinline__ float dpp_ror1(float x) { return __builtin_bit_cast(float, __builtin_amdgcn_update_dpp(0, __builtin_bit_cast(int, x), 0x121, 0xf, 0xf, false)); }
__device__ __forceinline__ float dpp_ror15(float x) { return __builtin_bit_cast(float, __builtin_amdgcn_update_dpp(0, __builtin_bit_cast(int, x), 0x12F, 0xf, 0xf, false)); }
constexpr int LDS_RT = 131072, LDS_XST = 132096, LDS_CGT = 132112;
struct EpiGate {
    static constexpr bool PERM = true, AFTER_DRAIN = false;
    u16* G; u16* EDGE; const PG8_LAS float* rt; const PG8_LAS float* cgt;
    __device__ __forceinline__ void operator()(const f32x4 (&acc)[2][2][4][2], const pg8::Unit& u, int wr, int wc, int fr_in, int fq_in) const {
        const int lane_ = opaque_tid() & 63; const int fr = lane_ & 15, fq = lane_ >> 4;
        (void)fr_in; (void)fq_in;
        const PG8_LAS float* tb = cgt + ((u.pn >> 2) & 1) * 1024;
        const int cb = wc * 32 + 8 * fq;
        const int rowblk0 = u.pm * 256 + wr * 64;
#pragma unroll
        for (int n = 0; n < 2; ++n) {
            const int fcol = u.pn * 128 + cb + 4 * n;
#pragma unroll
            for (int ai = 0; ai < 2; ++ai) {
                float rs[4];
#pragma unroll
                for (int m = 0; m < 4; ++m) rs[m] = rt[wr * 64 + ai * 128 + m * 16 + fr];
                f32x4 o[4], eg[2], ev[2];
#pragma unroll
                for (int j = 0; j < 4; ++j) {
                    float W[4][2];
#pragma unroll
                    for (int k = 0; k < 4; ++k) { W[k][0] = tb[k * 256 + cb + 4 * n + j]; W[k][1] = tb[k * 256 + 128 + cb + 4 * n + j]; }
                    float g[4], v[4], gr[4], gl[4], vr[4], vl[4];
#pragma unroll
                    for (int m = 0; m < 4; ++m) { g[m] = acc[ai][0][m][n][j] * rs[m]; v[m] = acc[ai][1][m][n][j] * rs[m];
                        gr[m] = dpp_ror1(g[m]); gl[m] = dpp_ror15(g[m]); vr[m] = dpp_ror1(v[m]); vl[m] = dpp_ror15(v[m]); }
#pragma unroll
                    for (int m = 0; m < 4; ++m) {
                        const float gp = (fr == 0) ? (m > 0 ? gr[m > 0 ? m - 1 : 0] : 0.f) : gr[m];
                        const float gn = (fr == 15) ? (m < 3 ? gl[m < 3 ? m + 1 : 3] : 0.f) : gl[m];
                        const float vp = (fr == 0) ? (m > 0 ? vr[m > 0 ? m - 1 : 0] : 0.f) : vr[m];
                        const float vn = (fr == 15) ? (m < 3 ? vl[m < 3 ? m + 1 : 3] : 0.f) : vl[m];
                        const float cgv = W[0][0] * gp + W[1][0] * g[m] + W[2][0] * gn + W[3][0];
                        const float cvv = W[0][1] * vp + W[1][1] * v[m] + W[2][1] * vn + W[3][1];
                        o[m][j] = cgv * __builtin_amdgcn_rcpf(1.0f + __expf(-cgv)) * cvv;
                    }
                    eg[0][j] = g[0]; eg[1][j] = g[3]; ev[0][j] = v[0]; ev[1][j] = v[3];
                }
#pragma unroll
                for (int m = 0; m < 4; ++m) {
                    const bool skip = (m == 0 && fr == 0) || (m == 3 && fr == 15);
                    if (!skip) { u32x2 w; w.x = cvt_pk_bf16(o[m][0], o[m][1]); w.y = cvt_pk_bf16(o[m][2], o[m][3]);
                        *(u32x2*)(G + (size_t)(rowblk0 + ai * 128 + m * 16 + fr) * F_ + fcol) = w; }
                }
                const int blk = (rowblk0 + ai * 128) >> 6;
                if (fr < 2) { u16* ep = EDGE + (size_t)(blk * 4 + fr) * F2_ + fcol;
                    u32x2 w; w.x = cvt_pk_bf16(eg[0][0], eg[0][1]); w.y = cvt_pk_bf16(eg[0][2], eg[0][3]); *(u32x2*)ep = w;
                    u32x2 x; x.x = cvt_pk_bf16(ev[0][0], ev[0][1]); x.y = cvt_pk_bf16(ev[0][2], ev[0][3]); *(u32x2*)(ep + F_) = x; }
                if (fr >= 14) { u16* ep = EDGE + (size_t)(blk * 4 + fr - 12) * F2_ + fcol;
                    u32x2 w; w.x = cvt_pk_bf16(eg[1][0], eg[1][1]); w.y = cvt_pk_bf16(eg[1][2], eg[1][3]); *(u32x2*)ep = w;
                    u32x2 x; x.x = cvt_pk_bf16(ev[1][0], ev[1][1]); x.y = cvt_pk_bf16(ev[1][2], ev[1][3]); *(u32x2*)(ep + F_) = x; }
            }
        }
    }
};
struct CgOrder : pg8::StaticOrder {
    const float* tab; PG8_LAS u8* ldsb;
    __device__ __forceinline__ void a_ready(const pg8::Unit& u) const {
        const int t = opaque_tid(), wid = __builtin_amdgcn_readfirstlane(t >> 6), lane = t & 63;
        if (wid < 4) {
            const float* src = tab + (size_t)u.pn * 1024 + wid * 256 + lane * 4;
            __builtin_amdgcn_global_load_lds((const unsigned*)src, (PG8_LAS unsigned*)(ldsb + LDS_CGT + ((u.pn >> 2) & 1) * 4096 + wid * 1024), 16, 0, 0);
        }
    }
    __device__ __forceinline__ void done(const pg8::Unit&) const {}
};

__device__ __forceinline__ void convT_tile(const float* __restrict__ W, int K, int N, u16* __restrict__ Wt, const float* __restrict__ gk, int permF, int tile, u8* shm) {
    unsigned* tl = (unsigned*)shm;
    const int tid = opaque_tid(), wid = tid >> 6, lane = tid & 63;
    const int nN = N >> 8, kt = tile / nN, nt = tile - kt * nN, k0 = kt * 64, n0 = nt * 256;
    float v[8][4];
#pragma unroll
    for (int r = 0; r < 8; ++r)
#pragma unroll
        for (int e = 0; e < 4; ++e) v[r][e] = W[(size_t)(k0 + wid * 8 + r) * N + (permF ? ((e >> 1) * F_ + 128 * nt + lane + 64 * (e & 1)) : (n0 + lane + 64 * e))];
    if (gk) {
#pragma unroll
        for (int r = 0; r < 8; ++r) { const float g = gk[k0 + wid * 8 + r];
#pragma unroll
            for (int e = 0; e < 4; ++e) v[r][e] *= g; }
    }
#pragma unroll
    for (int rp = 0; rp < 4; ++rp)
#pragma unroll
        for (int e = 0; e < 4; ++e) tl[(lane + 64 * e) * 33 + wid * 4 + rp] = cvt_pk_bf16(v[2 * rp][e], v[2 * rp + 1][e]);
    __syncthreads();
#pragma unroll
    for (int i = 0; i < 4; ++i) {
        const int id = i * 512 + tid, n = id >> 3, kc = id & 7;
        uint4 w; w.x = tl[n * 33 + kc * 4]; w.y = tl[n * 33 + kc * 4 + 1]; w.z = tl[n * 33 + kc * 4 + 2]; w.w = tl[n * 33 + kc * 4 + 3];
        *(uint4*)(Wt + (size_t)(n0 + n) * K + k0 + kc * 8) = w;
    }
    __syncthreads();
}

__device__ __forceinline__ void norm_phase(const float* x, const float* __restrict__ g, u16* h, float* outf) {
    const int wid = opaque_tid() >> 6, lane = opaque_tid() & 63;
    for (int row = blockIdx.x * 8 + wid; row < T_; row += gridDim.x * 8) {
        const float* xr = x + (size_t)row * D_;
        float4 v[8]; float ss = 0.f;
#pragma unroll
        for (int i = 0; i < 8; ++i) { v[i] = *(const float4*)(xr + i * 256 + lane * 4); ss += v[i].x * v[i].x + v[i].y * v[i].y + v[i].z * v[i].z + v[i].w * v[i].w; }
        ss = wave_sum(ss);
        const float rstd = rsqrtf(ss * (1.0f / D_) + 1e-6f);
#pragma unroll
        for (int i = 0; i < 8; ++i) {
            const float4 gg = *(const float4*)(g + i * 256 + lane * 4);
            const float a = v[i].x * rstd * gg.x, b = v[i].y * rstd * gg.y, c = v[i].z * rstd * gg.z, d = v[i].w * rstd * gg.w;
            if (outf) *(float4*)(outf + (size_t)row * D_ + i * 256 + lane * 4) = make_float4(a, b, c, d);
            else { u32x2 w; w.x = cvt_pk_bf16(a, b); w.y = cvt_pk_bf16(c, d); *(u32x2*)(h + (size_t)row * D_ + i * 256 + lane * 4) = w; }
        }
    }
}

__device__ __forceinline__ void xprep_phase(const float* x, u16* xb, float* ssp) {
    const int wid = opaque_tid() >> 6, lane = opaque_tid() & 63;
    for (int row = blockIdx.x * 8 + wid; row < T_; row += gridDim.x * 8) {
        const float* xr = x + (size_t)row * D_;
        float ss = 0.f;
#pragma unroll
        for (int i = 0; i < 8; ++i) { const float4 v = *(const float4*)(xr + i * 256 + lane * 4); ss += v.x * v.x + v.y * v.y + v.z * v.z + v.w * v.w;
            u32x2 w; w.x = cvt_pk_bf16(v.x, v.y); w.y = cvt_pk_bf16(v.z, v.w); *(u32x2*)(xb + (size_t)row * D_ + i * 256 + lane * 4) = w; }
        ss = wave_sum(ss);
        if (lane < 32) ssp[(size_t)row * 32 + lane] = lane == 0 ? ss : 0.f;
    }
}

__device__ __forceinline__ void hf1_phase(const Params& P) {
    const int wid = opaque_tid() >> 6, lane = opaque_tid() & 63;
    for (int idx = blockIdx.x * 8 + wid; idx < 2 * L_; idx += gridDim.x * 8) {
        const int i = idx >> 12, t = idx & 4095;
        const float* w1 = P.in[15] + i * 33 * 64; const float* b1 = P.in[16] + i * 64;
        const float* w2 = P.in[17] + i * 64 * 64; const float* b2 = P.in[18] + i * 64;
        const float* fr = P.in[20] + i * 128;
        const float tn = (float)t / 4095.0f;
        const float w = (6.283185307179586f * (float)t) / 4096.0f;
        float acc = b1[lane] + tn * w1[lane];
        {
            const float band = 1e-4f + (float)(lane & 15) * ((15.0f - 1e-4f) / 15.0f);
            const float a = w * band;
            const float zv = ((lane & 16) == 0) ? cosf(a) : -sinf(a);
#pragma unroll 8
            for (int k = 0; k < 32; ++k) acc += __shfl(zv, k) * w1[(1 + k) * 64 + lane];
        }
        const float h1 = sinf(fr[lane] * acc);
        float acc2 = b2[lane];
#pragma unroll 8
        for (int k = 0; k < 64; ++k) acc2 += __shfl(h1, k) * w2[k * 64 + lane];
        ((u16*)P.h2tab)[(size_t)idx * 64 + lane] = f2bf(sinf(fr[64 + lane] * acc2));
    }
}

__device__ __forceinline__ void hf2_item(const Params& P, int id, u8* shm) {
    u16* w3s = (u16*)shm;
    float* red = (float*)(shm + 4096);
    const int tid = opaque_tid(), wid = tid >> 6, lane = tid & 63, n = lane & 15, quad = lane >> 4;
    const int cb = id & 127, o = (id >> 7) & 1, i = id >> 8;
    const float* w3 = P.in[19] + (size_t)i * 64 * 4096;
    __syncthreads();
#pragma unroll
    for (int j = 0; j < 2; ++j) { const int e = j * 512 + tid, k = e >> 4, col = e & 15; w3s[col * 72 + k] = f2bf(w3[(size_t)k * 4096 + o * 2048 + (col >> 3) * 1024 + cb * 8 + (col & 7)]); }
    __syncthreads();
    const bf16x8 b0 = *(const bf16x8*)(w3s + n * 72 + 8 * quad), b1 = *(const bf16x8*)(w3s + n * 72 + 32 + 8 * quad);
    const int dir = n >> 3, e8 = n & 7, ch = cb * 8 + e8;
    const float delta = 3.0701134573253945f + (15.350567286626973f - 3.0701134573253945f) * ((float)ch / 1023.0f);
    u16* fb = P.filt + ((size_t)(i * 2 + o) * 1024 + ch) * FS;
    const u16* hb = (const u16*)P.h2tab + (size_t)i * 4096 * 64;
    float asum = 0.f;
#pragma unroll 2
    for (int tile = wid; tile < 256; tile += 8) {
        const u16* hp = hb + (size_t)(tile * 16 + n) * 64 + 8 * quad;
        const bf16x8 a0 = *(const bf16x8*)hp, a1 = *(const bf16x8*)(hp + 32);
        f32x4 acc = (f32x4){0.f, 0.f, 0.f, 0.f};
        acc = MFMA16(a0, b0, acc); acc = MFMA16(a1, b1, acc);
        const int t0 = tile * 16 + 4 * quad;
        float v[4];
#pragma unroll
        for (int j = 0; j < 4; ++j) { const float tn = (float)(t0 + j) / 4095.0f; v[j] = acc[j] * expf(-tn * delta); }
        if (dir == 0) {
#pragma unroll
            for (int j = 0; j < 4; ++j) { fb[4096 - (t0 + j)] = f2bf(v[j]); asum += fabsf(v[j]); }
        } else {
            u32x2 w; w.x = cvt_pk_bf16(v[0], v[1]); w.y = cvt_pk_bf16(v[2], v[3]);
            if (t0 == 0) { fb[4097] = f2bf(v[1]); fb[4098] = f2bf(v[2]); fb[4099] = f2bf(v[3]); asum += fabsf(v[1]) + fabsf(v[2]) + fabsf(v[3]); }
            else { *(u32x2*)(fb + 4096 + t0) = w; asum += (fabsf(v[0]) + fabsf(v[1])) + (fabsf(v[2]) + fabsf(v[3])); }
        }
    }
    if (tid < 8 * 17) { const int e = tid / 17, j = tid % 17; (P.filt + ((size_t)(i * 2 + o) * 1024 + cb * 8 + e) * FS)[j == 0 ? 0 : 8191 + j] = 0; }
    asum += sx(asum, 16); asum += sx(asum, 32); asum += sx(asum, 8);
    if (lane < 8) red[wid * 8 + lane] = asum;
    __syncthreads();
    if (tid < 8) { float s = 0.f; for (int w = 0; w < 8; ++w) s += red[w * 8 + tid]; P.invn[(i * 2 + o) * 1024 + cb * 8 + tid] = 1.0f / s; }
}

template <int NT>
__device__ __forceinline__ void tr_tile(const u16* __restrict__ src, int src_ld, int col0, int nct, u16* __restrict__ dst, size_t ch_stride, size_t b_stride,
                                        const float* cw, const float* cb, int cw_ld, int tile0, int tstride, int ntot, u8* shm, bool perm = false) {
    const int tid = opaque_tid();
    const int row = tid >> 3, chunk = tid & 7;
    u32x4 w[NT], hw[NT];
#pragma unroll
    for (int k = 0; k < NT; ++k) {
        const int tile = tile0 + k * tstride;
        w[k] = (u32x4){0u, 0u, 0u, 0u}; hw[k] = (u32x4){0u, 0u, 0u, 0u};
        if (tile < ntot) {
            const int ct = tile % nct, bs = tile / nct, st = bs & 63, b = bs >> 6, s0 = st * 64, c0 = ct * 64;
            w[k] = *(const u32x4*)(src + (size_t)(b * L_ + s0 + row) * src_ld + col0 + c0 + chunk * 8);
            if (tid < 16) { const int hr = tid >> 3, s = hr ? s0 + 64 : s0 - 1;
                if (s >= 0 && s < L_) hw[k] = *(const u32x4*)(src + (size_t)(b * L_ + s) * src_ld + col0 + c0 + chunk * 8); }
        }
    }
#pragma unroll
    for (int k = 0; k < NT; ++k) {
        unsigned* tl = (unsigned*)shm + k * (66 * 33 + 2);
        unsigned* d = tl + (row + 1) * 33 + chunk * 4; d[0] = w[k].x; d[1] = w[k].y; d[2] = w[k].z; d[3] = w[k].w;
        if (tid < 16) { const int hr = tid >> 3; unsigned* hd = tl + (hr ? 65 : 0) * 33 + chunk * 4; hd[0] = hw[k].x; hd[1] = hw[k].y; hd[2] = hw[k].z; hd[3] = hw[k].w; }
    }
    __syncthreads();
#pragma unroll
    for (int k = 0; k < NT; ++k) {
        const int tile = tile0 + k * tstride;
        if (tile < ntot) {
            const u16* tl16 = (const u16*)((unsigned*)shm + k * (66 * 33 + 2));
            const int ct = tile % nct, bs = tile / nct, st = bs & 63, b = bs >> 6, s0 = st * 64, c0 = ct * 64;
            const int ch = tid >> 3, sc = tid & 7;
            float o[8];
            if (cw) {
                const float w0 = cw[c0 + ch], w1 = cw[cw_ld + c0 + ch], w2 = cw[2 * cw_ld + c0 + ch], bb = cb[c0 + ch];
                float r[10];
#pragma unroll
                for (int j = 0; j < 10; ++j) r[j] = bf2f(tl16[(sc * 8 + j) * 66 + ch]);
#pragma unroll
                for (int j = 0; j < 8; ++j) o[j] = w0 * r[j] + w1 * r[j + 1] + w2 * r[j + 2] + bb;
            } else {
#pragma unroll
                for (int j = 0; j < 8; ++j) o[j] = bf2f(tl16[(sc * 8 + j + 1) * 66 + ch]);
            }
            uint4 wv; wv.x = cvt_pk_bf16(o[0], o[1]); wv.y = cvt_pk_bf16(o[2], o[3]); wv.z = cvt_pk_bf16(o[4], o[5]); wv.w = cvt_pk_bf16(o[6], o[7]);
            u16* dp = dst + (size_t)(c0 + ch) * ch_stride + (size_t)b * b_stride + s0;
            if (!perm) *(uint4*)(dp + sc * 8) = wv;
            else { u32x2 lo; lo.x = wv.x; lo.y = wv.y; u32x2 hi; hi.x = wv.z; hi.y = wv.w;
                *(u32x2*)(dp + 16 * (sc >> 1) + 4 * (sc & 1)) = lo; *(u32x2*)(dp + 16 * (sc >> 1) + 8 + 4 * (sc & 1)) = hi; }
        }
    }
    __syncthreads();
}

template <int NT>
__device__ __forceinline__ void trback_tile(const u16* __restrict__ yT, u16* __restrict__ y, int tile0, int tstride, int ntot, u8* shm) {
    const int tid = opaque_tid();
    u32x4 w[NT];
#pragma unroll
    for (int k = 0; k < NT; ++k) {
        const int tile = tile0 + k * tstride;
        w[k] = (u32x4){0u, 0u, 0u, 0u};
        if (tile < ntot) { const int ct = tile & 15, bs = tile >> 4, st = bs & 63, b = bs >> 6, t0 = st * 64, c0 = ct * 64; const int c = tid >> 3, chunk = tid & 7;
            w[k] = *(const u32x4*)(yT + ((size_t)(c0 + c) * 4 + b) * L_ + t0 + chunk * 8); }
    }
#pragma unroll
    for (int k = 0; k < NT; ++k) { const int c = tid >> 3, chunk = tid & 7; unsigned* d = (unsigned*)shm + k * (64 * 33 + 2) + c * 33 + chunk * 4; d[0] = w[k].x; d[1] = w[k].y; d[2] = w[k].z; d[3] = w[k].w; }
    __syncthreads();
#pragma unroll
    for (int k = 0; k < NT; ++k) {
        const int tile = tile0 + k * tstride;
        if (tile < ntot) {
            const u16* tl16 = (const u16*)((unsigned*)shm + k * (64 * 33 + 2));
            const int ct = tile & 15, bs = tile >> 4, st = bs & 63, b = bs >> 6, t0 = st * 64, c0 = ct * 64;
            const int t = tid >> 3, cc = tid & 7;
            unsigned short e[8];
#pragma unroll
            for (int j = 0; j < 8; ++j) e[j] = tl16[(cc * 8 + j) * 66 + t];
            uint4 wv; wv.x = e[0] | ((unsigned)e[1] << 16); wv.y = e[2] | ((unsigned)e[3] << 16); wv.z = e[4] | ((unsigned)e[5] << 16); wv.w = e[6] | ((unsigned)e[7] << 16);
            *(uint4*)(y + (size_t)(b * L_ + t0 + t) * D_ + 1024 + c0 + cc * 8) = wv;
        }
    }
    __syncthreads();
}

constexpr int HU_B = 5792, HU_J = 72, HU_P = 7;
__device__ __forceinline__ void hc_loadF(V8& f, const u16* Fo  , int j) {
    const unsigned* fp = (const unsigned*)(Fo - 16 * j);
    f.u[0] = fp[0]; f.u[1] = fp[1]; f.u[2] = fp[2]; f.u[3] = fp[3];
}
__device__ __forceinline__ void hc_loadB(V8 (&bv)[2][2], const u16* Uo, int m, int wid, int n, int quad) {
#pragma unroll
    for (int nt = 0; nt < 2; ++nt) {
        const int ii = 4 * (2 * wid + nt) + (n >> 2), b = n & 3, j = ii - m;
        const u16* up = Uo + b * HU_B + (j + HU_P) * HU_J + 8 * quad;
#pragma unroll
        for (int ks = 0; ks < 2; ++ks) bv[ks][nt].q = *(const uint4*)(up + 32 * ks);
    }
}
template <int PAR>
__device__ __forceinline__ void hc_step(V8 (&F)[16], f32x4 (&acc)[4][2], const V8 (&bc)[2][2], V8 (&bn)[2][2], const u16* Fo, const u16* Uo, int m, int wid, int n, int quad, int sh) {
    V8 nf[4];
#pragma unroll
    for (int e = 0; e < 4; ++e) hc_loadF(nf[e], Fo, 4 * (m + 1) + e);
    hc_loadB(bn, Uo, m + 1, wid, n, quad);
    __builtin_amdgcn_s_setprio(1);
#pragma unroll
    for (int ks = 0; ks < 2; ++ks)
#pragma unroll
        for (int mt = 0; mt < 4; ++mt) {
            const int slot = (PAR * 4 + mt - 2 * ks) & 15;
            acc[mt][0] = MFMA16(F[slot].v, bc[ks][0].v, acc[mt][0]);
            acc[mt][1] = MFMA16(F[slot].v, bc[ks][1].v, acc[mt][1]);
        }
    __builtin_amdgcn_s_setprio(0);
#pragma unroll
    for (int e = 0; e < 4; ++e) F[(PAR * 4 + 4 + e) & 15] = nf[e];
}

__device__ __forceinline__ void hconv_item(const Params& P, int i, int c, u8* shm) {
    u16* FA = (u16*)shm + 64; u16* FB = FA + FS; u16* U = FB + FS; u16* Z = U + 4 * HU_B;
    const int tid = opaque_tid(), wid = tid >> 6, lane = tid & 63, n = lane & 15, quad = lane >> 4;
    __syncthreads();
    {
        const uint4* su = (const uint4*)(P.pT + (size_t)c * 4 * L_);
#pragma unroll
        for (int j = 0; j < 4; ++j) { const int cidx = j * 512 + tid, bb = cidx >> 9, tt = (cidx & 511) * 8; *(uint4*)(U + bb * HU_B + ((tt >> 6) + HU_P) * HU_J + (tt & 63)) = su[cidx]; }
    }
    __syncthreads();
    const float skip0 = P.in[21][(i * 2 + 0) * 1024 + c], skip1 = P.in[21][(i * 2 + 1) * 1024 + c];
    const float in0 = P.invn[(i * 2 + 0) * 1024 + c], in1 = P.invn[(i * 2 + 1) * 1024 + c];
    const int sh = (n & 1) * 16;
#pragma unroll 1
    for (int o = 0; o < 2; ++o) {
        {
            const uint4* sf = (const uint4*)(P.filt + ((size_t)(i * 2 + o) * 1024 + c) * FS);
            for (int j = tid; j < FS / 8; j += 512) ((uint4*)FA)[j] = sf[j];
            __syncthreads();
            const unsigned* fa = (const unsigned*)FA; unsigned* fb = (unsigned*)FB;
            for (int k = tid; k < FS / 2; k += 512) fb[k] = __builtin_amdgcn_alignbit(fa[k + 1], fa[k], 16);
            __syncthreads();
        }
        const u16* Fo = ((n & 1) ? FB : FA) + ((4096 - n + 8 * quad) & ~1); const u16* Uo = o ? Z : U;
        f32x4 acc[4][2];
#pragma unroll
        for (int mt = 0; mt < 4; ++mt) { acc[mt][0] = (f32x4){0.f, 0.f, 0.f, 0.f}; acc[mt][1] = (f32x4){0.f, 0.f, 0.f, 0.f}; }
        V8 F[16];
#pragma unroll
        for (int e = 0; e < 16; ++e) F[e].q = make_uint4(0, 0, 0, 0);
        const int mb = 8 * wid - 64;
        V8 ba[2][2], bb[2][2];
        const u16* gsrc = P.pT + ((size_t)((o ? 2048 : 1024) + c) * 4) * L_;
        u32x2 ggp[2][4];
#pragma unroll
        for (int nt = 0; nt < 2; ++nt) { const int ii = 4 * (2 * wid + nt) + (n >> 2), b = n & 3;
#pragma unroll
            for (int mt = 0; mt < 4; ++mt) ggp[nt][mt] = *(const u32x2*)(gsrc + (size_t)b * L_ + 64 * ii + 16 * mt + 4 * quad); }
#pragma unroll
        for (int e = 0; e < 4; ++e) hc_loadF(F[e], Fo, 4 * mb + e);
        hc_loadB(ba, Uo, mb, wid, n, quad);
#pragma unroll 1
        for (int kk = 0; kk < 18; ++kk) {
            const int m0 = mb + 4 * kk;
            hc_step<0>(F, acc, ba, bb, Fo, Uo, m0, wid, n, quad, sh);
            hc_step<1>(F, acc, bb, ba, Fo, Uo, m0 + 1, wid, n, quad, sh);
            hc_step<2>(F, acc, ba, bb, Fo, Uo, m0 + 2, wid, n, quad, sh);
            hc_step<3>(F, acc, bb, ba, Fo, Uo, m0 + 3, wid, n, quad, sh);
        }
        const float sk = o ? skip1 : skip0, inn = o ? in1 : in0;
#pragma unroll
        for (int nt = 0; nt < 2; ++nt) {
            const int ii = 4 * (2 * wid + nt) + (n >> 2), b = n & 3;
#pragma unroll
            for (int mt = 0; mt < 4; ++mt) {
                const int t0 = 64 * ii + 16 * mt + 4 * quad;
                const int uidx = b * HU_B + ((t0 >> 6) + HU_P) * HU_J + (t0 & 63);
                const u32x2 uu = *(const u32x2*)(Uo + uidx);
                const u32x2 gg = ggp[nt][mt];
                const float r0 = bflo(gg.x) * (acc[mt][nt][0] * inn + sk * bflo(uu.x));
                const float r1 = bfhi(gg.x) * (acc[mt][nt][1] * inn + sk * bfhi(uu.x));
                const float r2 = bflo(gg.y) * (acc[mt][nt][2] * inn + sk * bflo(uu.y));
                const float r3 = bfhi(gg.y) * (acc[mt][nt][3] * inn + sk * bfhi(uu.y));
                u32x2 w; w.x = cvt_pk_bf16(r0, r1); w.y = cvt_pk_bf16(r2, r3);
                if (o == 0) *(u32x2*)(Z + uidx) = w;
                else *(u32x2*)(P.yT + ((size_t)c * 4 + b) * L_ + t0) = w;
            }
        }
        __syncthreads();
    }
}

__device__ __forceinline__ void gmlp_item(const Params& P, int i, int item, u8* shm) {
    float* rs = (float*)shm; u16* Ws = (u16*)(shm + 512); u16* Vt = Ws + 128 * 136;
    const int tid = opaque_tid(), wid = tid >> 6, lane = tid & 63, n = lane & 15, quad = lane >> 4;
    const int bc = item >> 1, gh = item & 1, tok0 = bc * 128;
    const u16* p = P.p;
    __syncthreads();
    {
        const int q = tid >> 2, part = tid & 3; float ss = 0.f;
        const uint4* vp = (const uint4*)(p + (size_t)(tok0 + q) * 5120 + 1024 + part * 256);
#pragma unroll 4
        for (int j = 0; j < 32; ++j) { const uint4 w = vp[j];
            ss += bflo(w.x) * bflo(w.x) + bfhi(w.x) * bfhi(w.x) + bflo(w.y) * bflo(w.y) + bfhi(w.y) * bfhi(w.y) + bflo(w.z) * bflo(w.z) + bfhi(w.z) * bfhi(w.z) + bflo(w.w) * bflo(w.w) + bfhi(w.w) * bfhi(w.w); }
        ss += sx(ss, 1); ss += sx(ss, 2);
        if (part == 0) rs[q] = rsqrtf(ss * (1.0f / 1024.0f) + 1e-6f);
    }
    __syncthreads();
    const float* gain = P.in[10] + i * 1024;
    for (int gi = 0; gi < 4; ++gi) {
        const int g = gh * 4 + gi;
        const float* ws = P.in[11] + ((size_t)(i * 8 + g)) * 16384;
#pragma unroll
        for (int j = 0; j < 8; ++j) { const int e4 = (j * 512 + tid) * 4; const float4 w = *(const float4*)(ws + e4); const int pp = e4 >> 7, qq = e4 & 127;
            u32x2 o; o.x = cvt_pk_bf16(w.x, w.y); o.y = cvt_pk_bf16(w.z, w.w); *(u32x2*)(Ws + pp * 136 + qq) = o; }
#pragma unroll
        for (int j = 0; j < 4; ++j) { const int id = j * 512 + tid, qq = id >> 4, dc = id & 15;
            const uint4 w = *(const uint4*)(p + (size_t)(tok0 + qq) * 5120 + 1024 + g * 128 + dc * 8);
            const float r = rs[qq]; const float* gp = gain + g * 128 + dc * 8;
            Vt[(dc * 8 + 0) * 136 + qq] = f2bf(bflo(w.x) * r * gp[0]); Vt[(dc * 8 + 1) * 136 + qq] = f2bf(bfhi(w.x) * r * gp[1]);
            Vt[(dc * 8 + 2) * 136 + qq] = f2bf(bflo(w.y) * r * gp[2]); Vt[(dc * 8 + 3) * 136 + qq] = f2bf(bfhi(w.y) * r * gp[3]);
            Vt[(dc * 8 + 4) * 136 + qq] = f2bf(bflo(w.z) * r * gp[4]); Vt[(dc * 8 + 5) * 136 + qq] = f2bf(bfhi(w.z) * r * gp[5]);
            Vt[(dc * 8 + 6) * 136 + qq] = f2bf(bflo(w.w) * r * gp[6]); Vt[(dc * 8 + 7) * 136 + qq] = f2bf(bfhi(w.w) * r * gp[7]); }
        __syncthreads();
        f32x4 acc[8];
#pragma unroll
        for (int dt = 0; dt < 8; ++dt) acc[dt] = (f32x4){0.f, 0.f, 0.f, 0.f};
#pragma unroll
        for (int ks = 0; ks < 4; ++ks) {
            const bf16x8 bfr = *(const bf16x8*)(Ws + (16 * wid + n) * 136 + 32 * ks + 8 * quad);
#pragma unroll
            for (int dt = 0; dt < 8; ++dt) { const bf16x8 afr = *(const bf16x8*)(Vt + (16 * dt + n) * 136 + 32 * ks + 8 * quad); acc[dt] = MFMA16(afr, bfr, acc[dt]); }
        }
        const int pp = 16 * wid + n;
        const float bsv = P.in[12][(i * 8 + g) * 128 + pp];
#pragma unroll
        for (int dt = 0; dt < 8; ++dt) {
            const int d = g * 128 + 16 * dt + 4 * quad;
            const u32x2 uu = *(const u32x2*)(p + (size_t)(tok0 + pp) * 5120 + d);
            u32x2 w; w.x = cvt_pk_bf16(bflo(uu.x) * (acc[dt][0] + bsv), bfhi(uu.x) * (acc[dt][1] + bsv)); w.y = cvt_pk_bf16(bflo(uu.y) * (acc[dt][2] + bsv), bfhi(uu.y) * (acc[dt][3] + bsv));
            *(u32x2*)(P.y + (size_t)(tok0 + pp) * D_ + d) = w;
        }
        __syncthreads();
    }
}

__device__ __forceinline__ void rotary_phase(const Params& P) {
    const int nth = gridDim.x * 512;
    for (int idx2 = blockIdx.x * 512 + opaque_tid(); idx2 < T_ * 8; idx2 += nth) {
        const int idx = idx2 >> 1, ghalf = idx2 & 1;
        const int tok = idx >> 2, dq = idx & 3, pos = tok & 4095;
        float cs[8], sn[8];
#pragma unroll
        for (int e = 0; e < 8; ++e) { const float inv = exp2f(-(float)(dq * 8 + e) * 0.41524101186092029f); const float ang = (float)pos * inv; cs[e] = cosf(ang); sn[e] = sinf(ang); }
        u16* base = P.p + (size_t)tok * 6144 + 3072;
#pragma unroll 2
        for (int g16 = 0; g16 < 16; ++g16) {
            const int grp = ghalf * 16 + g16;
            u16* gp = base + (grp >> 4) * 1024 + (grp & 15) * 64 + dq * 8;
            const float sc = (grp < 16) ? 0.125f * 1.4426950408889634f : 1.0f;
            const uint4 a = *(const uint4*)gp, b = *(const uint4*)(gp + 32);
            const unsigned aw[4] = {a.x, a.y, a.z, a.w}, bw[4] = {b.x, b.y, b.z, b.w};
            unsigned oa[4], ob[4];
#pragma unroll
            for (int j = 0; j < 4; ++j) {
                const float x1l = bflo(aw[j]), x1h = bfhi(aw[j]), x2l = bflo(bw[j]), x2h = bfhi(bw[j]);
                oa[j] = cvt_pk_bf16((x1l * cs[2 * j] - x2l * sn[2 * j]) * sc, (x1h * cs[2 * j + 1] - x2h * sn[2 * j + 1]) * sc);
                ob[j] = cvt_pk_bf16((x1l * sn[2 * j] + x2l * cs[2 * j]) * sc, (x1h * sn[2 * j + 1] + x2h * cs[2 * j + 1]) * sc);
            }
            *(uint4*)gp = make_uint4(oa[0], oa[1], oa[2], oa[3]); *(uint4*)(gp + 32) = make_uint4(ob[0], ob[1], ob[2], ob[3]);
        }
    }
}

__device__ __forceinline__ void nattn_witem(const Params& P, int io, int id, const float* rpl  ) {
    const int lane = opaque_tid() & 63, n = lane & 15, quad = lane >> 4;
    const int qb = id & 3, h = (id >> 2) & 7, r = (id >> 5) & 63, b = id >> 11;
    const int rs = min(max(r - 4, 0), 56);
    const int cw = qb == 0 ? 0 : qb == 1 ? 8 : qb == 2 ? 24 : 32;
    const int c = 16 * qb + n, cs = min(max(c - 8, 0), 48);
    const u16* pb = P.p + (size_t)b * L_ * 6144;
    bf16x8 qf[4];
#pragma unroll
    for (int ks = 0; ks < 4; ++ks) qf[ks] = *(const bf16x8*)(pb + (size_t)(r * 64 + c) * 6144 + h * 128 + 32 * ks + 8 * quad);
    f32x4 S[16];
    const int krow = 8 * (n >> 2) + (n & 3);
#pragma unroll
    for (int half = 0; half < 2; ++half) {
        bf16x8 kf[8][4];
#pragma unroll
        for (int t8 = 0; t8 < 8; ++t8) {
            const int kt = half * 8 + t8, kr = kt >> 1, ct = kt & 1;
            const u16* kp = pb + (size_t)((rs + kr) * 64 + cw + krow + 4 * ct) * 6144 + 1024 + h * 128 + 8 * quad;
#pragma unroll
            for (int ks = 0; ks < 4; ++ks) kf[t8][ks] = *(const bf16x8*)(kp + 32 * ks);
        }
#pragma unroll
        for (int t8 = 0; t8 < 8; ++t8) {
            f32x4 acc = (f32x4){0.f, 0.f, 0.f, 0.f};
#pragma unroll
            for (int ks = 0; ks < 4; ++ks) acc = MFMA16(kf[t8][ks], qf[ks], acc);
            S[half * 8 + t8] = acc;
        }
    }
    const float* rp = rpl + h * 465;
    float mx = -1e30f;
#pragma unroll
    for (int kt = 0; kt < 16; ++kt) {
        const int kr = kt >> 1, ct = kt & 1, relr = rs + kr - r + 7;
#pragma unroll
        for (int j = 0; j < 4; ++j) {
            const int kc = cw + 8 * quad + 4 * ct + j; const bool valid = (kc >= cs) && (kc < cs + 16);
            const int relc = min(max(kc - c + 15, 0), 30);
            const float v = valid ? S[kt][j] * 0.08838834764831845f + rp[relr * 31 + relc] : -1e30f;
            S[kt][j] = v; mx = fmaxf(mx, v);
        }
    }
    mx = fmaxf(mx, sx(mx, 16)); mx = fmaxf(mx, sx(mx, 32));
    float sum = 0.f;
#pragma unroll
    for (int kt = 0; kt < 16; ++kt)
#pragma unroll
        for (int j = 0; j < 4; ++j) { const float v = S[kt][j]; const float e = (v > -1e29f) ? __expf(v - mx) : 0.f; S[kt][j] = e; sum += e; }
    sum += sx(sum, 16); sum += sx(sum, 32);
    f32x4 O[8];
#pragma unroll
    for (int dt = 0; dt < 8; ++dt) O[dt] = (f32x4){0.f, 0.f, 0.f, 0.f};
    const u16* vb = P.vcT + ((size_t)(b * 8 + h) * 128) * L_;
#pragma unroll
    for (int kq = 0; kq < 2; ++kq) {
        bf16x8 av[4][8];
#pragma unroll
        for (int k4 = 0; k4 < 4; ++k4) {
            const int tok0 = (rs + kq * 4 + k4) * 64 + cw + 8 * quad;
#pragma unroll
            for (int dt = 0; dt < 8; ++dt) av[k4][dt] = *(const bf16x8*)(vb + (size_t)(16 * dt + n) * L_ + tok0);
        }
#pragma unroll
        for (int k4 = 0; k4 < 4; ++k4) {
            const int kr = kq * 4 + k4;
            V8 pf; pf.u[0] = cvt_pk_bf16(S[2 * kr][0], S[2 * kr][1]); pf.u[1] = cvt_pk_bf16(S[2 * kr][2], S[2 * kr][3]);
            pf.u[2] = cvt_pk_bf16(S[2 * kr + 1][0], S[2 * kr + 1][1]); pf.u[3] = cvt_pk_bf16(S[2 * kr + 1][2], S[2 * kr + 1][3]);
#pragma unroll
            for (int dt = 0; dt < 8; ++dt) O[dt] = MFMA16(av[k4][dt], pf.v, O[dt]);
        }
    }
    const float inv = 1.0f / sum;
    u16* yp = P.y + (size_t)(b * L_ + r * 64 + c) * D_ + h * 128 + 4 * quad;
#pragma unroll
    for (int dt = 0; dt < 8; ++dt) { u32x2 w; w.x = cvt_pk_bf16(O[dt][0] * inv, O[dt][1] * inv); w.y = cvt_pk_bf16(O[dt][2] * inv, O[dt][3] * inv); *(u32x2*)(yp + 16 * dt) = w; }
}

constexpr int NA_ST = 18432;
template <int S_>
__device__ __forceinline__ void na_load_stage(u32x4 (&w)[4], const u16* pb, const u16* vb2, int rs, int h0, int tid) {
    constexpr int kr = S_ & 7;
    if (S_ < 8) {
#pragma unroll
        for (int j = 0; j < 4; ++j) { const int id = j * 512 + tid, tok = id >> 5, c16 = id & 31;
            w[j] = *(const u32x4*)(pb + (size_t)((rs + kr) * 64 + tok) * 6144 + 1024 + h0 * 128 + c16 * 8); }
    } else {
#pragma unroll
        for (int j = 0; j < 4; ++j) { const int id = j * 512 + tid, rowi = id >> 3, c = id & 7;
            w[j] = *(const u32x4*)(vb2 + (size_t)rowi * L_ + (rs + kr) * 64 + c * 8); }
    }
}
template <int S_>
__device__ __forceinline__ void na_write_stage(const u32x4 (&w)[4], u16* buf, int tid) {
    if (S_ < 8) {
#pragma unroll
        for (int j = 0; j < 4; ++j) { const int id = j * 512 + tid, tok = id >> 5, c16 = id & 31; *(u32x4*)(buf + ((c16 >> 4) * 64 + tok) * 136 + (c16 & 15) * 8) = w[j]; }
    } else {
#pragma unroll
        for (int j = 0; j < 4; ++j) { const int id = j * 512 + tid, rowi = id >> 3, c = id & 7; *(u32x4*)(buf + rowi * 72 + c * 8) = w[j]; }
    }
}
__device__ __forceinline__ void nattn_wgitem(const Params& P, int io, int bb, int r, int hp, const float* rpl, u8* shm) {
    const int tid = opaque_tid(), wid = tid >> 6, lane = tid & 63, n = lane & 15, quad = lane >> 4;
    const int hh = wid >> 2, qb = wid & 3, h0 = hp * 2, h = h0 + hh, b = bb;
    const int rs = min(max(r - 4, 0), 56);
    const int cw = qb == 0 ? 0 : qb == 1 ? 8 : qb == 2 ? 24 : 32;
    const int c = 16 * qb + n, cs = min(max(c - 8, 0), 48);
    const u16* pb = P.p + (size_t)b * L_ * 6144;
    const u16* vb2 = P.vcT + ((size_t)(b * 8 + h0) * 128) * L_;
    u16* SB = (u16*)(shm + 16384);
    bf16x8 qf[4];
#pragma unroll
    for (int ks = 0; ks < 4; ++ks) qf[ks] = *(const bf16x8*)(pb + (size_t)(r * 64 + c) * 6144 + h * 128 + 32 * ks + 8 * quad);
    const int krow = 8 * (n >> 2) + (n & 3);
    f32x4 S[16], O[8];
#pragma unroll
    for (int dt = 0; dt < 8; ++dt) O[dt] = (f32x4){0.f, 0.f, 0.f, 0.f};
    float inv = 0.f;
    u32x4 w0[4], w1[4], w2[4];
    __syncthreads();
    na_load_stage<0>(w0, pb, vb2, rs, h0, tid);
    na_load_stage<1>(w1, pb, vb2, rs, h0, tid);
    na_load_stage<2>(w2, pb, vb2, rs, h0, tid);
    na_write_stage<0>(w0, SB, tid);
    __syncthreads();
#define NA_STAGE(S_) do { \
        if ((S_) + 3 < 16) na_load_stage<((S_) + 3) & 15>(((S_) % 3) == 0 ? w0 : ((S_) % 3) == 1 ? w1 : w2, pb, vb2, rs, h0, tid); \
        const u16* buf = SB + ((S_) & 1) * NA_ST; \
        if ((S_) < 8) { \
            _Pragma("unroll") for (int ct = 0; ct < 2; ++ct) { \
                const u16* kp = buf + (hh * 64 + cw + krow + 4 * ct) * 136 + 8 * quad; \
                f32x4 acc = (f32x4){0.f, 0.f, 0.f, 0.f}; \
                _Pragma("unroll") for (int ks = 0; ks < 4; ++ks) { const bf16x8 kf = *(const bf16x8*)(kp + 32 * ks); acc = MFMA16(kf, qf[ks], acc); } \
                S[((S_) & 7) * 2 + ct] = acc; } \
        } else { \
            constexpr int kr = (S_) & 7; \
            V8 pf; pf.u[0] = cvt_pk_bf16(S[2 * kr][0], S[2 * kr][1]); pf.u[1] = cvt_pk_bf16(S[2 * kr][2], S[2 * kr][3]); \
            pf.u[2] = cvt_pk_bf16(S[2 * kr + 1][0], S[2 * kr + 1][1]); pf.u[3] = cvt_pk_bf16(S[2 * kr + 1][2], S[2 * kr + 1][3]); \
            _Pragma("unroll") for (int dt = 0; dt < 8; ++dt) { const bf16x8 av = *(const bf16x8*)(buf + (hh * 128 + 16 * dt + n) * 72 + cw + 8 * quad); O[dt] = MFMA16(av, pf.v, O[dt]); } \
        } \
        if ((S_) == 7) { \
            const float* rp = rpl + h * 465; \
            float mx = -1e30f; \
            _Pragma("unroll") for (int kt = 0; kt < 16; ++kt) { const int kr2 = kt >> 1, ct = kt & 1, relr = rs + kr2 - r + 7; \
                _Pragma("unroll") for (int j = 0; j < 4; ++j) { const int kc = cw + 8 * quad + 4 * ct + j; const bool valid = (kc >= cs) && (kc < cs + 16); \
                    const int relc = min(max(kc - c + 15, 0), 30); \
                    const float v = valid ? S[kt][j] * 0.08838834764831845f + rp[relr * 31 + relc] : -1e30f; S[kt][j] = v; mx = fmaxf(mx, v); } } \
            mx = fmaxf(mx, sx(mx, 16)); mx = fmaxf(mx, sx(mx, 32)); \
            float sum = 0.f; \
            _Pragma("unroll") for (int kt = 0; kt < 16; ++kt) _Pragma("unroll") for (int j = 0; j < 4; ++j) { const float v = S[kt][j]; const float e = (v > -1e29f) ? __expf(v - mx) : 0.f; S[kt][j] = e; sum += e; } \
            sum += sx(sum, 16); sum += sx(sum, 32); inv = 1.0f / sum; \
        } \
        if ((S_) + 1 < 16) na_write_stage<((S_) + 1) & 15>((((S_) + 1) % 3) == 0 ? w0 : (((S_) + 1) % 3) == 1 ? w1 : w2, SB + (((S_) + 1) & 1) * NA_ST, tid); \
        __syncthreads(); \
    } while (0)
    NA_STAGE(0); NA_STAGE(1); NA_STAGE(2); NA_STAGE(3); NA_STAGE(4); NA_STAGE(5); NA_STAGE(6); NA_STAGE(7);
    NA_STAGE(8); NA_STAGE(9); NA_STAGE(10); NA_STAGE(11); NA_STAGE(12); NA_STAGE(13); NA_STAGE(14); NA_STAGE(15);
#undef NA_STAGE
    u16* yp = P.y + (size_t)(b * L_ + r * 64 + c) * D_ + h * 128 + 4 * quad;
#pragma unroll
    for (int dt = 0; dt < 8; ++dt) { u32x2 wv; wv.x = cvt_pk_bf16(O[dt][0] * inv, O[dt][1] * inv); wv.y = cvt_pk_bf16(O[dt][2] * inv, O[dt][3] * inv); *(u32x2*)(yp + 16 * dt) = wv; }
}

constexpr int DA_BUFE = (128 + 128) * 72;
__device__ __forceinline__ void da_iter(const int kt, u32x4 (&wr)[4], u32x4 (&ld)[4], f32x16 (&O)[4], V8 (&pf)[2][2], float& mrun, float& lrun, const bf16x8 (&qf)[4],
                                        u16* SB, const u16* kg0, const u16* vg0, const int mw, const int l31, const int kh, const int lrow, const int lch) {
    constexpr int BUFE = DA_BUFE;
        const u16* Ks = SB + (kt & 1) * BUFE; const u16* Vs = Ks + 128 * 72;
        {
            const int kn = kt + 2 < 64 ? kt + 2 : 63, vn = kt + 1 < 64 ? kt + 1 : 63;
            const u16* kg = kg0 + (size_t)kn * 64 * 6144; const u16* vg = vg0 + vn * 64;
            ld[0] = *(const u32x4*)(kg); ld[1] = *(const u32x4*)(kg + 64); ld[2] = *(const u32x4*)(vg); ld[3] = *(const u32x4*)(vg + (size_t)64 * L_);
        }
        f32x16 s0, s1;
        const float nm = -mrun;
#pragma unroll
        for (int r = 0; r < 16; ++r) { s0[r] = nm; s1[r] = nm; }
        {
            bf16x8 a0[4], a1[4];
#pragma unroll
            for (int ks = 0; ks < 4; ++ks) { a0[ks] = *(const bf16x8*)(Ks + (mw * 64 + l31) * 72 + 16 * ks + 8 * kh); a1[ks] = *(const bf16x8*)(Ks + (mw * 64 + 32 + l31) * 72 + 16 * ks + 8 * kh); }
#pragma unroll
            for (int ks = 0; ks < 4; ++ks) { s0 = MFMA32(a0[ks], qf[ks], s0); s1 = MFMA32(a1[ks], qf[ks], s1); }
        }
        bf16x8 av[2][4];
#pragma unroll
        for (int dt = 0; dt < 4; ++dt) av[0][dt] = *(const bf16x8*)(Vs + (32 * dt + l31) * 72 + 8 * kh);
        float mx = fmaxf(s0[0], s1[0]);
#pragma unroll
        for (int r = 1; r < 16; ++r) mx = fmaxf(fmaxf(mx, s0[r]), s1[r]);
        mx = fmaxf(mx, sx(mx, 32));
        const bool resc = (kt == 0) || (__builtin_amdgcn_ballot_w64(mx > 8.0f) != 0ull);
        float alpha = 1.0f;
        if (resc) {
            const float delta = (kt == 0) ? mx : fmaxf(mx, 0.f);
            alpha = (kt == 0) ? 0.f : __builtin_amdgcn_exp2f(-delta);
#pragma unroll
            for (int r = 0; r < 16; ++r) { s0[r] -= delta; s1[r] -= delta; }
            lrun *= alpha; mrun += delta;
        }
        V8 pn[2][2];
        float ps = 0.f;
#pragma unroll
        for (int tt = 0; tt < 2; ++tt)
#pragma unroll
            for (int ip = 0; ip < 2; ++ip) {
                const int gq = tt * 2 + ip;
                if (gq < 3) {
#pragma unroll
                    for (int dt = 0; dt < 4; ++dt) av[(gq + 1) & 1][dt] = *(const bf16x8*)(Vs + (32 * dt + l31) * 72 + 16 * (gq + 1) + 8 * kh);
                }
#pragma unroll
                for (int dt = 0; dt < 4; ++dt) O[dt] = MFMA32(av[gq & 1][dt], pf[tt][ip].v, O[dt]);
#pragma unroll
                for (int j = 0; j < 4; ++j) {
                    float e0, e1;
                    if (tt == 0) { e0 = __builtin_amdgcn_exp2f(s0[8 * ip + 2 * j]); e1 = __builtin_amdgcn_exp2f(s0[8 * ip + 2 * j + 1]); }
                    else { e0 = __builtin_amdgcn_exp2f(s1[8 * ip + 2 * j]); e1 = __builtin_amdgcn_exp2f(s1[8 * ip + 2 * j + 1]); }
                    ps += e0 + e1;
                    pn[tt][ip].u[j] = cvt_pk_bf16(e0, e1);
                }
            }
        ps += sx(ps, 32);
        lrun += ps;
        if (resc) {
#pragma unroll
            for (int dt = 0; dt < 4; ++dt)
#pragma unroll
                for (int r = 0; r < 16; ++r) O[dt][r] *= alpha;
        }
#pragma unroll
        for (int a = 0; a < 2; ++a)
#pragma unroll
            for (int c = 0; c < 2; ++c) pf[a][c] = pn[a][c];
        {
            u16* nb = SB + ((kt + 1) & 1) * BUFE;
            *(u32x4*)(nb + lrow * 72 + lch * 8) = wr[0]; *(u32x4*)(nb + (64 + lrow) * 72 + lch * 8) = wr[1];
            *(u32x4*)(nb + (128 + lrow) * 72 + lch * 8) = wr[2]; *(u32x4*)(nb + (192 + lrow) * 72 + lch * 8) = wr[3];
        }
        __syncthreads();
}

__device__ __forceinline__ void da_iter_b(const int kt, u32x4 (&wr)[4], u32x4 (&ld)[4], f32x16 (&O)[4], V8 (&pf)[2][2], float& mrun, float& lrun, const bf16x8 (&qf)[4],
                                          u16* SB, const u16* kg0, const u16* vg0, const int mw, const int l31, const int kh, const int lrow, const int lch) {
    constexpr int BUFE = DA_BUFE;
    const u16* Ks = SB + (kt & 1) * BUFE; const u16* Vs = Ks + 128 * 72;
    {
        const int kn = kt + 2 < 64 ? kt + 2 : 63, vn = kt + 1 < 64 ? kt + 1 : 63;
        const u16* kg = kg0 + (size_t)kn * 64 * 6144; const u16* vg = vg0 + vn * 64;
        ld[0] = *(const u32x4*)(kg); ld[1] = *(const u32x4*)(kg + 64); ld[2] = *(const u32x4*)(vg); ld[3] = *(const u32x4*)(vg + (size_t)64 * L_);
    }
    {
        bf16x8 av[2][4];
#pragma unroll
        for (int dt = 0; dt < 4; ++dt) av[0][dt] = *(const bf16x8*)(Vs + (32 * dt + l31) * 72 + 8 * kh);
#pragma unroll
        for (int gq = 0; gq < 4; ++gq) {
            if (gq < 3) {
#pragma unroll
                for (int dt = 0; dt < 4; ++dt) av[(gq + 1) & 1][dt] = *(const bf16x8*)(Vs + (32 * dt + l31) * 72 + 16 * (gq + 1) + 8 * kh);
            }
#pragma unroll
            for (int dt = 0; dt < 4; ++dt) O[dt] = MFMA32(av[gq & 1][dt], pf[gq >> 1][gq & 1].v, O[dt]);
        }
    }
    f32x16 s0, s1;
    const float nm = -mrun;
#pragma unroll
    for (int r = 0; r < 16; ++r) { s0[r] = nm; s1[r] = nm; }
    {
        bf16x8 a0[4], a1[4];
#pragma unroll
        for (int ks = 0; ks < 4; ++ks) { a0[ks] = *(const bf16x8*)(Ks + (mw * 64 + l31) * 72 + 16 * ks + 8 * kh); a1[ks] = *(const bf16x8*)(Ks + (mw * 64 + 32 + l31) * 72 + 16 * ks + 8 * kh); }
#pragma unroll
        for (int ks = 0; ks < 4; ++ks) { s0 = MFMA32(a0[ks], qf[ks], s0); s1 = MFMA32(a1[ks], qf[ks], s1); }
    }
    float mx = fmaxf(s0[0], s1[0]);
#pragma unroll
    for (int r = 1; r < 16; ++r) mx = fmaxf(fmaxf(mx, s0[r]), s1[r]);
    mx = fmaxf(mx, sx(mx, 32));
    const bool resc = (kt == 0) || (__builtin_amdgcn_ballot_w64(mx > 8.0f) != 0ull);
    if (resc) {
        const float delta = (kt == 0) ? mx : fmaxf(mx, 0.f);
        const float alpha = (kt == 0) ? 0.f : __builtin_amdgcn_exp2f(-delta);
#pragma unroll
        for (int r = 0; r < 16; ++r) { s0[r] -= delta; s1[r] -= delta; }
        lrun *= alpha; mrun += delta;
#pragma unroll
        for (int dt = 0; dt < 4; ++dt)
#pragma unroll
            for (int r = 0; r < 16; ++r) O[dt][r] *= alpha;
    }
    float ps = 0.f;
#pragma unroll
    for (int ip = 0; ip < 2; ++ip)
#pragma unroll
        for (int j = 0; j < 4; ++j) {
            const float e0 = __builtin_amdgcn_exp2f(s0[8 * ip + 2 * j]), e1 = __builtin_amdgcn_exp2f(s0[8 * ip + 2 * j + 1]);
            const float f0 = __builtin_amdgcn_exp2f(s1[8 * ip + 2 * j]), f1 = __builtin_amdgcn_exp2f(s1[8 * ip + 2 * j + 1]);
            ps += (e0 + e1) + (f0 + f1);
            pf[0][ip].u[j] = cvt_pk_bf16(e0, e1); pf[1][ip].u[j] = cvt_pk_bf16(f0, f1);
        }
    ps += sx(ps, 32);
    lrun += ps;
    {
        u16* nb = SB + ((kt + 1) & 1) * BUFE;
        *(u32x4*)(nb + lrow * 72 + lch * 8) = wr[0]; *(u32x4*)(nb + (64 + lrow) * 72 + lch * 8) = wr[1];
        *(u32x4*)(nb + (128 + lrow) * 72 + lch * 8) = wr[2]; *(u32x4*)(nb + (192 + lrow) * 72 + lch * 8) = wr[3];
    }
    __syncthreads();
}

__device__ __forceinline__ void da_iter2(const int kt, f32x16 (&sc)[2], f32x16 (&sn)[2], u32x4 (&wr)[4], u32x4 (&ld)[4], f32x16 (&O)[4], V8 (&pf)[2][2], float& mrun, float& lrun,
                                         const bf16x8 (&qf)[4], u16* SB, const u16* kg0, const u16* vg0, const int mw, const int l31, const int kh, const int lrow, const int lch) {
    constexpr int BUFE = DA_BUFE;
    const u16* Ks = SB + (kt & 1) * BUFE; const u16* Vs = Ks + 128 * 72;
    {
        const int kn = kt + 3 < 64 ? kt + 3 : 63, vn = kt + 1 < 64 ? kt + 1 : 63;
        const u16* kg = kg0 + (size_t)kn * 64 * 6144; const u16* vg = vg0 + vn * 64;
        ld[0] = *(const u32x4*)(kg); ld[1] = *(const u32x4*)(kg + 64); ld[2] = *(const u32x4*)(vg); ld[3] = *(const u32x4*)(vg + (size_t)64 * L_);
    }
    __builtin_amdgcn_s_setprio(1);
    {
        bf16x8 a0[4], a1[4];
#pragma unroll
        for (int ks = 0; ks < 4; ++ks) { a0[ks] = *(const bf16x8*)(Ks + (mw * 64 + l31) * 72 + 16 * ks + 8 * kh); a1[ks] = *(const bf16x8*)(Ks + (mw * 64 + 32 + l31) * 72 + 16 * ks + 8 * kh); }
        f32x16 z;
#pragma unroll
        for (int r = 0; r < 16; ++r) z[r] = 0.f;
        sn[0] = MFMA32(a0[0], qf[0], z); sn[1] = MFMA32(a1[0], qf[0], z);
#pragma unroll
        for (int ks = 1; ks < 4; ++ks) { sn[0] = MFMA32(a0[ks], qf[ks], sn[0]); sn[1] = MFMA32(a1[ks], qf[ks], sn[1]); }
    }
    float mx = fmaxf(sc[0][0], sc[1][0]);
#pragma unroll
    for (int r = 1; r < 16; ++r) mx = fmaxf(fmaxf(mx, sc[0][r]), sc[1][r]);
    mx = fmaxf(mx, sx(mx, 32));
    const bool resc = (kt == 0) || (__builtin_amdgcn_ballot_w64(mx - mrun > 8.0f) != 0ull);
    float alpha = 1.0f;
    if (resc) {
        const float mnew = (kt == 0) ? mx : fmaxf(mrun, mx);
        alpha = (kt == 0) ? 0.f : __builtin_amdgcn_exp2f(mrun - mnew);
        lrun *= alpha; mrun = mnew;
    }
    V8 pn[2][2];
    float ps = 0.f;
    bf16x8 av[2][4];
#pragma unroll
    for (int dt = 0; dt < 4; ++dt) av[0][dt] = *(const bf16x8*)(Vs + (32 * dt + l31) * 72 + 8 * kh);
#pragma unroll
    for (int tt = 0; tt < 2; ++tt)
#pragma unroll
        for (int ip = 0; ip < 2; ++ip) {
            const int gq = tt * 2 + ip;
            if (gq < 3) {
#pragma unroll
                for (int dt = 0; dt < 4; ++dt) av[(gq + 1) & 1][dt] = *(const bf16x8*)(Vs + (32 * dt + l31) * 72 + 16 * (gq + 1) + 8 * kh);
            }
#pragma unroll
            for (int dt = 0; dt < 4; ++dt) O[dt] = MFMA32(av[gq & 1][dt], pf[tt][ip].v, O[dt]);
#pragma unroll
            for (int j = 0; j < 4; ++j) {
                const float e0 = __builtin_amdgcn_exp2f(sc[tt][8 * ip + 2 * j] - mrun), e1 = __builtin_amdgcn_exp2f(sc[tt][8 * ip + 2 * j + 1] - mrun);
                ps += e0 + e1;
                pn[tt][ip].u[j] = cvt_pk_bf16(e0, e1);
            }
        }
    __builtin_amdgcn_s_setprio(0);
    ps += sx(ps, 32);
    lrun += ps;
    if (resc) {
#pragma unroll
        for (int dt = 0; dt < 4; ++dt)
#pragma unroll
            for (int r = 0; r < 16; ++r) O[dt][r] *= alpha;
    }
#pragma unroll
    for (int a = 0; a < 2; ++a)
#pragma unroll
        for (int c = 0; c < 2; ++c) pf[a][c] = pn[a][c];
    {
        u16* nb = SB + ((kt + 1) & 1) * BUFE;
        *(u32x4*)(nb + lrow * 72 + lch * 8) = wr[0]; *(u32x4*)(nb + (64 + lrow) * 72 + lch * 8) = wr[1];
        *(u32x4*)(nb + (128 + lrow) * 72 + lch * 8) = wr[2]; *(u32x4*)(nb + (192 + lrow) * 72 + lch * 8) = wr[3];
    }
    __syncthreads();
}

__device__ __forceinline__ void dattn_item(const Params& P, int io, float lam_init, int item, u8* shm) {
    const int tid = opaque_tid(), wid = tid >> 6, lane = tid & 63, l31 = lane & 31, kh = lane >> 5, mw = wid >> 2, qw = wid & 3;
    const int qb = item & 31, h = (item >> 5) & 7, b = item >> 8;
    const float* lp = P.in[24] + io * 256;
    const float sa = wave_sum(lp[lane] * lp[64 + lane]), sc = wave_sum(lp[128 + lane] * lp[192 + lane]);
    const float lam = expf(sa) - expf(sc) + lam_init;
    const int tq = qb * 128 + 32 * qw + l31;
    const u16* pb = P.p + (size_t)b * L_ * 6144;
    const u16* qrow = pb + (size_t)tq * 6144 + 3072 + h * 128 + mw * 64;
    bf16x8 qf[4];
#pragma unroll
    for (int ks = 0; ks < 4; ++ks) qf[ks] = *(const bf16x8*)(qrow + 16 * ks + 8 * kh);
    f32x16 O[4];
#pragma unroll
    for (int dt = 0; dt < 4; ++dt)
#pragma unroll
        for (int r = 0; r < 16; ++r) O[dt][r] = 0.f;
    float mrun = 0.f, lrun = 0.f;
    constexpr int BUFE = (128 + 128) * 72;
    u16* SB = (u16*)shm;
    const u16* vb = P.vdT + ((size_t)(b * 8 + h) * 128) * L_;
    const int lrow = tid >> 3, lch = tid & 7;
    const u16* kg0 = pb + (size_t)lrow * 6144 + 4096 + h * 128 + lch * 8;
    const u16* vg0 = vb + (size_t)lrow * L_ + lch * 8;
    u32x4 wA[4], wB[4];
    f32x16 sA[2], sB[2];
    __syncthreads();
    {
        const u32x4 k0a = *(const u32x4*)(kg0), k0b = *(const u32x4*)(kg0 + 64);
        const u32x4 k1a = *(const u32x4*)(kg0 + (size_t)64 * 6144), k1b = *(const u32x4*)(kg0 + (size_t)64 * 6144 + 64);
        wA[0] = *(const u32x4*)(kg0 + (size_t)128 * 6144); wA[1] = *(const u32x4*)(kg0 + (size_t)128 * 6144 + 64); wA[2] = *(const u32x4*)(vg0); wA[3] = *(const u32x4*)(vg0 + (size_t)64 * L_);
        u16* B1 = SB + DA_BUFE;
        *(u32x4*)(B1 + lrow * 72 + lch * 8) = k0a; *(u32x4*)(B1 + (64 + lrow) * 72 + lch * 8) = k0b;
        *(u32x4*)(SB + lrow * 72 + lch * 8) = k1a; *(u32x4*)(SB + (64 + lrow) * 72 + lch * 8) = k1b;
        *(uint4*)(SB + (128 + lrow) * 72 + lch * 8) = make_uint4(0, 0, 0, 0); *(uint4*)(SB + (192 + lrow) * 72 + lch * 8) = make_uint4(0, 0, 0, 0);
    }
    __syncthreads();
    {
        const u16* Ks = SB + DA_BUFE;
        bf16x8 a0[4], a1[4];
#pragma unroll
        for (int ks = 0; ks < 4; ++ks) { a0[ks] = *(const bf16x8*)(Ks + (mw * 64 + l31) * 72 + 16 * ks + 8 * kh); a1[ks] = *(const bf16x8*)(Ks + (mw * 64 + 32 + l31) * 72 + 16 * ks + 8 * kh); }
#pragma unroll
        for (int r = 0; r < 16; ++r) { sA[0][r] = 0.f; sA[1][r] = 0.f; }
#pragma unroll
        for (int ks = 0; ks < 4; ++ks) { sA[0] = MFMA32(a0[ks], qf[ks], sA[0]); sA[1] = MFMA32(a1[ks], qf[ks], sA[1]); }
    }
    __syncthreads();
    V8 pf[2][2];
#pragma unroll
    for (int a = 0; a < 2; ++a)
#pragma unroll
        for (int c = 0; c < 2; ++c) pf[a][c].q = make_uint4(0, 0, 0, 0);
#pragma unroll 1
    for (int kt2 = 0; kt2 < 64; kt2 += 2) {
        da_iter2(kt2, sA, sB, wA, wB, O, pf, mrun, lrun, qf, SB, kg0, vg0, mw, l31, kh, lrow, lch);
        da_iter2(kt2 + 1, sB, sA, wB, wA, O, pf, mrun, lrun, qf, SB, kg0, vg0, mw, l31, kh, lrow, lch);
    }
    {
        const u16* Vs = SB + 128 * 72;
#pragma unroll
        for (int tt = 0; tt < 2; ++tt)
#pragma unroll
            for (int ip = 0; ip < 2; ++ip)
#pragma unroll
                for (int dt = 0; dt < 4; ++dt) {
                    const bf16x8 av = *(const bf16x8*)(Vs + (32 * dt + l31) * 72 + 32 * tt + 16 * ip + 8 * kh);
                    O[dt] = MFMA32(av, pf[tt][ip].v, O[dt]);
                }
    }
    __syncthreads();
    float* comb = (float*)shm;
    const float inv = 1.0f / lrun;
    if (mw == 1) {
#pragma unroll
        for (int dt = 0; dt < 4; ++dt)
#pragma unroll
            for (int i4 = 0; i4 < 4; ++i4) {
                const int d = 32 * dt + 8 * i4 + 4 * kh;
                *(float4*)(comb + (32 * qw + l31) * 132 + d) = make_float4(O[dt][4 * i4] * inv, O[dt][4 * i4 + 1] * inv, O[dt][4 * i4 + 2] * inv, O[dt][4 * i4 + 3] * inv);
            }
    }
    __syncthreads();
    if (mw == 0) {
        float ss = 0.f;
#pragma unroll
        for (int dt = 0; dt < 4; ++dt)
#pragma unroll
            for (int i4 = 0; i4 < 4; ++i4) {
                const int d = 32 * dt + 8 * i4 + 4 * kh;
                const float4 o1 = *(const float4*)(comb + (32 * qw + l31) * 132 + d);
                const float a0 = O[dt][4 * i4] * inv - lam * o1.x, a1 = O[dt][4 * i4 + 1] * inv - lam * o1.y, a2 = O[dt][4 * i4 + 2] * inv - lam * o1.z, a3 = O[dt][4 * i4 + 3] * inv - lam * o1.w;
                O[dt][4 * i4] = a0; O[dt][4 * i4 + 1] = a1; O[dt][4 * i4 + 2] = a2; O[dt][4 * i4 + 3] = a3;
                ss += a0 * a0 + a1 * a1 + a2 * a2 + a3 * a3;
            }
        ss += sx(ss, 32);
        const float rstd = rsqrtf(ss * (1.0f / 128.0f) + 1e-6f) * (1.0f - lam_init);
        const float* sg = P.in[25] + io * 128;
        u16* yp = P.y + (size_t)(b * L_ + tq) * D_ + 1024 + h * 128;
#pragma unroll
        for (int dt = 0; dt < 4; ++dt)
#pragma unroll
            for (int i4 = 0; i4 < 4; ++i4) {
                const int d = 32 * dt + 8 * i4 + 4 * kh;
                const float4 g4 = *(const float4*)(sg + d);
                u32x2 w; w.x = cvt_pk_bf16(O[dt][4 * i4] * rstd * g4.x, O[dt][4 * i4 + 1] * rstd * g4.y); w.y = cvt_pk_bf16(O[dt][4 * i4 + 2] * rstd * g4.z, O[dt][4 * i4 + 3] * rstd * g4.w);
                *(u32x2*)(yp + d) = w;
            }
    }
}

__device__ __forceinline__ void cgfix_phase(const Params& P, int l) {
    const float* cw = P.in[5] + (size_t)l * 3 * F2_; const float* cb = P.in[6] + (size_t)l * F2_;
    const int nth = gridDim.x * 512;
    for (int idx = blockIdx.x * 512 + opaque_tid(); idx < 257 * 2 * 704; idx += nth) {
        const int chunk = idx % 704, t = idx / 704, which = t & 1, k = t >> 1, f0 = chunk * 8;
        const int row = which ? 64 * k : 64 * k - 1;
        if (row < 0 || row >= T_) continue;
        const int s0 = row & 4095;
        const int rp = row - 1, rn = row + 1;
        const u16* ec = P.edge + (size_t)((row >> 6) * 4 + ((row & 63) < 2 ? (row & 63) : (row & 63) - 60)) * F2_ + f0;
        const uint4 zero = make_uint4(0, 0, 0, 0);
        uint4 pg = zero, pv = zero, ng = zero, nv = zero;
        if (s0 > 0) { const u16* ep = P.edge + (size_t)((rp >> 6) * 4 + ((rp & 63) < 2 ? (rp & 63) : (rp & 63) - 60)) * F2_ + f0; pg = *(const uint4*)ep; pv = *(const uint4*)(ep + F_); }
        if (s0 < 4095) { const u16* en = P.edge + (size_t)((rn >> 6) * 4 + ((rn & 63) < 2 ? (rn & 63) : (rn & 63) - 60)) * F2_ + f0; ng = *(const uint4*)en; nv = *(const uint4*)(en + F_); }
        const uint4 cg_ = *(const uint4*)ec, cv = *(const uint4*)(ec + F_);
        const unsigned a0[4] = {pg.x, pg.y, pg.z, pg.w}, a1[4] = {cg_.x, cg_.y, cg_.z, cg_.w}, a2[4] = {ng.x, ng.y, ng.z, ng.w};
        const unsigned c0[4] = {pv.x, pv.y, pv.z, pv.w}, c1[4] = {cv.x, cv.y, cv.z, cv.w}, c2[4] = {nv.x, nv.y, nv.z, nv.w};
        unsigned ow[4];
#pragma unroll
        for (int j = 0; j < 4; ++j) {
            const int fa = f0 + 2 * j, fb = fa + 1;
            const float gl = cw[fa] * bflo(a0[j]) + cw[F2_ + fa] * bflo(a1[j]) + cw[2 * F2_ + fa] * bflo(a2[j]) + cb[fa];
            const float gh = cw[fb] * bfhi(a0[j]) + cw[F2_ + fb] * bfhi(a1[j]) + cw[2 * F2_ + fb] * bfhi(a2[j]) + cb[fb];
            const float vl = cw[F_ + fa] * bflo(c0[j]) + cw[F2_ + F_ + fa] * bflo(c1[j]) + cw[2 * F2_ + F_ + fa] * bflo(c2[j]) + cb[F_ + fa];
            const float vh = cw[F_ + fb] * bfhi(c0[j]) + cw[F2_ + F_ + fb] * bfhi(c1[j]) + cw[2 * F2_ + F_ + fb] * bfhi(c2[j]) + cb[F_ + fb];
            ow[j] = cvt_pk_bf16(gl / (1.0f + __expf(-gl)) * vl, gh / (1.0f + __expf(-gh)) * vh);
        }
        *(uint4*)(P.gated + (size_t)row * F_ + f0) = make_uint4(ow[0], ow[1], ow[2], ow[3]);
    }
}
__device__ __forceinline__ void cgtab_phase(const Params& P) {
    const int nth = gridDim.x * 512;
    for (int idx = blockIdx.x * 512 + opaque_tid(); idx < 4 * 44 * 1024; idx += nth) {
        const int c = idx & 255, k = (idx >> 8) & 3, pn = (idx >> 10) % 44, l = idx / (44 * 1024);
        const int col = (c >> 7) * F_ + 128 * pn + (c & 127);
        P.cgtab[idx] = k < 3 ? P.in[5][((size_t)l * 3 + k) * F2_ + col] : P.in[6][(size_t)l * F2_ + col];
    }
}

__device__ __forceinline__ int rstd_table(const float* ssp, const pg8::StaticOrder& S, u8* shm) {
    PG8_LAS float* rt = (PG8_LAS float*)((PG8_LAS u8*)shm + 131072);
    pg8::Unit u0; if (!S.next(0, u0)) return -1;
    const int tid = opaque_tid();
    const float4* sp = (const float4*)(ssp + (size_t)(u0.pm * 256 + (tid >> 1)) * 32 + (tid & 1) * 16);
    const float4 a = sp[0], b = sp[1], c = sp[2], d = sp[3];
    float s = ((a.x + a.y) + (a.z + a.w)) + ((b.x + b.y) + (b.z + b.w)) + ((c.x + c.y) + (c.z + c.w)) + ((d.x + d.y) + (d.z + d.w));
    s += sx(s, 1);
    if ((tid & 1) == 0) rt[tid >> 1] = rsqrtf(s * (1.0f / D_) + 1e-6f);
    __syncthreads();
    return u0.pm;
}

template <int OP>
__device__ __forceinline__ void run_op(const Params& P, const int l, const int which, u8* shm) {
    constexpr int op = OP; const int i = l >> 1;
    PG8_LAS u8* lds = (PG8_LAS u8*)shm;
    switch (op) {
    case OP_PRE: {
        const int total = P.cw_t0[16];
        for (int tile = blockIdx.x; tile < total; tile += gridDim.x) {
            int mi = 0;
#pragma unroll 1
            for (int k = 1; k < 16; ++k) if (tile >= P.cw_t0[k]) mi = k;
            convT_tile(P.cw_src[mi], P.cw_K[mi], P.cw_N[mi], P.cw_dst[mi], P.cw_g[mi], P.cw_perm[mi], tile - P.cw_t0[mi], shm);
        }
        hf1_phase(P);
        cgtab_phase(P);
        xprep_phase(P.in[0], P.h, P.ssp);
    } break;
    case OP_HF2: {
        for (int id = blockIdx.x; id < 512; id += gridDim.x) hf2_item(P, id, shm);
    } break;
    case OP_NORM: {
        if (which == 0) norm_phase(P.x, P.in[1] + l * D_, P.h, nullptr);
        else if (which == 1) norm_phase(P.x, P.in[2] + l * D_, P.h, nullptr);
        else norm_phase(P.x, P.in[8], nullptr, P.x);
    } break;
    case OP_GEMM_IN: {
        const int N = (l & 1) ? 6144 : 5120;
        pg8::Gemm g{P.h, P.wt_in[l], T_, N, D_};
        pg8::StaticOrder S; S.init(T_, N, gridDim.x, blockIdx.x);
        const int pm0 = rstd_table(P.ssp, S, shm);
        EpiStoreBf16 E{P.p, N, (l & 1) ? 0 : 2048, P.ssp, (const PG8_LAS float*)(lds + 131072), pm0};
        pg8::gemm_phase<EpiStoreBf16, pg8::StaticOrder, false>(lds, g, S, E, nullptr);
    } break;
    case OP_GEMM_UP: {
        pg8::Gemm g{P.h, P.wt_up[l], T_, F2_, D_};
        CgOrder S; S.init(T_, F2_, gridDim.x, blockIdx.x); S.tab = P.cgtab + (size_t)l * 44 * 1024; S.ldsb = lds;
        (void)rstd_table(P.ssp, S, shm);
        EpiGate E{P.gated, P.edge, (const PG8_LAS float*)(lds + LDS_RT), (const PG8_LAS float*)(lds + LDS_CGT)};
        pg8::gemm_phase<EpiGate, CgOrder, false>(lds, g, S, E, nullptr);
    } break;
    case OP_GEMM_OUT: {
        pg8::Gemm g{P.y, P.wt_out[l], T_, D_, D_};
        pg8::StaticOrder S; S.init(T_, D_, gridDim.x, blockIdx.x);
        EpiResid E{l == 0 ? P.in[0] : P.x, P.x, P.h, P.ssp};
        pg8::gemm_phase<EpiResid, pg8::StaticOrder, false>(lds, g, S, E, nullptr);
    } break;
    case OP_GEMM_DOWN: {
        pg8::Gemm g{P.gated, P.wt_down[l], T_, D_, F_};
        pg8::StaticOrder S; S.init(T_, D_, gridDim.x, blockIdx.x);
        EpiResid E{P.x, P.x, l == 3 ? (u16*)nullptr : P.h, P.ssp};
        pg8::gemm_phase<EpiResid, pg8::StaticOrder, false>(lds, g, S, E, nullptr);
    } break;
    case OP_EVEN_A: {
        for (int it = blockIdx.x; it < 256; it += gridDim.x) gmlp_item(P, i, it, shm);
        for (int tile = blockIdx.x; tile < 48 * 256; tile += 8 * gridDim.x)
            tr_tile<8>(P.p, 5120, 2048, 48, P.pT, (size_t)4 * L_, (size_t)L_, P.in[13] + (size_t)i * 3 * 3072, P.in[14] + (size_t)i * 3072, 3072, tile, gridDim.x, 48 * 256, shm);
    } break;
    case OP_HC: {
        {
            uint4* zp = (uint4*)((u16*)shm + 64 + 2 * FS);
            __syncthreads();
            unsigned z0 = 0u; asm volatile("" : "+v"(z0));
            for (int e = opaque_tid(); e < (2 * 4 * HU_B) / 8; e += 512) zp[e] = make_uint4(z0, z0, z0, z0);
            __syncthreads();
        }
        for (int c = blockIdx.x; c < 1024; c += gridDim.x) hconv_item(P, i, c, shm);
    } break;
    case OP_HB: {
        for (int tile = blockIdx.x; tile < 4096; tile += 8 * gridDim.x) trback_tile<8>(P.yT, P.y, tile, gridDim.x, 4096, shm);
    } break;
    case OP_ODD_PREP: {
        rotary_phase(P);
        for (int tile = blockIdx.x; tile < 16 * 256; tile += 8 * gridDim.x)
            tr_tile<8>(P.p, 6144, 2048, 16, P.vcT, (size_t)L_, (size_t)1024 * L_, nullptr, nullptr, 0, tile, gridDim.x, 16 * 256, shm);
        for (int tile = blockIdx.x; tile < 16 * 256; tile += 8 * gridDim.x)
            tr_tile<8>(P.p, 6144, 5120, 16, P.vdT, (size_t)L_, (size_t)1024 * L_, nullptr, nullptr, 0, tile, gridDim.x, 16 * 256, shm, true);
    } break;
    case OP_ATTN: {
        const float lam_init = 0.8f - 0.6f * expf(-0.3f * (float)l);
        for (int it = blockIdx.x; it < 1024; it += gridDim.x) {
            const int rnd = it / (int)gridDim.x, cidx = it - rnd * (int)gridDim.x;
            const int itm = (gridDim.x == 256) ? (((rnd * 8 + (cidx & 7)) << 5) + (cidx >> 3)) : it;
            dattn_item(P, i, lam_init, itm, shm);
        }
        const int wid = opaque_tid() >> 6;
        float* rpl = (float*)shm;
        __syncthreads();
        for (int e = opaque_tid(); e < 8 * 465; e += 512) rpl[e] = P.in[23][(size_t)i * 8 * 465 + e];
        __syncthreads();
        for (int wg = blockIdx.x; wg < 1024; wg += gridDim.x) {
            int bb, row, hp;
            if (gridDim.x == 256) { const int rnd = wg >> 8, cidx = wg & 255, pr = (cidx & 7) * 2 + (rnd >> 1); bb = pr >> 2; hp = pr & 3; row = (rnd & 1) * 32 + (cidx >> 3); }
            else { hp = wg & 3; row = (wg >> 2) & 63; bb = wg >> 8; }
            nattn_wgitem(P, i, bb, row, hp, rpl, shm);
        }
#ifdef PROBE_NA
        for (int wg = blockIdx.x; wg < 1024; wg += gridDim.x) {
            const int rnd = wg >> 8, cidx = wg & 255, pr = (cidx & 7) * 2 + (rnd >> 1); const int bb = pr >> 2, hp = pr & 3, row = (rnd & 1) * 32 + (cidx >> 3);
            const int id = (bb << 11) | (row << 5) | (((hp << 1) | (wid >> 2)) << 2) | (wid & 3);
            nattn_witem(P, i, id, rpl);
        }
#endif
#ifdef PROBE_DA
        for (int it = blockIdx.x; it < 1024; it += gridDim.x) dattn_item(P, i, lam_init, it, shm);
#endif
    } break;
    case OP_CG: cgfix_phase(P, l); break;

    }
}

#if MEGA
__global__ __launch_bounds__(512, 2) void k_mega(Params P) {
    extern __shared__ __attribute__((aligned(16))) u8 shm[];
    cg::grid_group grid = cg::this_grid();
    volatile LAS unsigned* xst = (volatile LAS unsigned*)((LAS u8*)shm + LDS_XST);
    if (threadIdx.x < 4) xst[threadIdx.x] = 0u;
    __syncthreads();
    (void)xcd_barrier_post(P.bar, xst);
#define XSYNC() do { XcdBarrier b_; b_.bar = P.bar; b_.x = xb_xcc_id(); b_.st = xst; xcd_barrier(b_); } while (0)
#ifndef PROBE_MASK
#define PROBE_MASK 0
#endif
#define RUNP(OP, L) do { for (int r_ = 0; r_ < (((PROBE_MASK >> (OP)) & 1) ? 2 : 1); ++r_) { run_op<OP>(P, (L), 0, shm); XSYNC(); } } while (0)
    run_op<OP_PRE>(P, 0, 0, shm);
    if (P.nsteps == -12345) grid.sync();
    XSYNC();
    if ((PROBE_MASK >> OP_PRE) & 1) { run_op<OP_PRE>(P, 0, 0, shm); XSYNC(); }
    RUNP(OP_HF2, 0);
#pragma unroll 1
    for (int l = 0; l < 4; ++l) {
        RUNP(OP_GEMM_IN, l);
        if ((l & 1) == 0) { RUNP(OP_EVEN_A, l); RUNP(OP_HC, l); RUNP(OP_HB, l); }
        else { run_op<OP_ODD_PREP>(P, l, 0, shm); XSYNC(); RUNP(OP_ATTN, l); }
        run_op<OP_GEMM_OUT>(P, l, 0, shm); XSYNC();
        RUNP(OP_GEMM_UP, l);
        RUNP(OP_CG, l);
        run_op<OP_GEMM_DOWN>(P, l, 0, shm); XSYNC();
    }
    run_op<OP_NORM>(P, 3, 2, shm);
}
#else
__global__ __launch_bounds__(512, 2) void k_step(Params P, int step) {
    extern __shared__ __attribute__((aligned(16))) u8 shm[];
    const int l = P.lyr[step], a = P.arg[step];
    switch (P.ops[step]) {
    case OP_PRE: run_op<OP_PRE>(P, l, a, shm); break; case OP_HF2: run_op<OP_HF2>(P, l, a, shm); break; case OP_NORM: run_op<OP_NORM>(P, l, a, shm); break;
    case OP_GEMM_IN: run_op<OP_GEMM_IN>(P, l, a, shm); break; case OP_EVEN_A: run_op<OP_EVEN_A>(P, l, a, shm); break; case OP_HC: run_op<OP_HC>(P, l, a, shm); break;
    case OP_HB: run_op<OP_HB>(P, l, a, shm); break; case OP_ODD_PREP: run_op<OP_ODD_PREP>(P, l, a, shm); break; case OP_ATTN: run_op<OP_ATTN>(P, l, a, shm); break;
    case OP_GEMM_OUT: run_op<OP_GEMM_OUT>(P, l, a, shm); break; case OP_GEMM_UP: run_op<OP_GEMM_UP>(P, l, a, shm); break; case OP_CG: run_op<OP_CG>(P, l, a, shm); break;
    case OP_GEMM_DOWN: run_op<OP_GEMM_DOWN>(P, l, a, shm); break;
    }
}
#endif

extern "C" void kernel_launch(void* const* d_in, const int* in_sizes, int n_in, void* d_out, int out_size, void* d_ws, size_t ws_size, hipStream_t stream) {
    Params P; std::memset((void*)&P, 0, sizeof(P));
    for (int k = 0; k < 26; ++k) P.in[k] = (const float*)d_in[k];
    P.x = (float*)d_out;
    char* ws = (char*)d_ws; size_t off = 0;
    auto take = [&](size_t bytes) { char* r = ws + off; off += (bytes + 255) & ~(size_t)255; return r; };
    int nm = 0, t0 = 0;
    auto addw = [&](const float* src, int K, int N, u16* dst, const float* g) { P.cw_src[nm] = src; P.cw_dst[nm] = dst; P.cw_g[nm] = g; P.cw_perm[nm] = (N == F2_) ? 1 : 0; P.cw_K[nm] = K; P.cw_N[nm] = N; P.cw_t0[nm] = t0; t0 += (K / 64) * (N / 256); ++nm; };
    for (int l = 0; l < 4; ++l) {
        const int N = (l & 1) ? 6144 : 5120, i = l >> 1;
        P.wt_in[l] = (u16*)take((size_t)N * D_ * 2);
        P.wt_out[l] = (u16*)take((size_t)D_ * D_ * 2);
        P.wt_up[l] = (u16*)take((size_t)F2_ * D_ * 2);
        P.wt_down[l] = (u16*)take((size_t)D_ * F_ * 2);
        addw(((l & 1) ? P.in[22] : P.in[9]) + (size_t)i * D_ * N, D_, N, P.wt_in[l], P.in[1] + (size_t)l * D_);
        addw(P.in[3] + (size_t)l * D_ * D_, D_, D_, P.wt_out[l], nullptr);
        addw(P.in[4] + (size_t)l * D_ * F2_, D_, F2_, P.wt_up[l], P.in[2] + (size_t)l * D_);
        addw(P.in[7] + (size_t)l * F_ * D_, F_, D_, P.wt_down[l], nullptr);
    }
    P.cw_t0[16] = t0; P.cw_t0[17] = 0;
    P.h = (u16*)take((size_t)T_ * D_ * 2);
    P.y = (u16*)take((size_t)T_ * D_ * 2);
    char* r1 = take((size_t)T_ * F2_ * 2);
    P.up = (u16*)r1; P.p = (u16*)r1;
    P.pT = (u16*)(r1 + (size_t)T_ * 6144 * 2); P.yT = (u16*)(r1 + (size_t)T_ * 6144 * 2 + (size_t)3072 * T_ * 2);
    P.vcT = (u16*)(r1 + (size_t)T_ * 6144 * 2); P.vdT = (u16*)(r1 + (size_t)T_ * 6144 * 2 + (size_t)1024 * T_ * 2);
    P.gated = (u16*)take((size_t)T_ * F_ * 2);
    P.filt = (u16*)take((size_t)4096 * FS * 2);
    P.invn = (float*)take(4096 * 4);
    P.h2tab = (float*)take((size_t)2 * L_ * 64 * 4);
    P.ssp = (float*)take((size_t)T_ * 32 * 4);
    P.bar = (unsigned*)take((size_t)XCD_BAR_WORDS * 4);
    P.edge = (u16*)take((size_t)(T_ / 64) * 4 * F2_ * 2);
    P.cgtab = (float*)take((size_t)4 * 44 * 1024 * 4);
    if (off > ws_size) { fprintf(stderr, "workspace too small: need %zu have %zu\n", off, ws_size); }
    int ns = 0;
#ifndef PROBE_SET
#define PROBE_SET_ 0
#else
#define PROBE_SET_ PROBE_SET
#endif
    auto add = [&](int op, int l, int a) { P.ops[ns] = op; P.lyr[ns] = l; P.arg[ns] = a; P.rep[ns] = (((PROBE_SET_ >> op) & 1) && !(op == OP_NORM && a == 2)) ? 2 : 1; ++ns; };
    add(OP_PRE, 0, 0); add(OP_HF2, 0, 0);
    for (int l = 0; l < 4; ++l) {
        add(OP_GEMM_IN, l, 0);
        if ((l & 1) == 0) { add(OP_EVEN_A, l, 0); add(OP_HC, l, 0); add(OP_HB, l, 0); }
        else { add(OP_ODD_PREP, l, 0); add(OP_ATTN, l, 0); }
        add(OP_GEMM_OUT, l, 0); add(OP_GEMM_UP, l, 0); add(OP_CG, l, 0); add(OP_GEMM_DOWN, l, 0);
        if (l == 3) add(OP_NORM, l, 2);
    }
    P.nsteps = ns;
#if MEGA
    static int grid_blocks = 0;
    if (!grid_blocks) {
        (void)hipFuncSetAttribute((const void*)k_mega, hipFuncAttributeMaxDynamicSharedMemorySize, LDS_BYTES);
        int dev = 0, cus = 0, per_cu = 0;
        (void)hipGetDevice(&dev);
        (void)hipDeviceGetAttribute(&cus, hipDeviceAttributeMultiprocessorCount, dev);
        (void)hipOccupancyMaxActiveBlocksPerMultiprocessor(&per_cu, k_mega, 512, LDS_BYTES);
        if (per_cu < 1) per_cu = 1;
        grid_blocks = cus * 1;
    }
    (void)hipMemsetAsync(P.bar, 0, (size_t)XCD_BAR_WORDS * 4, stream);
    void* args[] = {&P};
    hipError_t e = hipLaunchCooperativeKernel((void*)k_mega, dim3(grid_blocks), dim3(512), args, LDS_BYTES, stream);
    if (e != hipSuccess) fprintf(stderr, "cooperative launch failed: %s (grid %d)\n", hipGetErrorString(e), grid_blocks);
#else
    static int inited = 0;
    if (!inited) { (void)hipFuncSetAttribute((const void*)k_step, hipFuncAttributeMaxDynamicSharedMemorySize, LDS_BYTES); inited = 1; }
    for (int s = 0; s < ns; ++s) k_step<<<256, 512, LDS_BYTES, stream>>>(P, s);
#endif
}
```
